# Optimizing an MI355X kernel written in HIP

```python
import jax, jax.numpy as jnp
from jax import lax
import numpy as np

D_MODEL = 1024
BATCH = 8
SEQ = 4096
DEPTH = 4

GRID_W = 64
CTX_LEN = 256
N_MIXERS = 3
N_A = (DEPTH + 2) // 3
N_B = (DEPTH + 1) // 3
N_C = DEPTH // 3
ATTN_HEADS = 8
ATTN_HD = D_MODEL // (2 * ATTN_HEADS)
ROPE_FREQS = ATTN_HD // 4
ROPE_BASE = 10000.0
Q_BLOCK = 128
FNET_GROUPS = 8
FNET_GW = D_MODEL // FNET_GROUPS
CONV_WIDTH = 31
CONV_PAD = CONV_WIDTH // 2
N_EXPERTS = 32
TOP_K = 4
D_FF = D_MODEL
SWIGLU_ALPHA = 1.702
SWIGLU_LIMIT = 7.0
MOE_BLOCK = 128
DEEPNORM_ALPHA = (2 * DEPTH) ** 0.25
DEEPNORM_BETA = (8 * DEPTH) ** -0.25
LN_EPS = 1e-5

kernel_name = "hybrid_diffattn_fnet_conformer_moe_dit"


def layer_norm(x, g, b):
    xf = x.astype(jnp.float32)
    mu = jnp.mean(xf, axis=-1, keepdims=True)
    var = jnp.mean(jnp.square(xf - mu), axis=-1, keepdims=True)
    return ((xf - mu) * lax.rsqrt(var + LN_EPS) * g + b).astype(x.dtype)


def axial_rope_tables(n):
    rows_count = n // GRID_W
    rows = jnp.repeat(jnp.arange(rows_count), GRID_W).astype(jnp.float32)
    cols = jnp.tile(jnp.arange(GRID_W), rows_count).astype(jnp.float32)
    inv_freq = ROPE_BASE ** (-jnp.arange(ROPE_FREQS, dtype=jnp.float32) / ROPE_FREQS)
    ang_r = rows[:, None] * inv_freq
    ang_c = cols[:, None] * inv_freq
    shp = (1, n, 1, 1, ROPE_FREQS)
    return (jnp.cos(ang_r).reshape(shp), jnp.sin(ang_r).reshape(shp),
            jnp.cos(ang_c).reshape(shp), jnp.sin(ang_c).reshape(shp))


def rotate_half(xp, cos, sin):
    x1, x2 = jnp.split(xp, 2, axis=-1)
    return jnp.concatenate([x1 * cos - x2 * sin, x2 * cos + x1 * sin], axis=-1)


def axial_rope(x, tables):
    cr, sr, cc, sc = tables
    half = ATTN_HD // 2
    xr = rotate_half(x[..., :half], cr, sr)
    xc = rotate_half(x[..., half:], cc, sc)
    return jnp.concatenate([xr, xc], axis=-1).astype(x.dtype)


def diff_core(q, k, v, lam):
    s = jnp.einsum('bqhcd,bkhcd->cbhqk', q, k, preferred_element_type=jnp.float32) * (ATTN_HD ** -0.5)
    p = jax.nn.softmax(s, axis=-1)
    attn = p[0] - lam * p[1]
    return jnp.einsum('bhqk,bkhv->bqhv', attn.astype(v.dtype), v)


def diff_head_out(o, subln_g, lam_init, w_o):
    of = o.astype(jnp.float32)
    of = of * lax.rsqrt(jnp.mean(jnp.square(of), axis=-1, keepdims=True) + LN_EPS) * subln_g * (1.0 - lam_init)
    B, N = o.shape[0], o.shape[1]
    return of.astype(o.dtype).reshape(B, N, D_MODEL) @ w_o


def diff_attention(u_lat, u_ctx, w_qkv, w_o, lq1, lk1, lq2, lk2, subln_g, lam_init, tables, with_ctx_out):
    B, N, _ = u_lat.shape

    def project(u):
        q, k, v = jnp.split(u @ w_qkv, 3, axis=-1)
        n = u.shape[1]
        return (q.reshape(B, n, ATTN_HEADS, 2, ATTN_HD),
                k.reshape(B, n, ATTN_HEADS, 2, ATTN_HD),
                v.reshape(B, n, ATTN_HEADS, 2 * ATTN_HD))

    q_l, k_l, v_l = project(u_lat)
    q_c, k_c, v_c = project(u_ctx)
    q_l = axial_rope(q_l, tables)
    k_l = axial_rope(k_l, tables)
    lam = (jnp.exp(jnp.sum(lq1 * lk1).astype(jnp.float32))
           - jnp.exp(jnp.sum(lq2 * lk2).astype(jnp.float32)) + lam_init)

    k_all = jnp.concatenate([k_l, k_c], axis=1)
    v_all = jnp.concatenate([v_l, v_c], axis=1)
    nb = N // Q_BLOCK
    q_blocks = q_l.reshape(B, nb, Q_BLOCK, ATTN_HEADS, 2, ATTN_HD).transpose(1, 0, 2, 3, 4, 5)
    o_l = lax.map(lambda qb: diff_core(qb, k_all, v_all, lam), q_blocks)
    o_l = o_l.transpose(1, 0, 2, 3, 4).reshape(B, N, ATTN_HEADS, 2 * ATTN_HD)
    y_lat = diff_head_out(o_l, subln_g, lam_init, w_o)
    y_ctx = None
    if with_ctx_out:
        y_ctx = diff_head_out(diff_core(q_c, k_c, v_c, lam), subln_g, lam_init, w_o)
    return y_lat, y_ctx


def fourier_mix(u, w, b):
    B, N, _ = u.shape
    ug = u.astype(jnp.float32).reshape(B, N, FNET_GROUPS, FNET_GW)
    f = jnp.fft.fft2(ug, axes=(1, 3), norm='ortho').real
    return f.reshape(B, N, D_MODEL).astype(u.dtype) @ w + b


def conformer_conv(u, w_pw1, b_pw1, w_dw, b_dw, ln_g, ln_b, w_pw2, b_pw2):
    h = u @ w_pw1 + b_pw1
    a, g = jnp.split(h, 2, axis=-1)
    h = a * jax.nn.sigmoid(g)
    h = lax.conv_general_dilated(h, w_dw[:, None, :].astype(h.dtype), window_strides=(1,),
                                 padding=[(CONV_PAD, CONV_PAD)],
                                 dimension_numbers=('NWC', 'WIO', 'NWC'),
                                 feature_group_count=D_MODEL) + b_dw
    h = jax.nn.silu(layer_norm(h, ln_g, ln_b))
    return h @ w_pw2 + b_pw2


def clamped_swiglu(h):
    glu, lin = jnp.split(h, 2, axis=-1)
    glu = jnp.minimum(glu, SWIGLU_LIMIT)
    lin = jnp.clip(lin, -SWIGLU_LIMIT, SWIGLU_LIMIT)
    return glu * jax.nn.sigmoid(SWIGLU_ALPHA * glu) * (lin + 1.0)


def moe(tokens, w_router, b_router, w1, b1, w2, b2):
    T = tokens.shape[0]
    logits = (tokens @ w_router + b_router).astype(jnp.float32)
    top_val, top_idx = lax.top_k(logits, TOP_K)
    gates = jax.nn.softmax(top_val, axis=-1)
    A = T * TOP_K
    flat_e = top_idx.reshape(-1)
    order = jnp.argsort(flat_e)
    sorted_e = flat_e[order]
    counts = jnp.bincount(flat_e, length=N_EXPERTS)
    padded = (counts + MOE_BLOCK - 1) // MOE_BLOCK * MOE_BLOCK
    start = jnp.cumsum(counts) - counts
    pend = jnp.cumsum(padded)
    pstart = pend - padded
    dest = pstart[sorted_e] + (jnp.arange(A) - start[sorted_e])
    n_blocks = -(-A // MOE_BLOCK) + N_EXPERTS
    P = n_blocks * MOE_BLOCK
    row_tok = jnp.zeros((P,), jnp.int32).at[dest].set((order // TOP_K).astype(jnp.int32))
    row_gate = jnp.zeros((P,), jnp.float32).at[dest].set(gates.reshape(-1)[order])
    block_e = jnp.minimum(jnp.searchsorted(pend, jnp.arange(n_blocks) * MOE_BLOCK, side='right'),
                          N_EXPERTS - 1)
    xb = tokens[row_tok].reshape(n_blocks, MOE_BLOCK, D_MODEL)

    def expert_block(args):
        xe, e = args
        h = clamped_swiglu(xe @ w1[e] + b1[e])
        return h @ w2[e] + b2[e]

    yb = lax.map(expert_block, (xb, block_e)).reshape(P, D_MODEL)
    return jnp.zeros_like(tokens).at[row_tok].add(yb * row_gate[:, None].astype(tokens.dtype))


def setup_inputs(seed: int = 0) -> dict:
    key = jax.random.key(seed)
    keys = iter(jax.random.split(key, 48))

    def nrm(shape, scale):
        return jax.random.normal(next(keys), shape, jnp.float32) * scale

    D, E, F, HD = D_MODEL, N_EXPERTS, D_FF, ATTN_HD
    din = D ** -0.5
    return {
        "x": nrm((BATCH, SEQ, D), 1.0),
        "c": nrm((BATCH, D), 1.0),
        "ctx": nrm((BATCH, CTX_LEN, D), 1.0),
        "c_ctx": nrm((D,), 1.0),
        "w_mod": nrm((DEPTH, D, 6 * D), 0.5 * din),
        "b_mod": nrm((DEPTH, 6 * D), 0.02),
        "ln1_g": 1.0 + nrm((DEPTH, D), 0.02),
        "ln1_b": nrm((DEPTH, D), 0.02),
        "ln2_g": 1.0 + nrm((DEPTH, D), 0.02),
        "ln2_b": nrm((DEPTH, D), 0.02),
        "attn_w_qkv": nrm((N_A, D, 3 * D), din),
        "attn_w_o": nrm((N_A, D, D), din * DEEPNORM_BETA),
        "attn_lam_q1": nrm((N_A, HD), 0.1),
        "attn_lam_k1": nrm((N_A, HD), 0.1),
        "attn_lam_q2": nrm((N_A, HD), 0.1),
        "attn_lam_k2": nrm((N_A, HD), 0.1),
        "attn_subln_g": 1.0 + nrm((N_A, 2 * HD), 0.02),
        "fnet_w": nrm((N_B, D, D), din * DEEPNORM_BETA),
        "fnet_b": nrm((N_B, D), 0.02),
        "conv_w_pw1": nrm((N_C, D, 2 * D), din),
        "conv_b_pw1": nrm((N_C, 2 * D), 0.02),
        "conv_w_dw": nrm((N_C, CONV_WIDTH, D), CONV_WIDTH ** -0.5),
        "conv_b_dw": nrm((N_C, D), 0.02),
        "conv_ln_g": 1.0 + nrm((N_C, D), 0.02),
        "conv_ln_b": nrm((N_C, D), 0.02),
        "conv_w_pw2": nrm((N_C, D, D), din * DEEPNORM_BETA),
        "conv_b_pw2": nrm((N_C, D), 0.02),
        "moe_w_router": nrm((DEPTH, D, E), din),
        "moe_b_router": nrm((DEPTH, E), 0.01),
        "moe_w1": nrm((DEPTH, E, D, 2 * F), din),
        "moe_b1": nrm((DEPTH, E, 2 * F), 0.02),
        "moe_w2": nrm((DEPTH, E, F, D), F ** -0.5 * DEEPNORM_BETA),
        "moe_b2": nrm((DEPTH, E, D), 0.02),
    }


def reference(x, c, ctx, c_ctx, w_mod, b_mod, ln1_g, ln1_b, ln2_g, ln2_b,
              attn_w_qkv, attn_w_o, attn_lam_q1, attn_lam_k1, attn_lam_q2, attn_lam_k2, attn_subln_g,
              fnet_w, fnet_b,
              conv_w_pw1, conv_b_pw1, conv_w_dw, conv_b_dw, conv_ln_g, conv_ln_b, conv_w_pw2, conv_b_pw2,
              moe_w_router, moe_b_router, moe_w1, moe_b1, moe_w2, moe_b2):
    B, N, D = x.shape
    C = ctx.shape[1]
    tables = axial_rope_tables(N)
    cond_lat = jax.nn.silu(c)
    cond_ctx = jax.nn.silu(c_ctx)
    x_lat, x_ctx = x, ctx

    for i in range(DEPTH):
        last = i == DEPTH - 1
        kind = i % N_MIXERS
        j = i // N_MIXERS
        m_lat = cond_lat @ w_mod[i] + b_mod[i]
        m_ctx = cond_ctx @ w_mod[i] + b_mod[i]
        sh1, sc1, g1, sh2, sc2, g2 = jnp.split(m_lat[:, None, :], 6, axis=-1)
        ch1, cs1, cg1, ch2, cs2, cg2 = jnp.split(m_ctx, 6)

        u_lat = x_lat * (1.0 + sc1) + sh1
        need_ctx = (not last) or kind == 0
        u_ctx = x_ctx * (1.0 + cs1) + ch1 if need_ctx else None
        if kind == 0:
            lam_init = 0.8 - 0.6 * float(np.exp(-0.3 * i))
            y_lat, y_ctx = diff_attention(u_lat, u_ctx, attn_w_qkv[j], attn_w_o[j],
                                          attn_lam_q1[j], attn_lam_k1[j], attn_lam_q2[j], attn_lam_k2[j],
                                          attn_subln_g[j], lam_init, tables, with_ctx_out=not last)
        elif kind == 1:
            y_lat = fourier_mix(u_lat, fnet_w[j], fnet_b[j])
            y_ctx = None if last else fourier_mix(u_ctx, fnet_w[j], fnet_b[j])
        else:
            cw = (conv_w_pw1[j], conv_b_pw1[j], conv_w_dw[j], conv_b_dw[j],
                  conv_ln_g[j], conv_ln_b[j], conv_w_pw2[j], conv_b_pw2[j])
            y_lat = conformer_conv(u_lat, *cw)
            y_ctx = None if last else conformer_conv(u_ctx, *cw)
        x_lat = layer_norm(DEEPNORM_ALPHA * x_lat + g1 * y_lat, ln1_g[i], ln1_b[i])
        if not last:
            x_ctx = layer_norm(DEEPNORM_ALPHA * x_ctx + cg1 * y_ctx, ln1_g[i], ln1_b[i])

        mw = (moe_w_router[i], moe_b_router[i], moe_w1[i], moe_b1[i], moe_w2[i], moe_b2[i])
        v_lat = (x_lat * (1.0 + sc2) + sh2).reshape(B * N, D)
        if last:
            f_lat = moe(v_lat, *mw).reshape(B, N, D)
        else:
            v_ctx = (x_ctx * (1.0 + cs2) + ch2).reshape(B * C, D)
            f_all = moe(jnp.concatenate([v_lat, v_ctx], axis=0), *mw)
            f_lat = f_all[:B * N].reshape(B, N, D)
            f_ctx = f_all[B * N:].reshape(B, C, D)
            x_ctx = layer_norm(DEEPNORM_ALPHA * x_ctx + cg2 * f_ctx, ln2_g[i], ln2_b[i])
        x_lat = layer_norm(DEEPNORM_ALPHA * x_lat + g2 * f_lat, ln2_g[i], ln2_b[i])

    return x_lat
```

```cpp
#include <hip/hip_runtime.h>
#include <cstdio>
#include <cstdint>

#ifndef MK_MULTI
#define MK_MULTI 0
#endif
#ifndef PH_MASK
#define PH_MASK 0xffffffffu
#endif
#define EN(k) (((PH_MASK) >> (k)) & 1u)
#ifndef REP_MASK
#define REP_MASK 0u
#endif
#ifndef MOE_PROBE
#define MOE_PROBE 0
#endif
#ifndef ATT_GSH
#define ATT_GSH 0
#endif
#ifndef ATT_PROBE
#define ATT_PROBE 0
#endif
#define NREP(k) ((((REP_MASK) >> (k)) & 1u) ? 2 : 1)

#define LAS __attribute__((address_space(3)))
#define GAS __attribute__((address_space(1)))
typedef unsigned short bf16_t;
typedef short bf16x8 __attribute__((ext_vector_type(8)));
typedef short s16x4 __attribute__((ext_vector_type(4)));
typedef float f32x2 __attribute__((ext_vector_type(2)));
typedef float f32x4 __attribute__((ext_vector_type(4)));
typedef float f32x16 __attribute__((ext_vector_type(16)));
typedef unsigned u32x2 __attribute__((ext_vector_type(2)));
typedef unsigned u32x4 __attribute__((ext_vector_type(4)));
typedef int i32x4 __attribute__((ext_vector_type(4)));
typedef int i32x8 __attribute__((ext_vector_type(8)));

constexpr int D = 1024, NB = 8, SEQ = 4096, CTXL = 256, DEPTH = 4;
constexpr int T_LAT = NB * SEQ, T_CTX = NB * CTXL, T_ALL = T_LAT + T_CTX;
constexpr int NE = 32, TOPK = 4, P_MAX = 147456;
constexpr float LN_EPS = 1e-5f;
constexpr float DN_ALPHA = 1.6817928305074290f;
constexpr float ATT_C2 = 0.125f * 1.4426950408889634f;
constexpr int NWAVES = 8, NTHR = 512;
constexpr float H_PRESCALE = 7.5f, FP8_TOP = 440.0f, Q_PRESCALE = 16.0f;
constexpr float MIX_PRESCALE = 1.0f;
constexpr float Y2_PRESCALE = 16.0f;
constexpr float DFT_PRESCALE = 64.0f;
constexpr int VT_PITCH = 4352;

constexpr size_t MiB = 1u << 20;
constexpr size_t WS_CTL = 0, CTL_ZERO_BYTES = 1 * MiB;
constexpr size_t WS_MOD = 1 * MiB;
constexpr size_t WS_ROPE = 2 * MiB;
constexpr size_t WS_ACS = 2 * MiB + 65536;
constexpr size_t WS_DFTN = 4 * MiB;
constexpr size_t WS_WQKV = 72 * MiB;
constexpr size_t WS_WO = 84 * MiB;
constexpr size_t WS_WF = 88 * MiB;
constexpr size_t WS_PW1 = 90 * MiB;
constexpr size_t WS_PW2 = 94 * MiB;
constexpr size_t WS_W1 = 96 * MiB;
constexpr size_t WS_W2 = 608 * MiB;
constexpr size_t WS_X = 864 * MiB;
constexpr size_t WS_X1 = 1000 * MiB;
constexpr size_t WS_U = 1136 * MiB;
constexpr size_t WS_Q = 1204 * MiB, WS_K = 1272 * MiB, WS_V = 1340 * MiB;
constexpr size_t WS_MIX = 1408 * MiB;
constexpr size_t WS_Y = 1476 * MiB;
constexpr size_t WS_V2 = 1544 * MiB;
constexpr size_t WS_G = 1612 * MiB;
constexpr size_t WS_YT = 1680 * MiB;
constexpr size_t WS_YTC = 1808 * MiB;
constexpr size_t WS_H = 1936 * MiB;
constexpr size_t WS_Y2 = 2224 * MiB;
constexpr size_t WS_TOPK = 2512 * MiB;
constexpr size_t WS_GATE = 2513 * MiB;
constexpr size_t WS_POS = 2514 * MiB;
constexpr size_t WS_ROWTOK = 2515 * MiB;
constexpr size_t WS_ASCR = 2516 * MiB;
constexpr size_t WS_W1S = 2548 * MiB;
constexpr size_t WS_V2S = 2549 * MiB;
constexpr size_t WS_W2S = 2550 * MiB;
constexpr size_t WS_WQKVS = 2551 * MiB;
constexpr size_t WS_PW1S = 2551 * MiB + 65536;
constexpr size_t WS_WZS = 2551 * MiB + 131072;
constexpr size_t WS_SAP = 2552 * MiB;
constexpr size_t WS_END = 2553 * MiB;
constexpr int CW_TMO = 0, CW_BAR = 4096, CW_CNT = 16384, CW_CUR = 16384 + 1024;

constexpr int LDS_BYTES = 147456;
constexpr int RING_BYTES = 131072;
constexpr int MISC_OFF = LDS_BYTES - 2048;

#define RLX_AGENT __ATOMIC_RELAXED, __HIP_MEMORY_SCOPE_AGENT
#define LDS_WAIT() asm volatile("s_waitcnt lgkmcnt(0)" ::: "memory")
#define VM_WAIT() asm volatile("s_waitcnt vmcnt(0)" ::: "memory")
__device__ __forceinline__ unsigned cvt_pk_bf16(float lo, float hi) { unsigned r; asm volatile("v_cvt_pk_bf16_f32 %0, %1, %2" : "=v"(r) : "v"(lo), "v"(hi)); return r; }
__device__ __forceinline__ float bf_lo(unsigned w) { return __uint_as_float(w << 16); }
__device__ __forceinline__ float bf_hi(unsigned w) { return __uint_as_float(w & 0xffff0000u); }
template <int M> __device__ __forceinline__ float sx(float v) { return __int_as_float(__builtin_amdgcn_ds_swizzle(__float_as_int(v), 0x1f | (M << 10))); }
__device__ __forceinline__ float sum32x(float v) { auto rr = __builtin_amdgcn_permlane32_swap(__float_as_uint(v), __float_as_uint(v), false, false); return __uint_as_float(rr[0]) + __uint_as_float(rr[1]); }
__device__ __forceinline__ float wave_max(float v) { v = fmaxf(v, sx<1>(v)); v = fmaxf(v, sx<2>(v)); v = fmaxf(v, sx<4>(v)); v = fmaxf(v, sx<8>(v)); v = fmaxf(v, sx<16>(v));
    auto rr = __builtin_amdgcn_permlane32_swap(__float_as_uint(v), __float_as_uint(v), false, false); return fmaxf(__uint_as_float(rr[0]), __uint_as_float(rr[1])); }
__device__ __forceinline__ unsigned pack_i8x4(float a, float b, float c, float d) {
    int hi_ = 127, lo_ = -127; asm volatile("" : "+s"(hi_), "+s"(lo_));
    const int ia = max(lo_, min(hi_, __float2int_rn(a))), ib = max(lo_, min(hi_, __float2int_rn(b))), ic = max(lo_, min(hi_, __float2int_rn(c))), id = max(lo_, min(hi_, __float2int_rn(d)));
    return (unsigned)(ia & 255) | ((unsigned)(ib & 255) << 8) | ((unsigned)(ic & 255) << 16) | ((unsigned)id << 24); }
__device__ __forceinline__ unsigned pack_fp8x4(float a, float b, float c, float d) { int w = 0; w = __builtin_amdgcn_cvt_pk_fp8_f32(a, b, w, false); w = __builtin_amdgcn_cvt_pk_fp8_f32(c, d, w, true); return (unsigned)w; }
__device__ __forceinline__ float wave_sum(float v) { v += sx<1>(v); v += sx<2>(v); v += sx<4>(v); v += sx<8>(v); v += sx<16>(v); return sum32x(v); }
__device__ __forceinline__ float ln_eps() { float e = LN_EPS; asm volatile("" : "+s"(e)); return e; }
__device__ __forceinline__ int hidden_tid(int wave) { int l; asm volatile("v_mbcnt_lo_u32_b32 %0, -1, 0\n\tv_mbcnt_hi_u32_b32 %0, -1, %0" : "=v"(l)); return wave * 64 + l; }
__device__ __forceinline__ float fast_sigmoid(float x) { return __builtin_amdgcn_rcpf(1.0f + __builtin_amdgcn_exp2f(-1.4426950408889634f * x)); }

#define XB_TMO      128
#define XB_XCNT(j)  (256  + 64 * (j))
#define XB_XSUB(j)  (1280 + 64 * (j))
#define XB_XGEN(j)  (2304 + 64 * (j))
#define XB_TOP      3328
#define XB_TOPGEN   3392
#define XCD_BAR_WORDS 3456
#define XB_SPIN_CAP (1u << 18)
__device__ __forceinline__ unsigned xb_ld(unsigned* p)              { return __hip_atomic_load(p, __ATOMIC_RELAXED, __HIP_MEMORY_SCOPE_AGENT); }
__device__ __forceinline__ unsigned xb_add(unsigned* p, unsigned v) { return __hip_atomic_fetch_add(p, v, __ATOMIC_RELAXED, __HIP_MEMORY_SCOPE_AGENT); }
__device__ __forceinline__ unsigned xb_xcc_id() { return (unsigned)__builtin_amdgcn_s_getreg((3 << 11) | 20) & 0xFu; }
#define XB_SPIN(cond, bar) do { unsigned _sp = 0; while (cond) { __builtin_amdgcn_s_sleep(1); \
    if ((++_sp & 255u) == 0u) { if (xb_ld(&(bar)[XB_TMO])) break; if (_sp > XB_SPIN_CAP) { atomicAdd(&(bar)[XB_TMO], 1u); break; } } } } while (0)
struct XcdBarrier { unsigned* bar; unsigned x; volatile LAS unsigned* st; };
__device__ __forceinline__ XcdBarrier xcd_barrier_post(unsigned* bar, volatile LAS unsigned* st) {
    XcdBarrier b; b.bar = bar; b.x = xb_xcc_id(); b.st = st;
    if (threadIdx.x == 0) (void)xb_add(&bar[XB_XCNT(b.x)], 1u);
    return b;
}
__device__ __forceinline__ void xcd_barrier_complete(unsigned* bar, unsigned x, unsigned& nloc, unsigned& nx) {
    const unsigned G = gridDim.x * gridDim.y * gridDim.z;
    unsigned sum, cnt, mine, sp = 0u;
    for (;;) {
        sum = 0u; cnt = 0u; mine = 0u;
#pragma unroll
        for (unsigned j = 0; j < 16; ++j) { const unsigned c = xb_ld(&bar[XB_XCNT(j)]); sum += c; cnt += (c > 0u) ? 1u : 0u; mine = (j == x) ? c : mine; }
        if (sum == G) break;
        __builtin_amdgcn_s_sleep(1);
        if ((++sp & 255u) == 0u) { if (xb_ld(&bar[XB_TMO])) break; if (sp > XB_SPIN_CAP) { atomicAdd(&bar[XB_TMO], 1u); break; } }
    }
    nloc = mine > 0u ? mine : 1u; nx = cnt > 0u ? cnt : 1u;
}
__device__ __forceinline__ void xcd_barrier(const XcdBarrier& b, int wave_) {
    asm volatile("s_waitcnt vmcnt(0)" ::: "memory");
    __syncthreads();
    if (hidden_tid(wave_) == 0) {
        unsigned* bar = b.bar;
        __builtin_amdgcn_s_waitcnt(0);
        unsigned nloc = b.st[0], nx = b.st[1];
        if (nloc == 0u) { xcd_barrier_complete(bar, b.x, nloc, nx); b.st[0] = nloc; b.st[1] = nx; }
        const unsigned old = xb_add(&bar[XB_XSUB(b.x)], 1u);
        const unsigned gen = old / nloc;
        if (old + 1u == (gen + 1u) * nloc) {
            __builtin_amdgcn_fence(__ATOMIC_RELEASE, "agent");
            asm volatile("s_waitcnt vmcnt(0)" ::: "memory");
            const unsigned og = xb_add(&bar[XB_TOP], 1u);
            const unsigned tg = og / nx;
            if (og + 1u == (tg + 1u) * nx) xb_add(&bar[XB_TOPGEN], 1u);
            else XB_SPIN(xb_ld(&bar[XB_TOPGEN]) == tg, bar);
            __builtin_amdgcn_fence(__ATOMIC_ACQUIRE, "agent");
            xb_add(&bar[XB_XGEN(b.x)], 1u);
            asm volatile("s_waitcnt vmcnt(0)" ::: "memory");
        } else {
            XB_SPIN(xb_ld(&bar[XB_XGEN(b.x)]) == gen, bar);
            __builtin_amdgcn_fence(__ATOMIC_ACQUIRE, "agent");
            asm volatile("s_waitcnt vmcnt(0)" ::: "memory");
        }
    }
    __syncthreads();
}

namespace g8 {
constexpr int BM = 256, BK = 64, HALF = 128, HTB = HALF * BK * 2, NXCD = 8, WGM = 8, PF_OFF = 8 * HTB, PF_BLK = 3072;
__host__ __device__ __forceinline__ int lds_byte(int r, int c) { const int st = (r >> 4) * 2 + (c >> 5), rr = r & 15, cc = c & 31, ob = rr * 64 + cc * 2; return st * 1024 + (ob ^ (((ob >> 9) & 1) << 5)); }
__host__ __device__ __forceinline__ void stage_rc(int b, int& R, int& C) { const int st = b / 1024, sb = b % 1024, swz = sb ^ (((sb >> 9) & 1) << 5); R = (st >> 1) * 16 + swz / 64; C = (st & 1) * 32 + (swz % 64) / 2; }
__host__ __device__ __forceinline__ int perm32(int rho) { const int n = rho >> 4, i = rho & 15; return 8 * (i >> 2) + 4 * n + (i & 3); }

struct GU { unsigned a, b, ooff; int row0, col0, aux; };

struct DenseOrder {
    int nM, nN, nwg, G, c;
    __device__ __forceinline__ void init(int M, int N, int G_, int c_) { nM = M / BM; nN = N / BM; nwg = nM * nN; G = G_; c = c_; }
    __device__ __forceinline__ bool tile(int i, int& pm, int& pn) const {
        const long L = (long)i * G + c; if (L >= nwg) return false;
        int wgid = (int)L; { const int q = nwg / NXCD, r = nwg % NXCD, xcd = wgid % NXCD, off = wgid / NXCD; wgid = (xcd < r ? xcd * (q + 1) : r * (q + 1) + (xcd - r) * q) + off; }
        const int nig = WGM * nN, gid = wgid / nig, fm = gid * WGM, gsz = (nM - fm) < WGM ? (nM - fm) : WGM;
        pm = fm + ((wgid % nig) % gsz); pn = (wgid % nig) / gsz; return true;
    }
};

template <int MODE> struct Mma;
template <> struct Mma<0> { typedef f32x4 acc_t; static __device__ __forceinline__ f32x4 run(const bf16x8 (&a)[2], const bf16x8 (&b)[2], f32x4 c, int) {
    c = __builtin_amdgcn_mfma_f32_16x16x32_bf16(a[0], b[0], c, 0, 0, 0); return __builtin_amdgcn_mfma_f32_16x16x32_bf16(a[1], b[1], c, 0, 0, 0); } };
template <> struct Mma<1> { typedef i32x4 acc_t; static __device__ __forceinline__ i32x4 run(const bf16x8 (&a)[2], const bf16x8 (&b)[2], i32x4 c, int) {
    c = __builtin_amdgcn_mfma_i32_16x16x64_i8(__builtin_bit_cast(i32x4, a[0]), __builtin_bit_cast(i32x4, b[0]), c, 0, 0, 0); return __builtin_amdgcn_mfma_i32_16x16x64_i8(__builtin_bit_cast(i32x4, a[1]), __builtin_bit_cast(i32x4, b[1]), c, 0, 0, 0); } };
template <> struct Mma<2> { typedef f32x4 acc_t; static __device__ __forceinline__ f32x4 run(const bf16x8 (&a)[2], const bf16x8 (&b)[2], f32x4 c, int sc1) {
    const i32x4 a0 = __builtin_bit_cast(i32x4, a[0]), a1 = __builtin_bit_cast(i32x4, a[1]), b0 = __builtin_bit_cast(i32x4, b[0]), b1 = __builtin_bit_cast(i32x4, b[1]);
    const i32x8 av = (i32x8){a0[0], a0[1], a0[2], a0[3], a1[0], a1[1], a1[2], a1[3]}, bv = (i32x8){b0[0], b0[1], b0[2], b0[3], b1[0], b1[1], b1[2], b1[3]};
    return __builtin_amdgcn_mfma_scale_f32_16x16x128_f8f6f4(av, bv, c, 0, 0, 0, sc1, 0, sc1); } };
template <class Epi, class Sched, int PROBE = 0>
__device__ __forceinline__ void gemm_phase(LAS unsigned char* lds, const Sched& S, const Epi& E, int wave_) {
    typedef typename Mma<Epi::MODE>::acc_t acc_t;
    int mxs = 0x7f7f7f7f; asm volatile("" : "+v"(mxs));
    constexpr bool GATHER = Sched::GATHER;
    const int tid = hidden_tid(wave_), wid = wave_, lane = tid & 63, wr = wid >> 2, wc = wid & 3, fr = lane & 15, fq = lane >> 4;
    unsigned voffA[2], voffB[2]; int RA[2];
#pragma unroll
    for (int i = 0; i < 2; ++i) { int R, C; stage_rc(tid * 16 + i * 8192, R, C); const int Rb = Epi::PERM ? ((R & ~31) + perm32(R & 31)) : R;
        voffA[i] = (GATHER ? 0u : (unsigned)R * S.lda) + (unsigned)C * 2u; voffB[i] = (unsigned)Rb * S.ldb + (unsigned)C * 2u; RA[i] = R; }
    constexpr unsigned kstep = (unsigned)(BK * 2);
    const unsigned hsA = GATHER ? 0u : S.hstepA, hsB = S.hstepB;
    const unsigned ldsw = (unsigned)wid * 1024u;
    const unsigned ldsb = (unsigned)(unsigned long)lds + ldsw;
    const int aoff = lds_byte(wr * 64 + fr, fq * 8), boff = lds_byte(wc * 32 + fr, fq * 8);
    const char* const Ab = S.A; const char* const Bb = S.Bt;
#define G8_SA(b, h) (((b) * 2 + (h)) * HTB)
#define G8_SB(b, h) ((4 + (b) * 2 + (h)) * HTB)
#define G8_STAGE(bufoff, gbase, soff, voff) do { const char* gp_ = (gbase) + (size_t)(soff); _Pragma("unroll") for (int _i = 0; _i < 2; ++_i) { unsigned keep_ = 0; \
        asm volatile("s_mov_b32 m0, %2\n\ts_nop 4\n\tglobal_load_lds_dwordx4 %0, %1" :: "v"((voff)[_i]), "s"(gp_), "s"(ldsb + (unsigned)((bufoff) + _i * 8192)) : "memory"); (void)keep_; } } while (0)
#define G8_LDA(dst, b, h) do { _Pragma("unroll") for (int m = 0; m < 4; ++m) _Pragma("unroll") for (int k = 0; k < 2; ++k) dst[m][k] = *(const LAS bf16x8*)(lds + G8_SA(b, h) + aoff + m * 2048 + k * 1024); } while (0)
#define G8_LDB(dst, b, h) do { _Pragma("unroll") for (int n = 0; n < 2; ++n) _Pragma("unroll") for (int k = 0; k < 2; ++k) dst[n][k] = *(const LAS bf16x8*)(lds + G8_SB(b, h) + boff + n * 2048 + k * 1024); } while (0)
#define G8_MMA(ai, bj, At, Bt) do { __builtin_amdgcn_s_setprio(1); _Pragma("unroll") for (int m = 0; m < 4; ++m) _Pragma("unroll") for (int n = 0; n < 2; ++n) { \
        if (PROBE & 2) { asm volatile("" :: "v"(Bt[n][0]), "v"(Bt[n][1]), "v"(At[m][0]), "v"(At[m][1])); } else acc[ai][bj][m][n] = Mma<Epi::MODE>::run(Bt[n], At[m], acc[ai][bj][m][n], mxs); } __builtin_amdgcn_s_setprio(0); } while (0)
#define G8_WAIT_V(n) asm volatile("s_waitcnt vmcnt(" #n ")" ::: "memory")
#define G8_WAIT_L(n) asm volatile("s_waitcnt lgkmcnt(" #n ")" ::: "memory")
#define G8_BAR __builtin_amdgcn_s_barrier()
#define G8_SCHED __builtin_amdgcn_sched_barrier(0)
    GU cur, nxt; int ui = 0;
    if (!S.next(0, cur)) return;
    acc_t acc[2][2][4][2];
#pragma unroll
    for (int a = 0; a < 2; ++a)
#pragma unroll
        for (int b = 0; b < 2; ++b)
#pragma unroll
            for (int m = 0; m < 4; ++m)
#pragma unroll
                for (int n = 0; n < 2; ++n) {
                    if constexpr (Epi::MODE == 0) acc[a][b][m][n] = (acc_t){0, 0, 0, 0};
                    else {
#pragma unroll
                        for (int j = 0; j < 4; ++j) { decltype(acc[a][b][m][n][j] + acc[a][b][m][n][j]) zv; asm volatile("v_mov_b32 %0, 0" : "=v"(zv)); acc[a][b][m][n][j] = zv; } } }
    bf16x8 At[4][2], B0[2][2], B1[2][2];
    unsigned cA = cur.a, cB = cur.b;
    unsigned c0[2], c1[2], n0[2], n1[2];
    if constexpr (GATHER) {
#pragma unroll
        for (int i = 0; i < 2; ++i) { const int r0 = S.rowtok[cur.row0 + RA[i]], r1 = S.rowtok[cur.row0 + HALF + RA[i]];
            c0[i] = (unsigned)r0 * S.lda + voffA[i]; c1[i] = (unsigned)r1 * S.lda + voffA[i]; n0[i] = c0[i]; n1[i] = c1[i]; }
    } else {
#pragma unroll
        for (int i = 0; i < 2; ++i) { c0[i] = voffA[i]; c1[i] = voffA[i]; n0[i] = voffA[i]; n1[i] = voffA[i]; }
    }
    G8_STAGE(G8_SB(0, 0), Bb, cB, voffB); G8_STAGE(G8_SB(0, 1), Bb, cB + hsB, voffB); G8_STAGE(G8_SA(0, 0), Ab, cA, c0); G8_STAGE(G8_SA(0, 1), Ab, cA + hsA, c1);
    if (wr == 1) G8_BAR;
    G8_WAIT_V(2); G8_BAR;
    G8_STAGE(G8_SB(1, 0), Bb, cB + kstep, voffB); G8_STAGE(G8_SA(1, 0), Ab, cA + kstep, c0); G8_STAGE(G8_SB(1, 1), Bb, cB + hsB + kstep, voffB);
    G8_WAIT_V(6); G8_BAR;
    for (;;) {
        const bool has_next = S.next(ui + 1, nxt);
        const unsigned nA = has_next ? nxt.a : cA, nB = has_next ? nxt.b : cB;
        const int nt = Sched::VAR_NT ? cur.aux : S.nt;
        if constexpr (Epi::PF) E.prefetch(cur, wave_, (unsigned)(unsigned long)lds + (unsigned)(PF_OFF + (ui & 1) * PF_BLK));
        for (int t = 0; t < nt; t += 2) {
            const bool last = (t == nt - 2);
            const unsigned a1 = cA + (unsigned)(t + 1) * kstep;
            const unsigned a2 = last ? nA : cA + (unsigned)(t + 2) * kstep, b2 = last ? nB : cB + (unsigned)(t + 2) * kstep;
            const unsigned a3 = a2 + kstep, b3 = b2 + kstep;
            unsigned s0[2], s1[2];
            if constexpr (GATHER) {
                if (last && has_next) {
#pragma unroll
                    for (int i = 0; i < 2; ++i) { const int r0 = S.rowtok[nxt.row0 + RA[i]], r1 = S.rowtok[nxt.row0 + HALF + RA[i]];
                        n0[i] = (unsigned)r0 * S.lda + voffA[i]; n1[i] = (unsigned)r1 * S.lda + voffA[i]; }
                }
#pragma unroll
                for (int i = 0; i < 2; ++i) { s0[i] = last ? n0[i] : c0[i]; s1[i] = last ? n1[i] : c1[i]; }
            } else {
#pragma unroll
                for (int i = 0; i < 2; ++i) { s0[i] = voffA[i]; s1[i] = voffA[i]; }
            }
            G8_LDB(B0, 0, 0); G8_LDB(B1, 0, 1); G8_SCHED; G8_LDA(At, 0, 0);
            G8_STAGE(G8_SA(1, 1), Ab, a1 + hsA, c1);
            G8_WAIT_V(8); G8_WAIT_L(0); G8_BAR; G8_MMA(0, 0, At, B0); G8_MMA(0, 1, At, B1); G8_BAR; G8_SCHED;
            G8_LDA(At, 0, 1); G8_STAGE(G8_SB(0, 0), Bb, b2, voffB); G8_STAGE(G8_SB(0, 1), Bb, b2 + hsB, voffB); G8_STAGE(G8_SA(0, 0), Ab, a2, s0);
            G8_WAIT_V(8); G8_WAIT_L(0); G8_BAR; G8_MMA(1, 0, At, B0); G8_MMA(1, 1, At, B1); G8_BAR; G8_SCHED;
            G8_LDB(B0, 1, 0); G8_LDB(B1, 1, 1); G8_SCHED; G8_LDA(At, 1, 0); G8_STAGE(G8_SA(0, 1), Ab, a2 + hsA, s1);
            G8_WAIT_V(8); G8_WAIT_L(0); G8_BAR; G8_MMA(0, 0, At, B0); G8_MMA(0, 1, At, B1); G8_BAR; G8_SCHED;
            G8_LDA(At, 1, 1); G8_STAGE(G8_SB(1, 0), Bb, b3, voffB); G8_STAGE(G8_SB(1, 1), Bb, b3 + hsB, voffB); G8_STAGE(G8_SA(1, 0), Ab, a3, s0);
            G8_WAIT_V(8); G8_WAIT_L(0); G8_BAR; G8_MMA(1, 0, At, B0); G8_MMA(1, 1, At, B1); G8_BAR; G8_SCHED;
        }
        if (wr == 0) G8_BAR;
        if (!(PROBE & 1)) E(acc, cur, wave_, lds + (Epi::PF ? (ui & 1) * PF_BLK : 0));
        if (!has_next) break;
#pragma unroll
        for (int a = 0; a < 2; ++a)
#pragma unroll
            for (int b = 0; b < 2; ++b)
#pragma unroll
                for (int m = 0; m < 4; ++m)
#pragma unroll
                    for (int n = 0; n < 2; ++n) {
                        if constexpr (Epi::MODE == 0) acc[a][b][m][n] = (acc_t){0, 0, 0, 0};
                        else {
#pragma unroll
                            for (int j = 0; j < 4; ++j) { decltype(acc[a][b][m][n][j] + acc[a][b][m][n][j]) zv; asm volatile("v_mov_b32 %0, 0" : "=v"(zv)); acc[a][b][m][n][j] = zv; } } }
        cur = nxt; cA = nA; cB = nB; ++ui;
        if constexpr (GATHER) {
#pragma unroll
            for (int i = 0; i < 2; ++i) { c0[i] = n0[i]; c1[i] = n1[i]; }
        }
        if (wr == 1) G8_BAR;
    }
    G8_WAIT_V(0);
    G8_BAR;
#undef G8_SA
#undef G8_SB
#undef G8_STAGE
#undef G8_LDA
#undef G8_LDB
#undef G8_MMA
#undef G8_WAIT_V
#undef G8_WAIT_L
#undef G8_BAR
#undef G8_SCHED
}
}

using g8::GU;
#define EPI_LANE_IDS() const int tz_ = hidden_tid(wave_); const int wid_ = wave_, lane_ = tz_ & 63, wr = wid_ >> 2, wc = wid_ & 3, fr = lane_ & 15, fq = lane_ >> 4
template <int MODE_ = 0> struct EpiBf16T {          static constexpr int MODE = MODE_; static constexpr bool PF = false;
    static constexpr bool PERM = true;
    bf16_t* O; int ldc; const float* bias; int bstride; const float* scale; float smul;
    __device__ __forceinline__ void operator()(const f32x4 (&acc)[2][2][4][2], const GU& u, int wave_, LAS unsigned char* lds_) const {
        EPI_LANE_IDS();
        const int cl = wc * 32 + 8 * fq;
        bf16_t* Ob = O + u.ooff;
#pragma unroll
        for (int bj = 0; bj < 2; ++bj) {
            f32x4 bv[2], sv[2];
#pragma unroll
            for (int n = 0; n < 2; ++n) { bv[n] = bias ? *(const f32x4*)(bias + (size_t)u.aux * bstride + u.col0 + cl + bj * 128 + 4 * n) : (f32x4){0.f, 0.f, 0.f, 0.f};
                sv[n] = scale ? *(const f32x4*)(scale + (size_t)u.aux * bstride + u.col0 + cl + bj * 128 + 4 * n) * smul : (f32x4){smul, smul, smul, smul}; }
#pragma unroll
            for (int ai = 0; ai < 2; ++ai)
#pragma unroll
                for (int m = 0; m < 4; ++m) { bf16_t* rowp = Ob + (unsigned)((ai * 128 + wr * 64 + m * 16 + fr) * ldc + cl) + bj * 128;
                    const f32x4 v0 = acc[ai][bj][m][0] * sv[0] + bv[0], v1 = acc[ai][bj][m][1] * sv[1] + bv[1];
                    u32x4 w; w.x = cvt_pk_bf16(v0[0], v0[1]); w.y = cvt_pk_bf16(v0[2], v0[3]); w.z = cvt_pk_bf16(v1[0], v1[1]); w.w = cvt_pk_bf16(v1[2], v1[3]);
                    *(u32x4*)rowp = w; }
        }
    }
};
typedef EpiBf16T<0> EpiBf16;
struct EpiGlu8 { static constexpr bool PF = false;
    static constexpr bool PERM = true; static constexpr int MODE = 2;
    bf16_t* O; int ldc; const float* bias; const float* sw; int half;
    __device__ __forceinline__ void operator()(const f32x4 (&acc)[2][2][4][2], const GU& u, int wave_, LAS unsigned char* lds_) const {
        EPI_LANE_IDS();
        const int cl = wc * 32 + 8 * fq;
        f32x4 bv[2][2], sv[2][2];
#pragma unroll
        for (int bj = 0; bj < 2; ++bj)
#pragma unroll
            for (int n = 0; n < 2; ++n) { bv[bj][n] = *(const f32x4*)(bias + u.col0 + cl + bj * half + 4 * n); sv[bj][n] = *(const f32x4*)(sw + u.col0 + cl + bj * half + 4 * n); }
        bf16_t* Ob = O + u.ooff;
#pragma unroll
        for (int ai = 0; ai < 2; ++ai)
#pragma unroll
            for (int m = 0; m < 4; ++m) { bf16_t* rowp = Ob + (unsigned)((ai * 128 + wr * 64 + m * 16 + fr) * ldc + cl);
                float o[8];
#pragma unroll
                for (int n = 0; n < 2; ++n) { const f32x4 a = acc[ai][0][m][n] * sv[0][n] + bv[0][n], g = acc[ai][1][m][n] * sv[1][n] + bv[1][n];
#pragma unroll
                    for (int j = 0; j < 4; ++j) o[4 * n + j] = a[j] * fast_sigmoid(g[j]); }
                u32x4 w; w.x = cvt_pk_bf16(o[0], o[1]); w.y = cvt_pk_bf16(o[2], o[3]); w.z = cvt_pk_bf16(o[4], o[5]); w.w = cvt_pk_bf16(o[6], o[7]);
                *(u32x4*)rowp = w; }
    }
};
#define EPI_DMA16(gptr, ldsaddr) asm volatile("s_mov_b32 m0, %1\n\ts_nop 4\n\tglobal_load_lds_dwordx4 %0, off" :: "v"(gptr), "s"(ldsaddr) : "memory")
struct EpiY2 { static constexpr bool PF = true;
    static constexpr bool PERM = true; static constexpr int MODE = 2;
    unsigned char* O; const float* bias; const float* scale;
    __device__ __forceinline__ void prefetch(const GU& u, int wave_, unsigned ldsaddr) const {
        const int l_ = hidden_tid(wave_) & 63;
        if (wave_ == 0) { const float* p = bias + (size_t)u.aux * 1024 + u.col0 + 4 * l_; EPI_DMA16(p, ldsaddr); }
        else if (wave_ == 1) { const float* p = scale + (size_t)u.aux * 1024 + u.col0 + 4 * l_; EPI_DMA16(p, ldsaddr + 1024u); }
    }
    __device__ __forceinline__ void operator()(const f32x4 (&acc)[2][2][4][2], const GU& u, int wave_, LAS unsigned char* lds_) const {
        EPI_LANE_IDS();
        const int cl = wc * 32 + 8 * fq;
        unsigned char* Ob = O + u.ooff; const LAS float* pf = (const LAS float*)(lds_ + g8::PF_OFF);
#pragma unroll
        for (int bj = 0; bj < 2; ++bj) {
            f32x4 bv[2], sv[2];
#pragma unroll
            for (int n = 0; n < 2; ++n) { bv[n] = *(const LAS f32x4*)(pf + cl + bj * 128 + 4 * n) * Y2_PRESCALE;
                sv[n] = *(const LAS f32x4*)(pf + 256 + cl + bj * 128 + 4 * n) * (Y2_PRESCALE / H_PRESCALE); }
#pragma unroll
            for (int ai = 0; ai < 2; ++ai)
#pragma unroll
                for (int m = 0; m < 4; m += 2) {
                    const f32x4 a0 = acc[ai][bj][m][0] * sv[0] + bv[0], a1 = acc[ai][bj][m][1] * sv[1] + bv[1], b0 = acc[ai][bj][m + 1][0] * sv[0] + bv[0], b1 = acc[ai][bj][m + 1][1] * sv[1] + bv[1];
                    const unsigned pa0 = pack_fp8x4(a0[0], a0[1], a0[2], a0[3]), pa1 = pack_fp8x4(a1[0], a1[1], a1[2], a1[3]), pb0 = pack_fp8x4(b0[0], b0[1], b0[2], b0[3]), pb1 = pack_fp8x4(b1[0], b1[1], b1[2], b1[3]);
                    const bool odd = (fq & 1) != 0;
                    const unsigned k0 = odd ? pb0 : pa0, k1 = odd ? pb1 : pa1, s0 = odd ? pa0 : pb0, s1 = odd ? pa1 : pb1;
                    const unsigned r0 = __float_as_uint(sx<16>(__uint_as_float(s0))), r1 = __float_as_uint(sx<16>(__uint_as_float(s1)));
                    const u32x4 w = odd ? (u32x4){r0, r1, k0, k1} : (u32x4){k0, k1, r0, r1};
                    unsigned char* rowp = Ob + (unsigned)((ai * 128 + wr * 64 + (m + (odd ? 1 : 0)) * 16 + fr) * 1024 + (cl - (odd ? 8 : 0))) + bj * 128;
                    *(u32x4*)rowp = w; }
        }
    }
};
template <int MODE_ = 0> struct EpiFp8T { static constexpr bool PF = false;
    static constexpr bool PERM = true; static constexpr int MODE = MODE_;
    unsigned char* O; int ldc; float smul;
    __device__ __forceinline__ void operator()(const f32x4 (&acc)[2][2][4][2], const GU& u, int wave_, LAS unsigned char* lds_) const {
        EPI_LANE_IDS();
        const int cl = wc * 32 + 8 * fq;
        unsigned char* Ob = O + u.ooff;
#pragma unroll
        for (int ai = 0; ai < 2; ++ai)
#pragma unroll
            for (int m = 0; m < 4; ++m) { unsigned char* rowp = Ob + (unsigned)((ai * 128 + wr * 64 + m * 16 + fr) * ldc + cl);
#pragma unroll
                for (int bj = 0; bj < 2; ++bj) { const f32x4 v0 = acc[ai][bj][m][0] * smul, v1 = acc[ai][bj][m][1] * smul;
                    *(u32x2*)(rowp + bj * 128) = (u32x2){pack_fp8x4(v0[0], v0[1], v0[2], v0[3]), pack_fp8x4(v1[0], v1[1], v1[2], v1[3])}; } }
    }
};
template <int PV = 0> struct EpiGatedI8T { static constexpr bool PF = true;
    static constexpr bool PERM = true; static constexpr int MODE = 1;
    unsigned char* O; const float* bias; const float* sw; const float* sap;
    __device__ __forceinline__ void prefetch(const GU& u, int wave_, unsigned ldsaddr) const {
        const int l_ = hidden_tid(wave_) & 63;
        if (wave_ == 0) { const float* p = bias + (size_t)u.aux * 2048 + u.col0 + (l_ >> 5) * 1024 + 4 * (l_ & 31); EPI_DMA16(p, ldsaddr); }
        else if (wave_ == 1) { const float* p = sw + (size_t)u.aux * 2048 + u.col0 + (l_ >> 5) * 1024 + 4 * (l_ & 31); EPI_DMA16(p, ldsaddr + 1024u); }
        else if (wave_ == 2) { const float* p = sap + u.row0 + 4 * l_; EPI_DMA16(p, ldsaddr + 2048u); }
    }
    __device__ __forceinline__ void operator()(const i32x4 (&acc)[2][2][4][2], const GU& u, int wave_, LAS unsigned char* lds_) const {
        EPI_LANE_IDS();
        const int cl = wc * 32 + 8 * fq; const LAS float* pf = (const LAS float*)(lds_ + g8::PF_OFF);
        f32x4 bv[2][2], sv[2][2]; float sr[2][4];
#pragma unroll
        for (int bj = 0; bj < 2; ++bj)
#pragma unroll
            for (int n = 0; n < 2; ++n) { if (PV & 1) { bv[bj][n] = (f32x4){0.f, 0.f, 0.f, 0.f}; sv[bj][n] = (f32x4){1.f, 1.f, 1.f, 1.f}; } else { bv[bj][n] = *(const LAS f32x4*)(pf + bj * 128 + cl + 4 * n); sv[bj][n] = *(const LAS f32x4*)(pf + 256 + bj * 128 + cl + 4 * n); } }
#pragma unroll
        for (int ai = 0; ai < 2; ++ai)
#pragma unroll
            for (int m = 0; m < 4; ++m) sr[ai][m] = (PV & 1) ? 1.0f : pf[512 + ai * 128 + wr * 64 + m * 16 + fr];
        unsigned char* Ob = O + u.ooff;
        float C_SIG = -1.702f * 1.4426950408889634f, K2 = H_PRESCALE / (-1.702f * 1.4426950408889634f), c7s = 7.0f * (-1.702f * 1.4426950408889634f), glo = -6.0f * (H_PRESCALE / (-1.702f * 1.4426950408889634f)), ghi = 8.0f * (H_PRESCALE / (-1.702f * 1.4426950408889634f));
        asm volatile("" : "+s"(C_SIG), "+s"(K2), "+s"(c7s), "+s"(glo), "+s"(ghi));
        if (!(PV & 1)) {
#pragma unroll
            for (int n = 0; n < 2; ++n) { sv[0][n] = sv[0][n] * C_SIG; bv[0][n] = bv[0][n] * C_SIG; sv[1][n] = sv[1][n] * K2; bv[1][n] = bv[1][n] * K2 + K2; } }
#pragma unroll
        for (int ai = 0; ai < 2; ++ai)
#pragma unroll
            for (int m = 0; m < 4; ++m) { const int rl = ai * 128 + wr * 64 + m * 16 + fr; const float srow = sr[ai][m];
                unsigned char* rowp = Ob + (unsigned)(rl * 1024 + cl);
                float o[8];
#pragma unroll
                for (int n = 0; n < 2; ++n) {
#pragma unroll
                    for (int j = 0; j < 4; ++j) { const float a = ((float)acc[ai][0][m][n][j] * sv[0][n][j]) * srow + bv[0][n][j], g = ((float)acc[ai][1][m][n][j] * sv[1][n][j]) * srow + bv[1][n][j];
                        if (PV & 4) { o[4 * n + j] = a + g; } else {
                        const float gl = fmaxf(a, c7s), li = __builtin_amdgcn_fmed3f(g, glo, ghi);
                        const float sg = __builtin_amdgcn_rcpf(1.0f + __builtin_amdgcn_exp2f(gl));
                        o[4 * n + j] = (gl * sg) * li; } } }
                int w0 = 0, w1 = 0; w0 = __builtin_amdgcn_cvt_pk_fp8_f32(o[0], o[1], w0, false); w0 = __builtin_amdgcn_cvt_pk_fp8_f32(o[2], o[3], w0, true);
                w1 = __builtin_amdgcn_cvt_pk_fp8_f32(o[4], o[5], w1, false); w1 = __builtin_amdgcn_cvt_pk_fp8_f32(o[6], o[7], w1, true);
                if (PV & 2) { asm volatile("" :: "v"(w0), "v"(w1)); } else *(u32x2*)rowp = (u32x2){(unsigned)w0, (unsigned)w1}; }
    }
};
typedef EpiGatedI8T<0> EpiGatedI8;
struct EpiQK8 { static constexpr bool PF = false;
    static constexpr bool PERM = false; static constexpr int MODE = 2;
    unsigned char* Q; const float* rope; const float* sw;
    __device__ __forceinline__ void operator()(const f32x4 (&acc)[2][2][4][2], const GU& u, int wave_, LAS unsigned char* lds_) const {
        EPI_LANE_IDS();
        const int which = u.col0 >> 10, colw = u.col0 & 1023;
        unsigned char* base = Q + (size_t)which * (WS_K - WS_Q);
        const bool dorope = u.row0 < T_LAT;
        const float sc = which == 0 ? ATT_C2 * Q_PRESCALE : 1.0f;
#pragma unroll
        for (int bj = 0; bj < 2; ++bj) {
            const f32x4 s1 = *(const f32x4*)(sw + u.col0 + bj * 128 + wc * 32 + 4 * fq) * sc, s2 = *(const f32x4*)(sw + u.col0 + bj * 128 + wc * 32 + 16 + 4 * fq) * sc;
#pragma unroll
            for (int ai = 0; ai < 2; ++ai)
#pragma unroll
                for (int m = 0; m < 4; ++m) { const int row = u.row0 + ai * 128 + wr * 64 + m * 16 + fr;
                    float one_ = 1.0f; asm volatile("" : "+s"(one_));
                    f32x4 cs0 = (f32x4){one_, 0.f, one_, 0.f}, cs1 = cs0;
                    if (dorope) { const int t = row & (SEQ - 1); const int pos = (wc & 1) ? (t & 63) : (t >> 6); const float* rp = rope + (pos * 16 + 4 * fq) * 2; cs0 = *(const f32x4*)rp; cs1 = *(const f32x4*)(rp + 4); }
                    const float cj[4] = {cs0[0], cs0[2], cs1[0], cs1[2]}, sj[4] = {cs0[1], cs0[3], cs1[1], cs1[3]};
                    const f32x4 x1 = acc[ai][bj][m][0] * s1, x2 = acc[ai][bj][m][1] * s2; float o1[4], o2[4];
#pragma unroll
                    for (int j = 0; j < 4; ++j) { o1[j] = x1[j] * cj[j] - x2[j] * sj[j]; o2[j] = x2[j] * cj[j] + x1[j] * sj[j]; }
                    unsigned char* rowp = base + (size_t)row * D + colw + bj * 128 + wc * 32 + 4 * fq;
                    *(unsigned*)rowp = pack_fp8x4(o1[0], o1[1], o1[2], o1[3]); *(unsigned*)(rowp + 16) = pack_fp8x4(o2[0], o2[1], o2[2], o2[3]);
                    if (m & 1) __builtin_amdgcn_sched_barrier(0); }
        }
    }
};
struct EpiVt8 { static constexpr bool PF = false;
    static constexpr bool PERM = true; static constexpr int MODE = 2;
    unsigned char* Vt; const float* sw;
    __device__ __forceinline__ void operator()(const f32x4 (&acc)[2][2][4][2], const GU& u, int wave_, LAS unsigned char* lds_) const {
        EPI_LANE_IDS();
        unsigned char* Ob = Vt + u.ooff; const float* swp = sw + u.row0;
        const int k0 = wc * 32 + 8 * fq, kk = k0 & 63;
        const unsigned pcol = (unsigned)((k0 & ~63) + 16 * (kk >> 5) + 4 * ((kk >> 3) & 3));
#pragma unroll
        for (int ai = 0; ai < 2; ++ai)
#pragma unroll
            for (int m = 0; m < 4; ++m) { const int r = ai * 128 + wr * 64 + m * 16 + fr; const float sr = swp[r];
                const unsigned ro = (unsigned)r * (unsigned)VT_PITCH + pcol;
#pragma unroll
                for (int bj = 0; bj < 2; ++bj) { const f32x4 v0 = acc[ai][bj][m][0] * sr, v1 = acc[ai][bj][m][1] * sr;
                    *(unsigned*)(Ob + ro + bj * 128) = pack_fp8x4(v0[0], v0[1], v0[2], v0[3]); *(unsigned*)(Ob + ro + bj * 128 + 32) = pack_fp8x4(v1[0], v1[1], v1[2], v1[3]); }
                __builtin_amdgcn_sched_barrier(0); }
    }
};

struct DenseSched {
    static constexpr bool GATHER = false, VAR_NT = false;
    const char* A; const char* Bt; unsigned lda, ldb, hstepA, hstepB; int nt, ldc; const int* rowtok; g8::DenseOrder ord;
    __device__ __forceinline__ void init(const void* A_, const void* Bt_, int M, int N, int K, int ldc_, int G, int c) {
        A = (const char*)A_; Bt = (const char*)Bt_; lda = (unsigned)K * 2u; ldb = lda; hstepA = 128u * lda; hstepB = hstepA; nt = K / 64; ldc = ldc_; rowtok = nullptr; ord.init(M, N, G, c); }
    __device__ __forceinline__ void init8(const void* A_, const void* Bt_, int M, int N, int Kbytes, int ldc_, int G, int c) {
        A = (const char*)A_; Bt = (const char*)Bt_; lda = (unsigned)Kbytes; ldb = lda; hstepA = 128u * lda; hstepB = hstepA; nt = Kbytes / 128; ldc = ldc_; rowtok = nullptr; ord.init(M, N, G, c); }
    __device__ __forceinline__ bool next(int i, GU& u) const { int pm, pn; if (!ord.tile(i, pm, pn)) return false;
        u.a = (unsigned)pm * 2u * hstepA; u.b = (unsigned)pn * 2u * hstepB; u.row0 = pm * 256; u.col0 = pn * 256; u.ooff = (unsigned)(pm * 256) * (unsigned)ldc + (unsigned)(pn * 256); u.aux = 0; return true; }
};
__device__ __forceinline__ bool xcd_local(int i, int G, int c, int total, int& Li) {
    if ((G & 7) == 0 && (total & 7) == 0) { const int per = total >> 3, off = i * (G >> 3) + (c >> 3); if (off >= per) return false; Li = (c & 7) * per + off; return true; }
    const long L = (long)i * G + c; if (L >= total) return false; Li = (int)L; return true;
}
struct VtSched {
    static constexpr bool GATHER = false, VAR_NT = false;
    const char* A; const char* Bt; unsigned lda, ldb, hstepA, hstepB; int nt, ldc; const int* rowtok; int G, c;
    __device__ __forceinline__ void init(const void* Wv, const void* U, int G_, int c_) { A = (const char*)Wv; Bt = (const char*)U; lda = 1024u; ldb = 1024u; hstepA = 128u * 1024u; hstepB = hstepA; nt = 8; ldc = VT_PITCH; rowtok = nullptr; G = G_; c = c_; }
    __device__ __forceinline__ bool next(int i, GU& u) const {
        const long L = (long)i * G + c; if (L >= 4 * 136) return false; const int Li = (int)L, pm = Li & 3, pn = Li >> 2;
        const int b = pn < 128 ? (pn >> 4) : pn - 128, n0 = pn < 128 ? (pn & 15) * 256 : SEQ;
        u.a = (unsigned)pm * 256u * 1024u; u.b = (unsigned)pn * 256u * 1024u; u.row0 = pm * 256; u.col0 = 0; u.aux = 0;
        u.ooff = (unsigned)(b * 1024 + pm * 256) * (unsigned)VT_PITCH + (unsigned)n0; return true; }
};
struct GatedSched {
    static constexpr bool GATHER = false, VAR_NT = false;
    const char* A; const char* Bt; unsigned lda, ldb, hstepA, hstepB; int nt, ldc; const int* rowtok; g8::DenseOrder ord;
    __device__ __forceinline__ void init(const void* A_, const void* Bt_, int M, int N2, int K, int ldc_, int G, int c) {
        A = (const char*)A_; Bt = (const char*)Bt_; lda = (unsigned)K * 2u; ldb = lda; hstepA = 128u * lda; hstepB = (unsigned)N2 * ldb; nt = K / 64; ldc = ldc_; rowtok = nullptr; ord.init(M, 2 * N2, G, c); }
    __device__ __forceinline__ void init8(const void* A_, const void* Bt_, int M, int N2, int Kbytes, int ldc_, int G, int c) {
        A = (const char*)A_; Bt = (const char*)Bt_; lda = (unsigned)Kbytes; ldb = lda; hstepA = 128u * lda; hstepB = (unsigned)N2 * ldb; nt = Kbytes / 128; ldc = ldc_; rowtok = nullptr; ord.init(M, 2 * N2, G, c); }
    __device__ __forceinline__ bool next(int i, GU& u) const { int pm, pn; if (!ord.tile(i, pm, pn)) return false;
        u.a = (unsigned)pm * 2u * hstepA; u.b = (unsigned)pn * 128u * ldb; u.row0 = pm * 256; u.col0 = pn * 128; u.ooff = (unsigned)(pm * 256) * (unsigned)ldc + (unsigned)(pn * 128); u.aux = 0; return true; }
};
template <bool G1> struct MoeSched {
    static constexpr bool GATHER = G1, VAR_NT = false;
    const char* A; const char* Bt; unsigned lda, ldb, hstepA, hstepB; int nt, ldc; const int* rowtok;
    int G, c, NCT, wv; const volatile LAS int* tsp;
    __device__ __forceinline__ void init(const void* A_, const void* Bt_, const int* rowtok_, const volatile LAS int* tstart, int G_, int c_, int wave_) {
        A = (const char*)A_; Bt = (const char*)Bt_; lda = 1024u; ldb = lda; hstepA = 128u * lda; hstepB = G1 ? 1024u * ldb : 128u * ldb; nt = 8; ldc = 1024; rowtok = rowtok_;
        G = G_; c = c_; NCT = G1 ? 8 : 4; wv = wave_; tsp = tstart; }
    __device__ __forceinline__ bool next(int i, GU& u) const {
        const int l = hidden_tid(wv) & 63; const int vts = l <= 32 ? tsp[l] : 0x7fffffff;
        const int total = __builtin_amdgcn_readlane(vts, 32) * NCT; int Li;
        if ((G & 7) == 0) {
            const int x = c & 7, j = c >> 3, q = total >> 3, r = total & 7; const int len = q + (x < r ? 1 : 0), start = x * q + (x < r ? x : r), off = i * (G >> 3) + j;
            if (off >= len) return false; Li = start + off; }
        else { const long L = (long)i * G + c; if (L >= total) return false; Li = (int)L; }
        const unsigned long long mk = __ballot(l < 32 && vts * NCT <= Li);
        const int e = __popcll(mk) - 1; const int t0 = __builtin_amdgcn_readlane(vts, e);
        const int loc = Li - t0 * NCT, rt = loc / NCT, ct = loc - rt * NCT;
        const int prow = (t0 + rt) * 256;
        u.row0 = prow; u.aux = e;
        if (G1) { u.a = 0u; u.b = ((unsigned)e * 2048u + (unsigned)ct * 128u) * 1024u; u.col0 = ct * 128; u.ooff = (unsigned)prow * 1024u + (unsigned)ct * 128u; }
        else { u.a = (unsigned)prow * 1024u; u.b = ((unsigned)e * 1024u + (unsigned)ct * 256u) * 1024u; u.col0 = ct * 256; u.ooff = (unsigned)prow * 1024u + (unsigned)ct * 256u; }
        return true; }
};
struct F1Sched {
    static constexpr bool GATHER = false, VAR_NT = false;
    const char* A; const char* Bt; unsigned lda, ldb, hstepA, hstepB; int nt, ldc; const int* rowtok; int G, c;
    __device__ __forceinline__ void init(const void* acs, const void* U, int G_, int c_) { A = (const char*)acs; Bt = (const char*)U; lda = 512u; ldb = 2048u; hstepA = 128u * 512u; hstepB = 128u * 2048u; nt = 4; ldc = 8192; rowtok = nullptr; G = G_; c = c_; }
    __device__ __forceinline__ bool next(int i, GU& u) const {
        int Li; if (!xcd_local(i, G, c, 1024 + 64, Li)) return false;
        if (Li < 1024) { const int sub = Li & 7, tt = (Li >> 3) & 15, b = Li >> 7, cs = sub >> 2, mt = sub & 3;
            u.a = (unsigned)cs * 131072u; u.b = (unsigned)(b * SEQ + tt * 256) * 2048u + (unsigned)mt * 512u; u.row0 = mt * 256; u.col0 = 0; u.aux = 0;
            u.ooff = (unsigned)(b * 1024 + mt * 256) * 8192u + (unsigned)(cs * 4096 + tt * 256); }
        else { Li -= 1024; const int sub = Li & 7, b = Li >> 3, cs = sub >> 2, mt = sub & 3;
            u.a = (unsigned)cs * 131072u; u.b = (unsigned)(T_LAT + b * CTXL) * 2048u + (unsigned)mt * 512u; u.row0 = mt * 256; u.col0 = 0; u.aux = 0;
            u.ooff = 8u * 1024u * 8192u + (unsigned)(b * 1024 + mt * 256) * 8192u + (unsigned)(cs * 256); }
        return true; }
};
static_assert(WS_K - WS_Q == WS_V - WS_K, "Q, K, V equally spaced");
static_assert(WS_YTC >= WS_YT + (size_t)2 * 8 * 1024 * 8192, "ctx Yt follows lat Yt (8 MiB x 8 after it)");
struct F2Sched {
    static constexpr bool GATHER = false, VAR_NT = true;
    const char* A; const char* Bt; unsigned lda, ldb, hstepA, hstepB; int nt, ldc; const int* rowtok; int G, c;
    __device__ __forceinline__ void init(const void* dft, const void* Yt, int G_, int c_) { A = (const char*)dft; Bt = (const char*)Yt;
        lda = 8192u; ldb = 8192u; hstepA = 128u * 8192u; hstepB = hstepA; nt = 0; ldc = 1024; rowtok = nullptr; G = G_; c = c_; }
    __device__ __forceinline__ bool next(int i, GU& u) const {
        int Li;
        if ((G & 7) == 0) { const int off = i * (G >> 3) + (c >> 3); if (off >= 68) return false; Li = off < 64 ? (c & 7) * 64 + off : 512 + (c & 7) * 4 + (off - 64); }
        else { const long L = (long)i * G + c; if (L >= 512 + 32) return false; Li = (int)L; }
        if (Li < 512) { const int ct = Li & 3, kt = (Li >> 2) & 15, b = Li >> 6;
            u.a = (unsigned)kt * 256u * 8192u; u.b = (unsigned)(b * 1024 + ct * 256) * 8192u; u.row0 = b * SEQ + kt * 256; u.col0 = ct * 256; u.aux = 64; }
        else { Li -= 512; const int ct = Li & 3, b = Li >> 2;
            u.a = 4096u * 8192u; u.b = (unsigned)(8 * 1024 + b * 1024 + ct * 256) * 8192u; u.row0 = T_LAT + b * CTXL; u.col0 = ct * 256; u.aux = 4; }
        u.ooff = (unsigned)u.row0 * 1024u + (unsigned)u.col0; return true; }
};
namespace att {
constexpr int SLOTK = 4096, SLOTV = 8192, NSLOT = 4, PFD = NSLOT - 1;
constexpr int LDS_K = 0, LDS_V = NSLOT * SLOTK, LDS_WS = LDS_V + NSLOT * SLOTV, LDS_OST = LDS_WS + NWAVES * 256, LDS_END = LDS_OST + NWAVES * 8192;
static_assert(LDS_END <= MISC_OFF, "attention LDS map");
__device__ __forceinline__ int crow(int r, int hi) { return (r & 3) + 8 * (r >> 2) + 4 * hi; }
struct Params { const unsigned char* Q; const unsigned char* K; const unsigned char* Vt; unsigned char* O; float* scr; const float* subln_g; float lam, outscale; int wave; };
__device__ __forceinline__ float max3f(float a, float b, float c) { float r; asm("v_max3_f32 %0, %1, %2, %3" : "=v"(r) : "v"(a), "v"(b), "v"(c)); return r; }
__device__ __forceinline__ i32x8 cat8(i32x4 a, i32x4 b) { return (i32x8){a[0], a[1], a[2], a[3], b[0], b[1], b[2], b[3]}; }

template <int THRL, int VAR = 0>
__device__ __forceinline__ void unit(const Params& P, int b, int h, int c, int qrow0, int t_begin, int t_end, LAS unsigned char* lds) {
    const int tid = hidden_tid(P.wave), lane = tid & 63, r32 = lane & 31, hi = lane >> 5; const int wid = P.wave; const int grp = (wid >> ATT_GSH) & 1; const bool dk = wid < 4;
    LAS float* wsf = (LAS float*)(lds + LDS_WS) + wid * 64;
    const int drow = lane >> 2, dsw = (lane & 3) ^ ((lane >> 4) & 3);
    const unsigned koff = (unsigned)(16 * (wid & 3) + drow) * 1024u + (unsigned)(h * 128 + c * 64 + 16 * dsw);
    const unsigned voff = (unsigned)((b * 1024 + h * 128 + 16 * wid + drow) * VT_PITCH + 16 * dsw);
    const char* Kb = (const char*)P.K; const char* Vb = (const char*)P.Vt; const unsigned lds0 = (unsigned)(unsigned long)lds;
#define ATT_KROW0(t) ((t) < 64 ? b * SEQ + 64 * (t) : T_LAT + b * CTXL + 64 * ((t) - 64))
#define ATT_GLDS(sbase, vo, ldsaddr) do { unsigned keep_ = 0; asm volatile("s_mov_b32 m0, %2\n\ts_nop 4\n\tglobal_load_lds_dwordx4 %0, %1" :: "v"(vo), "s"(sbase), "s"(ldsaddr) : "memory"); (void)keep_; } while (0)
#define ATT_DMA_K(t, slot) do { if (dk) { const char* kp_ = Kb + (size_t)(ATT_KROW0(t)) * 1024; ATT_GLDS(kp_, koff, lds0 + (unsigned)(LDS_K + (slot) * SLOTK + wid * 1024)); } } while (0)
#define ATT_DMA_V(t, slot) do { const char* vp_ = Vb + (size_t)(t) * 64; ATT_GLDS(vp_, voff, lds0 + (unsigned)(LDS_V + (slot) * SLOTV + wid * 1024)); } while (0)
#define ATT_BAR() asm volatile("s_waitcnt lgkmcnt(0)\n\ts_barrier" ::: "memory")
#define ATT_VM(N) asm volatile("s_waitcnt vmcnt(" #N ")" ::: "memory")
#define ATT_VMN(N) asm volatile("s_waitcnt vmcnt(%0)" :: "n"(N) : "memory")
    const int T = t_end - t_begin;
#pragma unroll
    for (int j = 0; j < PFD; ++j) { if (j < T) ATT_DMA_K(t_begin + j, j); if (j < PFD - 1 && j < T) ATT_DMA_V(t_begin + j, j); }
    i32x8 qf;
    { const unsigned char* Qw = P.Q + (size_t)(qrow0 + wid * 32 + r32) * D + h * 128 + c * 64 + hi * 32; qf = cat8(*(const i32x4*)Qw, *(const i32x4*)(Qw + 16)); }
    f32x16 o[4], negm;
#pragma unroll
    for (int r = 0; r < 16; ++r) { negm[r] = 0.f;
#pragma unroll
        for (int d0 = 0; d0 < 4; ++d0) o[d0][r] = 0.f; }
    float mhat = 0.f;
    f32x16 lacc;
#pragma unroll
    for (int r = 0; r < 16; ++r) lacc[r] = 0.f;
    i32x8 ones; { int o1_ = 0x38383838; asm volatile("" : "+v"(o1_)); ones = (i32x8){o1_, o1_, o1_, o1_, o1_, o1_, o1_, o1_}; }
    const int fsw = (r32 >> 2) & 3;
    const int foff0 = r32 * 64 + ((2 * hi) ^ fsw) * 16, foff1 = r32 * 64 + ((2 * hi + 1) ^ fsw) * 16;
    int sc_s = 0x7d7d7d7d, sc_1 = 0x7f7f7f7f; asm volatile("" : "+v"(sc_s), "+v"(sc_1));
    f32x16 p0, p1; i32x8 pa;
#pragma unroll
    for (int r = 0; r < 16; ++r) { p0[r] = 0.f; p1[r] = 0.f; }
#pragma unroll
    for (int k = 0; k < 8; ++k) pa[k] = 0;
#define ATT_SOFTMAX(FIRST) do { \
        float rm, rm1 = max3f(p0[3], p0[4], p0[5]), rm2 = max3f(p0[6], p0[7], p0[8]), rm3 = max3f(p0[9], p0[10], p0[11]);     \
        rm = max3f(p0[0], p0[1], p0[2]); rm = max3f(rm, p0[12], p0[13]); rm1 = max3f(rm1, p0[14], p0[15]); rm2 = max3f(rm2, p1[0], p1[1]); rm3 = max3f(rm3, p1[2], p1[3]); \
        rm = max3f(rm, p1[4], p1[5]); rm1 = max3f(rm1, p1[6], p1[7]); rm2 = max3f(rm2, p1[8], p1[9]); rm3 = max3f(rm3, p1[10], p1[11]); \
        rm = max3f(rm, p1[12], p1[13]); rm1 = max3f(rm1, p1[14], p1[15]); rm = max3f(rm, rm1, rm2); rm = max3f(rm, rm3, rm3); \
        { auto rr = __builtin_amdgcn_permlane32_swap(__float_as_uint(rm), __float_as_uint(rm), false, false); rm = max3f(__uint_as_float(rr[0]), __uint_as_float(rr[1]), __uint_as_float(rr[1])); } \
        if ((FIRST) || __any(rm > (float)THRL)) { \
            const float dl = (FIRST) ? rm : fmaxf(rm, 0.f), f = (FIRST) ? 1.0f : __builtin_amdgcn_exp2f(-dl);     \
            mhat += dl; \
            _Pragma("unroll") for (int r = 0; r < 16; ++r) { p0[r] -= dl; p1[r] -= dl; negm[r] = -mhat; } \
            if (hi == 0) wsf[r32] = f; \
            LDS_WAIT(); \
            _Pragma("unroll") for (int r = 0; r < 16; ++r) { const float fr_ = wsf[crow(r, hi)]; \
                lacc[r] *= fr_; \
                _Pragma("unroll") for (int d0 = 0; d0 < 4; ++d0) o[d0][r] *= fr_; } \
        } \
        _Pragma("unroll") for (int r = 0; r < 16; ++r) { p0[r] = __builtin_amdgcn_exp2f(p0[r]); p1[r] = __builtin_amdgcn_exp2f(p1[r]); } \
        _Pragma("unroll") for (int q = 0; q < 4; ++q) { pa[q] = (int)pack_fp8x4(p0[4 * q], p0[4 * q + 1], p0[4 * q + 2], p0[4 * q + 3]); pa[4 + q] = (int)pack_fp8x4(p1[4 * q], p1[4 * q + 1], p1[4 * q + 2], p1[4 * q + 3]); } \
    } while (0)
    ATT_VM(0); ATT_BAR();
    int sk = 0, sv = NSLOT - 1;
    for (int s = 0; s <= T; ++s) {
#define ATT_ISSUE() do { const int k2 = sk == 0 ? NSLOT - 1 : sk - 1, v1 = k2 == 0 ? NSLOT - 1 : k2 - 1;     \
          if (VAR != 3) { if (s + PFD < T) ATT_DMA_K(t_begin + s + PFD, k2); \
          if (s + PFD - 1 < T) ATT_DMA_V(t_begin + s + PFD - 1, v1); } } while (0)
        if (VAR != 1 && VAR != 5) { if (grp == 1 && s > 0) ATT_SOFTMAX(s == 1); }
        if (grp == 1) ATT_ISSUE();
        i32x8 kf0, kf1;
        if (VAR != 2 && VAR != 5 && s < T) { const LAS unsigned char* Ks = lds + LDS_K + sk * SLOTK;
            kf0 = cat8(*(const LAS i32x4*)(Ks + foff0), *(const LAS i32x4*)(Ks + foff1)); kf1 = cat8(*(const LAS i32x4*)(Ks + 2048 + foff0), *(const LAS i32x4*)(Ks + 2048 + foff1)); }
        if (VAR != 2 && VAR != 5 && s < T) {
            __builtin_amdgcn_s_setprio(1);
            p0 = __builtin_amdgcn_mfma_scale_f32_32x32x64_f8f6f4(kf0, qf, negm, 0, 0, 0, sc_s, 0, sc_s);
            p1 = __builtin_amdgcn_mfma_scale_f32_32x32x64_f8f6f4(kf1, qf, negm, 0, 0, 0, sc_s, 0, sc_s);
            __builtin_amdgcn_s_setprio(0);
        }
        if (VAR != 2 && VAR != 5 && s > 0) {
            const LAS unsigned char* Vs = lds + LDS_V + sv * SLOTV;
            i32x8 vf[4];
#pragma unroll
            for (int d0 = 0; d0 < 4; ++d0) vf[d0] = cat8(*(const LAS i32x4*)(Vs + d0 * 2048 + foff0), *(const LAS i32x4*)(Vs + d0 * 2048 + foff1));
            __builtin_amdgcn_s_setprio(1);
#pragma unroll
            for (int d0 = 0; d0 < 4; ++d0) o[d0] = __builtin_amdgcn_mfma_scale_f32_32x32x64_f8f6f4(pa, vf[d0], o[d0], 0, 0, 0, sc_1, 0, sc_1);
            lacc = __builtin_amdgcn_mfma_scale_f32_32x32x64_f8f6f4(pa, ones, lacc, 0, 0, 0, sc_1, 0, sc_1);
            __builtin_amdgcn_s_setprio(0);
        }
        if (VAR != 2 && VAR != 5 && s < T) asm volatile("s_nop 15\n\ts_nop 15" : "+v"(p0), "+v"(p1));
        if (grp == 0) ATT_ISSUE();
        if (VAR != 1 && VAR != 5) { if (grp == 0 && s < T) ATT_SOFTMAX(s == 0); }
        if (s + PFD < T) { if (dk) { ATT_VMN(2 * (PFD - 1)); } else { ATT_VMN(PFD - 1); } } else { ATT_VM(0); }
        if (VAR != 4) ATT_BAR();
        sv = sk; sk = sk == NSLOT - 1 ? 0 : sk + 1;
    }
#undef ATT_SOFTMAX
#undef ATT_ISSUE
    f32x4* scr4 = (f32x4*)(P.scr + (size_t)blockIdx.x * 32768) + tid;
    if (c == 0) {
        float rl[16];
#pragma unroll
        for (int r = 0; r < 16; ++r) rl[r] = __builtin_amdgcn_rcpf(lacc[r]);
#pragma unroll
        for (int d0 = 0; d0 < 4; ++d0)
#pragma unroll
            for (int rq = 0; rq < 4; ++rq) scr4[(d0 * 4 + rq) * 512] = (f32x4){o[d0][4 * rq] * rl[4 * rq], o[d0][4 * rq + 1] * rl[4 * rq + 1], o[d0][4 * rq + 2] * rl[4 * rq + 2], o[d0][4 * rq + 3] * rl[4 * rq + 3]};
    } else {
        f32x4 o0v[16];
#pragma unroll
        for (int q = 0; q < 16; ++q) o0v[q] = scr4[q * 512];
        const float g0 = P.subln_g[r32], g1 = P.subln_g[32 + r32], g2 = P.subln_g[64 + r32], g3 = P.subln_g[96 + r32];
        LAS unsigned char* stg = lds + LDS_OST + wid * 4096;
#pragma unroll
        for (int r = 0; r < 16; ++r) { const float rl = __builtin_amdgcn_rcpf(lacc[r]) * P.lam; float dv[4]; float ss = 0.f;
#pragma unroll
            for (int d0 = 0; d0 < 4; ++d0) { const float o0 = o0v[d0 * 4 + (r >> 2)][r & 3]; dv[d0] = o0 - o[d0][r] * rl; ss += dv[d0] * dv[d0]; }
            ss += sx<1>(ss); ss += sx<2>(ss); ss += sx<4>(ss); ss += sx<8>(ss); ss += sx<16>(ss);
            const float sc = rsqrtf(ss * (1.0f / 128.0f) + ln_eps()) * P.outscale; const int orow = crow(r, hi);
            { const unsigned pk_ = pack_fp8x4(dv[0] * sc * g0, dv[1] * sc * g1, dv[2] * sc * g2, dv[3] * sc * g3);
              stg[orow * 128 + r32] = (unsigned char)(pk_ & 0xffu); stg[orow * 128 + 32 + r32] = (unsigned char)((pk_ >> 8) & 0xffu);
              stg[orow * 128 + 64 + r32] = (unsigned char)((pk_ >> 16) & 0xffu); stg[orow * 128 + 96 + r32] = (unsigned char)(pk_ >> 24); }
            if ((r & 3) == 3) __builtin_amdgcn_sched_barrier(0); }
        LDS_WAIT();
        unsigned char* Ow = P.O + (size_t)(qrow0 + wid * 32) * D + h * 128;
#pragma unroll
        for (int i = 0; i < 4; ++i) { const int id = i * 64 + lane, row = id >> 3, ch = id & 7; const u32x4 v = *(const LAS u32x4*)(stg + row * 128 + ch * 16); *(u32x4*)(Ow + (size_t)row * D + ch * 16) = v; }
    }
    asm volatile("s_waitcnt vmcnt(0) lgkmcnt(0)\n\ts_barrier" ::: "memory");
#undef ATT_DMA_K
#undef ATT_GLDS
#undef ATT_DMA_V
#undef ATT_KROW0
#undef ATT_BAR
#undef ATT_VM
#undef ATT_VMN
}
}

struct Args { const float* in[33]; float* out; unsigned char* ws; int ph_lo, ph_hi; };
enum { I_X = 0, I_C, I_CTX, I_CCTX, I_WMOD, I_BMOD, I_LN1G, I_LN1B, I_LN2G, I_LN2B, I_AQKV, I_AWO, I_LQ1, I_LK1, I_LQ2, I_LK2, I_SUBLN, I_FW, I_FB,
       I_CPW1, I_CBPW1, I_CWDW, I_CBDW, I_CLNG, I_CLNB, I_CPW2, I_CBPW2, I_RW, I_RB, I_MW1, I_MB1, I_MW2, I_MB2 };
struct Frame {
    LAS unsigned char* lds; volatile LAS unsigned* MISC; unsigned* ctl; unsigned char* ws;
    int tid, lane, wave, vcu, G, zi;
    const float* const* in; float* out;
};
#define WSP(T, off) ((T*)(F.ws + (off)))
#define MODP(layer, ci, chunk) (WSP(const float, WS_MOD) + ((size_t)(layer) * 9 + (ci)) * 6144 + (chunk) * 1024)

__device__ __forceinline__ void ld_row_f32(const float* p, int lane, f32x4 (&v)[4]) {
#pragma unroll
    for (int j = 0; j < 4; ++j) v[j] = *(const f32x4*)(p + 4 * lane + 256 * j);
}
__device__ __forceinline__ void ld_row_bf16(const bf16_t* p, int lane, f32x4 (&v)[4]) {
#pragma unroll
    for (int j = 0; j < 4; ++j) { const u32x2 w = *(const u32x2*)(p + 4 * lane + 256 * j); v[j] = (f32x4){bf_lo(w.x), bf_hi(w.x), bf_lo(w.y), bf_hi(w.y)}; }
}
__device__ __forceinline__ void ld_row_fp8(const unsigned char* p, int lane, f32x4 (&v)[4]) {
#pragma unroll
    for (int j = 0; j < 4; ++j) { const int w = *(const int*)(p + 4 * lane + 256 * j); const f32x2 lo = __builtin_amdgcn_cvt_pk_f32_fp8(w, false), hi = __builtin_amdgcn_cvt_pk_f32_fp8(w, true); v[j] = (f32x4){lo.x, lo.y, hi.x, hi.y}; }
}
__device__ __forceinline__ void st_row_f32(float* p, int lane, const f32x4 (&v)[4]) {
#pragma unroll
    for (int j = 0; j < 4; ++j) *(f32x4*)(p + 4 * lane + 256 * j) = v[j];
}
__device__ __forceinline__ void st_row_bf16(bf16_t* p, int lane, const f32x4 (&v)[4]) {
#pragma unroll
    for (int j = 0; j < 4; ++j) { u32x2 w; w.x = cvt_pk_bf16(v[j][0], v[j][1]); w.y = cvt_pk_bf16(v[j][2], v[j][3]); *(u32x2*)(p + 4 * lane + 256 * j) = w; }
}
__device__ __forceinline__ void st_row_fp8(unsigned char* p, int lane, const f32x4 (&v)[4]) {
#pragma unroll
    for (int j = 0; j < 4; ++j) *(unsigned*)(p + 4 * lane + 256 * j) = pack_fp8x4(v[j][0], v[j][1], v[j][2], v[j][3]);
}
__device__ __forceinline__ void layer_norm_row(f32x4 (&v)[4], const float* g, const float* b, int lane) {
    float s = 0.f;
#pragma unroll
    for (int j = 0; j < 4; ++j) s += (v[j][0] + v[j][1]) + (v[j][2] + v[j][3]);
    const float mean = wave_sum(s) * (1.0f / D); float q = 0.f;
#pragma unroll
    for (int j = 0; j < 4; ++j) { v[j] = v[j] - mean; q += (v[j][0] * v[j][0] + v[j][1] * v[j][1]) + (v[j][2] * v[j][2] + v[j][3] * v[j][3]); }
    const float rstd = rsqrtf(wave_sum(q) * (1.0f / D) + ln_eps());
#pragma unroll
    for (int j = 0; j < 4; ++j) { const f32x4 gg = *(const f32x4*)(g + 4 * lane + 256 * j), bb = *(const f32x4*)(b + 4 * lane + 256 * j); v[j] = v[j] * rstd * gg + bb; }
}
__device__ __forceinline__ void ld_vec(const float* p, int lane, f32x4 (&v)[4]) {
#pragma unroll
    for (int j = 0; j < 4; ++j) v[j] = *(const f32x4*)(p + 4 * lane + 256 * j);
}
__device__ __forceinline__ void layer_norm_row_r(f32x4 (&v)[4], const f32x4 (&g)[4], const f32x4 (&b)[4]) {
    float s = 0.f;
#pragma unroll
    for (int j = 0; j < 4; ++j) s += (v[j][0] + v[j][1]) + (v[j][2] + v[j][3]);
    const float mean = wave_sum(s) * (1.0f / D); float q = 0.f;
#pragma unroll
    for (int j = 0; j < 4; ++j) { v[j] = v[j] - mean; q += (v[j][0] * v[j][0] + v[j][1] * v[j][1]) + (v[j][2] * v[j][2] + v[j][3] * v[j][3]); }
    const float rstd = rsqrtf(wave_sum(q) * (1.0f / D) + ln_eps());
#pragma unroll
    for (int j = 0; j < 4; ++j) v[j] = v[j] * rstd * g[j] + b[j];
}
__device__ __forceinline__ void ld_rowB_f32(const float* p, int lane, f32x4 (&v)[4]) {
#pragma unroll
    for (int i = 0; i < 4; ++i) v[i] = *(const f32x4*)(p + 16 * lane + 4 * i);
}
__device__ __forceinline__ void st_rowB_f32(float* p, int lane, const f32x4 (&v)[4]) {
#pragma unroll
    for (int i = 0; i < 4; ++i) *(f32x4*)(p + 16 * lane + 4 * i) = v[i];
}
__device__ __forceinline__ void ld_rowB_fp8(const unsigned char* p, int lane, f32x4 (&v)[4]) {
    const u32x4 w = *(const u32x4*)(p + 16 * lane);
#pragma unroll
    for (int i = 0; i < 4; ++i) { const f32x2 lo = __builtin_amdgcn_cvt_pk_f32_fp8((int)w[i], false), hi = __builtin_amdgcn_cvt_pk_f32_fp8((int)w[i], true); v[i] = (f32x4){lo.x, lo.y, hi.x, hi.y}; }
}
__device__ __forceinline__ void ld_rowB_bf16(const bf16_t* p, int lane, f32x4 (&v)[4]) {
    const u32x4 w0 = *(const u32x4*)(p + 16 * lane), w1 = *(const u32x4*)(p + 16 * lane + 8);
    v[0] = (f32x4){bf_lo(w0.x), bf_hi(w0.x), bf_lo(w0.y), bf_hi(w0.y)}; v[1] = (f32x4){bf_lo(w0.z), bf_hi(w0.z), bf_lo(w0.w), bf_hi(w0.w)};
    v[2] = (f32x4){bf_lo(w1.x), bf_hi(w1.x), bf_lo(w1.y), bf_hi(w1.y)}; v[3] = (f32x4){bf_lo(w1.z), bf_hi(w1.z), bf_lo(w1.w), bf_hi(w1.w)};
}
__device__ __forceinline__ int permB(int c) { return 4 * (c >> 4) + 256 * ((c >> 2) & 3) + (c & 3); }
__device__ __forceinline__ void st_rowB_fp8(unsigned char* p, int lane, const f32x4 (&v)[4]) {
    *(u32x4*)(p + 16 * lane) = (u32x4){pack_fp8x4(v[0][0], v[0][1], v[0][2], v[0][3]), pack_fp8x4(v[1][0], v[1][1], v[1][2], v[1][3]), pack_fp8x4(v[2][0], v[2][1], v[2][2], v[2][3]), pack_fp8x4(v[3][0], v[3][1], v[3][2], v[3][3])};
}
__device__ __forceinline__ void st_rowB_bf16(bf16_t* p, int lane, const f32x4 (&v)[4]) {
    *(u32x4*)(p + 16 * lane) = (u32x4){cvt_pk_bf16(v[0][0], v[0][1]), cvt_pk_bf16(v[0][2], v[0][3]), cvt_pk_bf16(v[1][0], v[1][1]), cvt_pk_bf16(v[1][2], v[1][3])};
    *(u32x4*)(p + 16 * lane + 8) = (u32x4){cvt_pk_bf16(v[2][0], v[2][1]), cvt_pk_bf16(v[2][2], v[2][3]), cvt_pk_bf16(v[3][0], v[3][1]), cvt_pk_bf16(v[3][2], v[3][3])};
}
__device__ __forceinline__ const float* xrow_in(const Frame& F, int layer, int row) {
    if (layer == 0) return row < T_LAT ? F.in[F.zi + I_X] + (size_t)row * D : F.in[F.zi + I_CTX] + (size_t)(row - T_LAT) * D;
    return WSP(const float, WS_X) + (size_t)row * D;
}
__device__ __forceinline__ int cond_of(int row) { return row < T_LAT ? (row >> 12) : 8; }

__device__ __forceinline__ void transpose_family(const Frame& F, const float* src, int nmat, int K, int N, bf16_t* dst, LAS float* scr) {
    const int lane = hidden_tid(F.wave) & 63; const int gw = F.vcu * NWAVES + F.wave, NGW = F.G * NWAVES;
    const int nkb = K / 64, nnb = N / 64, per = nkb * nnb; const long items = (long)nmat * per;
    for (long it = gw; it < items; it += NGW) {
        const int mat = (int)(it / per), r = (int)(it % per), kb = r / nnb, nb = r % nnb, k0 = kb * 64, n0 = nb * 64;
        const float* W = src + (size_t)mat * K * N; bf16_t* WT = dst + (size_t)mat * K * N;
        f32x4 v[16];
#pragma unroll
        for (int i = 0; i < 16; ++i) v[i] = *(const f32x4*)(W + (size_t)(k0 + 4 * i + (lane >> 4)) * N + n0 + 4 * (lane & 15));
#pragma unroll
        for (int i = 0; i < 16; ++i) { LAS float* s = scr + (4 * i + (lane >> 4)) * 65 + 4 * (lane & 15); s[0] = v[i][0]; s[1] = v[i][1]; s[2] = v[i][2]; s[3] = v[i][3]; }
        LDS_WAIT(); asm volatile("" ::: "memory");
        const int kc = lane & 7;
#pragma unroll
        for (int jj = 0; jj < 8; ++jj) { const int n = (lane >> 3) + 8 * jj; const LAS float* s = scr + (8 * kc) * 65 + n;
            u32x4 o; o.x = cvt_pk_bf16(s[0], s[65]); o.y = cvt_pk_bf16(s[2 * 65], s[3 * 65]); o.z = cvt_pk_bf16(s[4 * 65], s[5 * 65]); o.w = cvt_pk_bf16(s[6 * 65], s[7 * 65]);
            *(u32x4*)(WT + (size_t)(n0 + n) * K + k0 + 8 * kc) = o; }
        LDS_WAIT(); asm volatile("" ::: "memory");
    }
}
template <bool FP8> __device__ __forceinline__ void quant_w(Frame& F, const float* src, int nmat, int N, unsigned char* dst, float* scales, int rot = 0) {
    const int tid = hidden_tid(F.wave), lane = tid & 63, wave = __builtin_amdgcn_readfirstlane(tid >> 6);
    LAS float* scr = (LAS float*)(F.lds + wave * 16640);
    LAS float* cmaxp = (LAS float*)(F.lds + 133120);
    LAS float* finv = (LAS float*)(F.lds + 133120 + 2048);
    const int strips = N / 64;
    for (int it = (F.vcu + F.G - rot % F.G) % F.G; it < nmat * strips; it += F.G) {
        const int mat = it / strips, n0 = (it % strips) * 64;
        const float* W = src + (size_t)mat * 1024 * N + n0 + 4 * (lane & 15);
        f32x4 v[32];
#pragma unroll
        for (int i = 0; i < 32; ++i) v[i] = *(const f32x4*)(W + (size_t)(wave * 128 + 4 * i + (lane >> 4)) * N);
        float mx0 = 0.f, mx1 = 0.f, mx2 = 0.f, mx3 = 0.f;
#pragma unroll
        for (int i = 0; i < 32; ++i) { mx0 = fmaxf(mx0, fabsf(v[i][0])); mx1 = fmaxf(mx1, fabsf(v[i][1])); mx2 = fmaxf(mx2, fabsf(v[i][2])); mx3 = fmaxf(mx3, fabsf(v[i][3])); }
        mx0 = fmaxf(mx0, sx<16>(mx0)); mx1 = fmaxf(mx1, sx<16>(mx1)); mx2 = fmaxf(mx2, sx<16>(mx2)); mx3 = fmaxf(mx3, sx<16>(mx3));
        { auto r0 = __builtin_amdgcn_permlane32_swap(__float_as_uint(mx0), __float_as_uint(mx0), false, false); mx0 = fmaxf(__uint_as_float(r0[0]), __uint_as_float(r0[1]));
          auto r1 = __builtin_amdgcn_permlane32_swap(__float_as_uint(mx1), __float_as_uint(mx1), false, false); mx1 = fmaxf(__uint_as_float(r1[0]), __uint_as_float(r1[1]));
          auto r2 = __builtin_amdgcn_permlane32_swap(__float_as_uint(mx2), __float_as_uint(mx2), false, false); mx2 = fmaxf(__uint_as_float(r2[0]), __uint_as_float(r2[1]));
          auto r3 = __builtin_amdgcn_permlane32_swap(__float_as_uint(mx3), __float_as_uint(mx3), false, false); mx3 = fmaxf(__uint_as_float(r3[0]), __uint_as_float(r3[1])); }
        if (lane < 16) *(LAS f32x4*)(cmaxp + wave * 64 + 4 * lane) = (f32x4){mx0, mx1, mx2, mx3};
        __syncthreads();
        if (tid < 64) { float m = cmaxp[tid];
#pragma unroll
            for (int w = 1; w < 8; ++w) m = fmaxf(m, cmaxp[w * 64 + tid]);
            const float sc = m > 0.f ? m * (1.0f / (FP8 ? FP8_TOP : 127.0f)) : 1.0f; scales[(size_t)mat * N + n0 + tid] = sc; finv[tid] = 1.0f / sc; }
        __syncthreads();
        unsigned char* Wq = dst + (size_t)mat * N * 1024;
#pragma unroll
        for (int kb2 = 0; kb2 < 2; ++kb2) { const int k0 = wave * 128 + kb2 * 64;
#pragma unroll
            for (int i = 0; i < 16; ++i) { LAS float* sp = scr + (4 * i + (lane >> 4)) * 65 + 4 * (lane & 15); sp[0] = v[16 * kb2 + i][0]; sp[1] = v[16 * kb2 + i][1]; sp[2] = v[16 * kb2 + i][2]; sp[3] = v[16 * kb2 + i][3]; }
            LDS_WAIT(); asm volatile("" ::: "memory");
            const int kc = lane & 3;
#pragma unroll
            for (int jj = 0; jj < 4; ++jj) { const int n = (lane >> 2) + 16 * jj; const LAS float* sp = scr + (16 * kc) * 65 + n; const float fi = finv[n];
                u32x4 o;
                if (FP8) { o.x = pack_fp8x4(sp[0] * fi, sp[65] * fi, sp[2 * 65] * fi, sp[3 * 65] * fi); o.y = pack_fp8x4(sp[4 * 65] * fi, sp[5 * 65] * fi, sp[6 * 65] * fi, sp[7 * 65] * fi);
                    o.z = pack_fp8x4(sp[8 * 65] * fi, sp[9 * 65] * fi, sp[10 * 65] * fi, sp[11 * 65] * fi); o.w = pack_fp8x4(sp[12 * 65] * fi, sp[13 * 65] * fi, sp[14 * 65] * fi, sp[15 * 65] * fi); }
                else { o.x = pack_i8x4(sp[0] * fi, sp[65] * fi, sp[2 * 65] * fi, sp[3 * 65] * fi); o.y = pack_i8x4(sp[4 * 65] * fi, sp[5 * 65] * fi, sp[6 * 65] * fi, sp[7 * 65] * fi);
                    o.z = pack_i8x4(sp[8 * 65] * fi, sp[9 * 65] * fi, sp[10 * 65] * fi, sp[11 * 65] * fi); o.w = pack_i8x4(sp[12 * 65] * fi, sp[13 * 65] * fi, sp[14 * 65] * fi, sp[15 * 65] * fi); }
                *(u32x4*)(Wq + (size_t)(n0 + n) * 1024 + k0 + 16 * kc) = o; }
            LDS_WAIT(); asm volatile("" ::: "memory");
        }
        __syncthreads();
    }
}
__device__ __forceinline__ void p0_prologue(Frame& F) {
    const int tid = hidden_tid(F.wave), lane = tid & 63, wave = __builtin_amdgcn_readfirstlane(tid >> 6);
    LAS float* sc = (LAS float*)F.lds;
    LAS float* red = (LAS float*)(F.lds + 40960);
    for (int i = tid; i < 9 * 1024; i += NTHR) { const float cv = i < 8192 ? F.in[F.zi + I_C][i] : F.in[F.zi + I_CCTX][i - 8192]; sc[i] = cv * fast_sigmoid(cv); }
    __syncthreads();
    for (int it = F.vcu; it < 4 * 96; it += F.G) {
        const int layer = it / 96, n = (it % 96) * 64 + lane;
        const float* W = F.in[F.zi + I_WMOD] + (size_t)layer * 1024 * 6144 + n;
        float a[9];
#pragma unroll
        for (int r = 0; r < 9; ++r) a[r] = 0.f;
#pragma unroll 8
        for (int k = wave * 128; k < wave * 128 + 128; ++k) { const float w = W[(size_t)k * 6144];
#pragma unroll
            for (int r = 0; r < 9; ++r) a[r] += sc[r * 1024 + k] * w; }
#pragma unroll
        for (int r = 0; r < 9; ++r) red[(wave * 9 + r) * 64 + lane] = a[r];
        __syncthreads();
        for (int r = wave; r < 9; r += NWAVES) { float s = F.in[F.zi + I_BMOD][layer * 6144 + n];
#pragma unroll
            for (int w = 0; w < 8; ++w) s += red[(w * 9 + r) * 64 + lane];
            WSP(float, WS_MOD)[((size_t)layer * 9 + r) * 6144 + n] = s; }
        __syncthreads();
    }
    const int gt = F.vcu * NTHR + tid, NGT = F.G * NTHR;
    for (int i = gt; i < 64 * 16; i += NGT) { const int pos = i >> 4, f = i & 15; const float inv = __powf(10000.0f, -(float)f / 16.0f); float s, c; sincosf((float)pos * inv, &s, &c);
        WSP(float, WS_ROPE)[2 * i] = c; WSP(float, WS_ROPE)[2 * i + 1] = s; }
    for (int i = gt; i < 2 * 256 * 256; i += NGT) { const int cs = i >> 16, r = (i >> 8) & 255, k = i & 255; float v = 0.f;
        if ((r >> 7) == (k >> 7)) { const int m = ((r & 127) * (k & 127)) & 127; v = (cs ? sinpif((float)m / 64.0f) : cospif((float)m / 64.0f)) * 0.08838834764831845f; }
        WSP(bf16_t, WS_ACS)[i] = (bf16_t)(cvt_pk_bf16(v, 0.f) & 0xffffu); }
    for (int i = gt; i < 256 * 512; i += NGT) { const int k = i >> 9, j = i & 511, n = j & 255; const int m = (k * n) & 255;
        const float v = (j < 256 ? cospif((float)m / 128.0f) : -sinpif((float)m / 128.0f)) * (0.0625f * DFT_PRESCALE);
        WSP(unsigned char, WS_DFTN)[(size_t)(4096 + k) * 8192 + j] = (unsigned char)(pack_fp8x4(v, 0.f, 0.f, 0.f) & 0xffu); }
    LAS float* tab = (LAS float*)(F.lds + 81920);
    for (int m = tid; m < 4096; m += NTHR) tab[m] = cospif((float)m / 2048.0f) * (0.015625f * DFT_PRESCALE);
    __syncthreads();
    for (int i = gt; i < 4096 * 1024; i += NGT) {
        const int k = i >> 10, j0 = (i & 1023) * 8; unsigned w[2];
#pragma unroll
        for (int q = 0; q < 2; ++q) { float v[4];
#pragma unroll
            for (int e = 0; e < 4; ++e) { const int j = j0 + 4 * q + e, n = j & 4095; const int m = (k * n) & 4095;
                v[e] = j < 4096 ? tab[m] : -tab[(m - 1024) & 4095]; }
            w[q] = pack_fp8x4(v[0], v[1], v[2], v[3]); }
        *(u32x2*)(WSP(unsigned char, WS_DFTN) + (size_t)k * 8192 + j0) = (u32x2){w[0], w[1]}; }
    __syncthreads();
    LAS float* scr = (LAS float*)(F.lds + wave * 16640);
    (void)scr;
    __syncthreads();
    quant_w<true>(F, F.in[F.zi + I_AQKV], 2, 3072, WSP(unsigned char, WS_WQKV), WSP(float, WS_WQKVS));
    quant_w<true>(F, F.in[F.zi + I_CPW1], 1, 2048, WSP(unsigned char, WS_PW1), WSP(float, WS_PW1S), 96);
    quant_w<true>(F, F.in[F.zi + I_AWO], 2, 1024, WSP(unsigned char, WS_WO), WSP(float, WS_WZS), 128);
    quant_w<true>(F, F.in[F.zi + I_FW], 1, 1024, WSP(unsigned char, WS_WF), WSP(float, WS_WZS) + 2048, 160);
    quant_w<true>(F, F.in[F.zi + I_CPW2], 1, 1024, WSP(unsigned char, WS_PW2), WSP(float, WS_WZS) + 3072, 176);
    quant_w<false>(F, F.in[F.zi + I_MW1], 128, 2048, WSP(unsigned char, WS_W1), WSP(float, WS_W1S));
    quant_w<true>(F, F.in[F.zi + I_MW2], 128, 1024, WSP(unsigned char, WS_W2), WSP(float, WS_W2S));
}
__device__ __forceinline__ void p1_modulate(Frame& F) {
    const int lane = hidden_tid(F.wave) & 63; const int gw = F.vcu * NWAVES + F.wave, NGW = F.G * NWAVES;
    const int per = (T_ALL + NGW - 1) / NGW, r0 = gw * per, r1 = min(T_ALL, r0 + per);
    int cic = -1; f32x4 psh[4], psc[4];
    for (int row = r0; row < r1; ++row) { const int ci = cond_of(row);
        if (ci != cic) { ld_rowB_f32(MODP(0, ci, 0), lane, psh); ld_rowB_f32(MODP(0, ci, 1), lane, psc); cic = ci; }
        f32x4 v[4]; ld_rowB_f32(xrow_in(F, 0, row), lane, v);
        st_rowB_bf16(WSP(bf16_t, WS_X) + (size_t)row * D, lane, v);
#pragma unroll
        for (int j = 0; j < 4; ++j) v[j] = v[j] * (1.0f + psc[j]) + psh[j];
        st_rowB_fp8(WSP(unsigned char, WS_U) + (size_t)row * D, lane, v); }
}
struct LRaw { u32x4 x0, x1, y0, y1; };
__device__ __forceinline__ void ln1_load(Frame& F, int row, int lane, LRaw& r) {
    const bf16_t* xp = WSP(const bf16_t, WS_X) + (size_t)row * D + 16 * lane; const bf16_t* yp = WSP(const bf16_t, WS_Y) + (size_t)row * D + 16 * lane;
    r.x0 = *(const u32x4*)xp; r.x1 = *(const u32x4*)(xp + 8); r.y0 = *(const u32x4*)yp; r.y1 = *(const u32x4*)(yp + 8);
}
__device__ __forceinline__ void unpack_bf16x16(const u32x4 w0, const u32x4 w1, f32x4 (&v)[4]) {
    v[0] = (f32x4){bf_lo(w0.x), bf_hi(w0.x), bf_lo(w0.y), bf_hi(w0.y)}; v[1] = (f32x4){bf_lo(w0.z), bf_hi(w0.z), bf_lo(w0.w), bf_hi(w0.w)};
    v[2] = (f32x4){bf_lo(w1.x), bf_hi(w1.x), bf_lo(w1.y), bf_hi(w1.y)}; v[3] = (f32x4){bf_lo(w1.z), bf_hi(w1.z), bf_lo(w1.w), bf_hi(w1.w)};
}
__device__ __forceinline__ void ln1_row(Frame& F, int layer, int row, int lane, const LRaw& raw, const LAS float* lgl, const f32x4 (&g1)[4], const f32x4 (&sc2)[4], const f32x4 (&sh2)[4], f32x4 (&v)[4]) {
    f32x4 y[4];
    unpack_bf16x16(raw.x0, raw.x1, v); unpack_bf16x16(raw.y0, raw.y1, y);
#pragma unroll
    for (int j = 0; j < 4; ++j) v[j] = DN_ALPHA * v[j] + g1[j] * y[j];
    { f32x4 lg[4], lb[4];
#pragma unroll
      for (int j = 0; j < 4; ++j) { lg[j] = *(const LAS f32x4*)(lgl + 4 * lane + 256 * j); lb[j] = *(const LAS f32x4*)(lgl + 1024 + 4 * lane + 256 * j); }
      layer_norm_row_r(v, lg, lb); }
    st_rowB_bf16(WSP(bf16_t, WS_X1) + (size_t)row * D, lane, v);
    float am = 0.f;
#pragma unroll
    for (int j = 0; j < 4; ++j) { v[j] = v[j] * (1.0f + sc2[j]) + sh2[j]; am = fmaxf(am, fmaxf(fmaxf(fabsf(v[j][0]), fabsf(v[j][1])), fmaxf(fabsf(v[j][2]), fabsf(v[j][3])))); }
    am = wave_max(am); const float qs = am > 0.f ? am * (1.0f / 127.0f) : 1.0f, qi = 1.0f / qs;
    *(u32x4*)(WSP(unsigned char, WS_V2) + (size_t)row * D + 16 * lane) = (u32x4){pack_i8x4(v[0][0] * qi, v[0][1] * qi, v[0][2] * qi, v[0][3] * qi), pack_i8x4(v[1][0] * qi, v[1][1] * qi, v[1][2] * qi, v[1][3] * qi),
        pack_i8x4(v[2][0] * qi, v[2][1] * qi, v[2][2] * qi, v[2][3] * qi), pack_i8x4(v[3][0] * qi, v[3][1] * qi, v[3][2] * qi, v[3][3] * qi)};
    if (lane == 0) WSP(float, WS_V2S)[row] = qs;
}
__device__ __forceinline__ float reduce_scatter32(float (&p)[32], int lane) {
    float q16[16], q8[8], q4[4], q2[2];
    { const bool up = (lane & 32) != 0;
#pragma unroll
      for (int i = 0; i < 16; ++i) { const float keep = up ? p[16 + i] : p[i], send = up ? p[i] : p[16 + i];
          auto rr = __builtin_amdgcn_permlane32_swap(__float_as_uint(send), __float_as_uint(send), false, false); q16[i] = keep + (up ? __uint_as_float(rr[0]) : __uint_as_float(rr[1])); } }
    { const bool up = (lane & 16) != 0;
#pragma unroll
      for (int i = 0; i < 8; ++i) { const float keep = up ? q16[8 + i] : q16[i], send = up ? q16[i] : q16[8 + i]; q8[i] = keep + sx<16>(send); } }
    { const bool up = (lane & 8) != 0;
#pragma unroll
      for (int i = 0; i < 4; ++i) { const float keep = up ? q8[4 + i] : q8[i], send = up ? q8[i] : q8[4 + i]; q4[i] = keep + sx<8>(send); } }
    { const bool up = (lane & 4) != 0;
#pragma unroll
      for (int i = 0; i < 2; ++i) { const float keep = up ? q4[2 + i] : q4[i], send = up ? q4[i] : q4[2 + i]; q2[i] = keep + sx<4>(send); } }
    float r; { const bool up = (lane & 2) != 0; const float keep = up ? q2[1] : q2[0], send = up ? q2[0] : q2[1]; r = keep + sx<2>(send); }
    return r + sx<1>(r);
}
__device__ __forceinline__ void route_token(Frame& F, int row, int lane, float lg, LAS float* ws, volatile LAS int* hist) {
    const int e = (lane >> 1) & 31;
    if ((lane & 1) == 0) ws[e] = lg;
    LDS_WAIT();
    int rank = 0;
#pragma unroll
    for (int q = 0; q < 8; ++q) { const f32x4 o = *(const LAS f32x4*)(ws + 4 * q);
#pragma unroll
        for (int j = 0; j < 4; ++j) { const int e2 = 4 * q + j; rank += (o[j] > lg || (o[j] == lg && e2 < e)) ? 1 : 0; } }
    if (rank < 4 && (lane & 1) == 0) ws[32 + rank] = lg;
    LDS_WAIT();
    const f32x4 tv = *(const LAS f32x4*)(ws + 32);
    const float e1 = __expf(tv[1] - tv[0]), e2 = __expf(tv[2] - tv[0]), e3 = __expf(tv[3] - tv[0]); const float inv = 1.0f / (1.0f + e1 + e2 + e3);
    if (rank < 4 && (lane & 1) == 0) {
        WSP(int, WS_TOPK)[(size_t)row * 4 + rank] = e; WSP(float, WS_GATE)[(size_t)row * 4 + rank] = __expf(lg - tv[0]) * inv;
        int one_ = 1; asm volatile("" : "+v"(one_)); __hip_atomic_fetch_add((LAS int*)(hist + e), one_, __ATOMIC_RELAXED, __HIP_MEMORY_SCOPE_WORKGROUP); }
}
__device__ __forceinline__ void phase_ln1_router(Frame& F, int layer, int nrows, bool count) {
    const int tid = hidden_tid(F.wave), lane = tid & 63;
    LAS float* wt = (LAS float*)F.lds;
    LAS float* wsc = (LAS float*)(F.lds + 131072) + F.wave * 128;
    volatile LAS int* hist = (volatile LAS int*)(F.lds + MISC_OFF + 64);
    const float* Wr = F.in[F.zi + I_RW] + (size_t)layer * 1024 * 32;
    for (int i = tid; i < 32768; i += NTHR) wt[(i & 31) * 1024 + permB(i >> 5)] = Wr[i];
    if (tid < 32) hist[tid] = 0;
    { u32x4* rt = WSP(u32x4, WS_ROWTOK); int gstep = F.G * NTHR; asm volatile("" : "+s"(gstep));
      unsigned zz = 0u; asm volatile("" : "+v"(zz));
#pragma clang loop vectorize(disable) unroll(disable)
      for (int p = F.vcu * NTHR + tid; p < P_MAX / 4; p += gstep) rt[p] = (u32x4){zz, zz, zz, zz}; }
    LAS float* lgl = (LAS float*)(F.lds + 131072 + 4096);
    for (int i = tid; i < 2048; i += NTHR) lgl[(i & 1024) + permB(i & 1023)] = i < 1024 ? F.in[F.zi + I_LN1G][layer * D + i] : F.in[F.zi + I_LN1B][layer * D + i - 1024];
    __syncthreads();
    f32x4 pg1[4], psc[4], psh[4];
    const float rbias = F.in[F.zi + I_RB][layer * 32 + ((lane >> 1) & 31)];
    const int gw = F.vcu * NWAVES + F.wave, NGW = F.G * NWAVES;
    const int npairs = nrows / 2, per = (npairs + NGW - 1) / NGW, p0 = gw * per, p1 = min(npairs, p0 + per);
    int cic = -1;
    LRaw ra, rb;
    if (p0 < p1) { ln1_load(F, 2 * p0, lane, ra); ln1_load(F, 2 * p0 + 1, lane, rb); }
    for (int pr = p0; pr < p1; ++pr) {
        const int ci = cond_of(2 * pr);
        if (ci != cic) { ld_rowB_f32(MODP(layer, ci, 2), lane, pg1); ld_rowB_f32(MODP(layer, ci, 4), lane, psc); ld_rowB_f32(MODP(layer, ci, 3), lane, psh); cic = ci; }
        f32x4 va[4], vb[4];
        ln1_row(F, layer, 2 * pr, lane, ra, lgl, pg1, psc, psh, va); ln1_row(F, layer, 2 * pr + 1, lane, rb, lgl, pg1, psc, psh, vb);
        { const int pn = pr + 1 < p1 ? pr + 1 : pr; ln1_load(F, 2 * pn, lane, ra); ln1_load(F, 2 * pn + 1, lane, rb); }
        float pa[32], pb[32];
#pragma unroll
        for (int e = 0; e < 32; ++e) { f32x2 sa = (f32x2){0.f, 0.f}, sb = sa;
#pragma unroll
            for (int j = 0; j < 4; ++j) { const f32x4 w = *(const LAS f32x4*)(wt + e * 1024 + 4 * lane + 256 * j);
                const f32x2 wl = __builtin_shufflevector(w, w, 0, 1), wh = __builtin_shufflevector(w, w, 2, 3);
                sa = __builtin_elementwise_fma(__builtin_shufflevector(va[j], va[j], 0, 1), wl, sa); sa = __builtin_elementwise_fma(__builtin_shufflevector(va[j], va[j], 2, 3), wh, sa);
                sb = __builtin_elementwise_fma(__builtin_shufflevector(vb[j], vb[j], 0, 1), wl, sb); sb = __builtin_elementwise_fma(__builtin_shufflevector(vb[j], vb[j], 2, 3), wh, sb); }
            pa[e] = sa.x + sa.y; pb[e] = sb.x + sb.y; }
        const float la = reduce_scatter32(pa, lane) + rbias, lbv = reduce_scatter32(pb, lane) + rbias;
        route_token(F, 2 * pr, lane, la, wsc, hist); route_token(F, 2 * pr + 1, lane, lbv, wsc + 64, hist);
    }
    __syncthreads();
    if (tid < 32 && count) { const int hv = hist[tid]; if (hv) __hip_atomic_fetch_add(F.ctl + CW_CNT + layer * 32 + tid, (unsigned)hv, RLX_AGENT); }
}
__device__ __forceinline__ volatile LAS int* moe_tables(Frame& F, int layer) {
    volatile LAS int* ts = (volatile LAS int*)(F.lds + MISC_OFF + 256);
    if (hidden_tid(F.wave) == 0) { int acc = 0; for (int e = 0; e < 32; ++e) { ts[e] = acc; acc += ((int)__hip_atomic_load(F.ctl + CW_CNT + layer * 32 + e, RLX_AGENT) + 255) >> 8; } ts[32] = acc; }
    __syncthreads();
    return ts;
}
__device__ __forceinline__ void phase_assign(Frame& F, int layer, int nrows) {
    const int tid = hidden_tid(F.wave);
    volatile LAS int* ts = moe_tables(F, layer);
    volatile LAS int* lcnt = (volatile LAS int*)(F.lds + MISC_OFF + 512);
    volatile LAS int* lbase = (volatile LAS int*)(F.lds + MISC_OFF + 640);
    if (tid < 32) lcnt[tid] = 0;
    __syncthreads();
    const int chunk = (nrows + F.G - 1) / F.G, r0 = F.vcu * chunk, r1 = min(nrows, r0 + chunk);
    const int* tk = WSP(const int, WS_TOPK);
    int one_ = 1; asm volatile("" : "+v"(one_));
    for (int i = r0 * 4 + tid; i < r1 * 4; i += NTHR) __hip_atomic_fetch_add((LAS int*)(lcnt + tk[i]), one_, __ATOMIC_RELAXED, __HIP_MEMORY_SCOPE_WORKGROUP);
    __syncthreads();
    if (tid < 32) { const int n = lcnt[tid]; int base = ts[tid] * 256; if (n) base += (int)__hip_atomic_fetch_add(F.ctl + CW_CUR + layer * 32 + tid, (unsigned)n, RLX_AGENT); lbase[tid] = base; lcnt[tid] = 0; }
    __syncthreads();
    int* rt = WSP(int, WS_ROWTOK); int* pos = WSP(int, WS_POS); float* sap = WSP(float, WS_SAP); const float* sa = WSP(const float, WS_V2S);
    for (int i = r0 * 4 + tid; i < r1 * 4; i += NTHR) { const int e = tk[i]; const int p = lbase[e] + __hip_atomic_fetch_add((LAS int*)(lcnt + e), one_, __ATOMIC_RELAXED, __HIP_MEMORY_SCOPE_WORKGROUP); rt[p] = i >> 2; pos[i] = p; sap[p] = sa[i >> 2]; }
}
__device__ __forceinline__ void combine_row(Frame& F, int layer, int row, int lane, bool last, bool fp8u, const int4 ps, const f32x4 gt, const f32x4 (&lg)[4], const f32x4 (&lb)[4], const f32x4 (&pg2)[4], const f32x4 (&psc)[4], const f32x4 (&psh)[4]) {
    const int pk[4] = {ps.x, ps.y, ps.z, ps.w};
    f32x4 y[4][4], v[4];
    ld_rowB_bf16(WSP(const bf16_t, WS_X1) + (size_t)row * D, lane, v);
#pragma unroll
    for (int k = 0; k < 4; ++k) ld_rowB_fp8(WSP(const unsigned char, WS_Y2) + (size_t)pk[k] * D, lane, y[k]);
    f32x4 a[4];
#pragma unroll
    for (int j = 0; j < 4; ++j) { a[j] = (gt[0] * y[0][j] + gt[1] * y[1][j]) + (gt[2] * y[2][j] + gt[3] * y[3][j]); v[j] = DN_ALPHA * v[j] + (pg2[j] * (1.0f / Y2_PRESCALE)) * a[j]; }
    layer_norm_row_r(v, lg, lb);
    if (last) { st_rowB_f32(F.out + (size_t)row * D, lane, v); }
    else { st_rowB_bf16(WSP(bf16_t, WS_X) + (size_t)row * D, lane, v);
#pragma unroll
        for (int j = 0; j < 4; ++j) v[j] = v[j] * (1.0f + psc[j]) + psh[j];
        if (fp8u) st_rowB_fp8(WSP(unsigned char, WS_U) + (size_t)row * D, lane, v);
        else st_rowB_bf16(WSP(bf16_t, WS_U) + (size_t)row * D, lane, v); }
}
__device__ __forceinline__ void phase_combine_ln2(Frame& F, int layer, int nrows) {
    const int lane = hidden_tid(F.wave) & 63; const bool last = layer == DEPTH - 1; const bool fp8u = (layer + 1) % 3 != 1;
    f32x4 lg[4], lb[4], pg2[4], psc[4], psh[4]; ld_rowB_f32(F.in[F.zi + I_LN2G] + layer * D, lane, lg); ld_rowB_f32(F.in[F.zi + I_LN2B] + layer * D, lane, lb);
    const int gw = F.vcu * NWAVES + F.wave, NGW = F.G * NWAVES;
    const int npairs = nrows / 2, per = (npairs + NGW - 1) / NGW, p0 = gw * per, p1 = min(npairs, p0 + per);
    const int4* posp = WSP(const int4, WS_POS); const f32x4* gatp = WSP(const f32x4, WS_GATE);
    int cic = -1;
    int4 psa, psb; f32x4 gta, gtb;
    if (p0 < p1) { psa = posp[2 * p0]; psb = posp[2 * p0 + 1]; gta = gatp[2 * p0]; gtb = gatp[2 * p0 + 1]; }
    for (int pr = p0; pr < p1; ++pr) {
        const int ci = cond_of(2 * pr);
        if (ci != cic) { ld_rowB_f32(MODP(layer, ci, 5), lane, pg2); if (!last) { ld_rowB_f32(MODP(layer + 1, ci, 1), lane, psc); ld_rowB_f32(MODP(layer + 1, ci, 0), lane, psh); } cic = ci; }
        const int4 ca = psa, cb = psb; const f32x4 ga = gta, gb = gtb;
        const int pn = pr + 1 < p1 ? pr + 1 : pr;
        psa = posp[2 * pn]; psb = posp[2 * pn + 1]; gta = gatp[2 * pn]; gtb = gatp[2 * pn + 1];
        combine_row(F, layer, 2 * pr, lane, last, fp8u, ca, ga, lg, lb, pg2, psc, psh);
        combine_row(F, layer, 2 * pr + 1, lane, last, fp8u, cb, gb, lg, lb, pg2, psc, psh);
    }
}
__device__ __forceinline__ void phase_dwconv(Frame& F) {
    const int tid = hidden_tid(F.wave), lane = tid & 63, wave = __builtin_amdgcn_readfirstlane(tid >> 6);
    LAS unsigned* tile = (LAS unsigned*)F.lds;
    LAS float* red = (LAS float*)(F.lds + 126976);
    const float* wdw = F.in[F.zi + I_CWDW]; f32x2 wv[31];
#pragma unroll
    for (int j = 0; j < 31; ++j) { unsigned bo = (unsigned)(j * D + 2 * tid) * 4u; asm volatile("" : "+v"(bo));
        wv[j] = *(const f32x2*)((const char*)wdw + bo); }
    const f32x2 bdw = *(const f32x2*)(F.in[F.zi + I_CBDW] + 2 * tid), lng = *(const f32x2*)(F.in[F.zi + I_CLNG] + 2 * tid), lnb = *(const f32x2*)(F.in[F.zi + I_CLNB] + 2 * tid);
    const bf16_t* Gin = WSP(const bf16_t, WS_G); unsigned char* outp = WSP(unsigned char, WS_MIX);
    for (int un = F.vcu; un < 1024 + 64; un += F.G) {
        int seq0, slen, t0;
        if (un < 1024) { seq0 = (un >> 7) * SEQ; slen = SEQ; t0 = (un & 127) * 32; } else { const int q = un - 1024; seq0 = T_LAT + (q >> 3) * CTXL; slen = CTXL; t0 = (q & 7) * 32; }
        __syncthreads();
        { const int rb_ = tid >> 7, ch = tid & 127;
#pragma unroll 1
          for (int qb = 0; qb < 4; ++qb) { u32x4 v[4];
#pragma unroll
              for (int u = 0; u < 4; ++u) { const int r = rb_ + 4 * (4 * qb + u), t = t0 - 15 + r; const int tc = t < 0 ? 0 : (t >= slen ? slen - 1 : t);
                  v[u] = *(const u32x4*)(Gin + (size_t)(seq0 + tc) * D + ch * 8); }
#pragma unroll
              for (int u = 0; u < 4; ++u) { const int r = rb_ + 4 * (4 * qb + u), t = t0 - 15 + r; const bool ok = t >= 0 && t < slen;
                  const u32x4 w = ok ? v[u] : (u32x4){0u, 0u, 0u, 0u};
                  if (r < 62) *(LAS u32x4*)(tile + r * 512 + ch * 4) = w; } } }
        __syncthreads();
        for (int hf = 0; hf < 2; ++hf) {
            f32x2 ov[16];
#pragma unroll
            for (int t = 0; t < 16; ++t) ov[t] = bdw;
            const LAS unsigned* tp = tile + hf * 16 * 512 + tid;
#pragma unroll
            for (int r = 0; r < 46; ++r) { const unsigned w = tp[r * 512]; const f32x2 xv = (f32x2){bf_lo(w), bf_hi(w)};
#pragma unroll
                for (int t = 0; t < 16; ++t) { const int j = r - t; if (j >= 0 && j < 31) ov[t] = __builtin_elementwise_fma(wv[j], xv, ov[t]); }
                if ((r & 7) == 7) __builtin_amdgcn_sched_barrier(0); }
            float o0[16], o1[16];
#pragma unroll
            for (int t = 0; t < 16; ++t) { o0[t] = ov[t].x; o1[t] = ov[t].y; }
#pragma unroll
            for (int t = 0; t < 16; ++t) { float s = o0[t] + o1[t], q = o0[t] * o0[t] + o1[t] * o1[t]; s = wave_sum(s); q = wave_sum(q);
                if (lane == 0) { red[(wave * 16 + t) * 2] = s; red[(wave * 16 + t) * 2 + 1] = q; } }
            __syncthreads();
#pragma unroll
            for (int t = 0; t < 16; t += 2) { unsigned pk2[2];
#pragma unroll
                for (int u = 0; u < 2; ++u) { float s = 0.f, q = 0.f;
#pragma unroll
                    for (int w = 0; w < 8; ++w) { s += red[(w * 16 + t + u) * 2]; q += red[(w * 16 + t + u) * 2 + 1]; }
                    const float mean = s * (1.0f / D), var = fmaxf(q * (1.0f / D) - mean * mean, 0.f), rstd = rsqrtf(var + ln_eps());
                    const float a0 = (o0[t + u] - mean) * rstd * lng.x + lnb.x, a1 = (o1[t + u] - mean) * rstd * lng.y + lnb.y;
                    pk2[u] = pack_fp8x4(a0 * fast_sigmoid(a0) * MIX_PRESCALE, a1 * fast_sigmoid(a1) * MIX_PRESCALE, 0.f, 0.f) & 0xffffu; }
                const bool odd = (tid & 1) != 0;
                const unsigned got = __float_as_uint(sx<1>(__uint_as_float(odd ? pk2[0] : pk2[1])));
                const unsigned word = odd ? (got | (pk2[1] << 16)) : (pk2[0] | (got << 16));
                *(unsigned*)(outp + (size_t)(seq0 + t0 + hf * 16 + t + (odd ? 1 : 0)) * D + 2 * (tid & ~1)) = word; }
            __syncthreads();
        }
    }
}
constexpr int NPHASE = 2 + 8 * DEPTH;
__global__ void __launch_bounds__(NTHR, 2) fwd(Args args) {
    extern __shared__ __attribute__((aligned(16))) unsigned char lds_raw[];
    Frame F;
    F.lds = (LAS unsigned char*)lds_raw; F.MISC = (volatile LAS unsigned*)(F.lds + MISC_OFF);
    F.tid = threadIdx.x; F.lane = F.tid & 63; F.wave = __builtin_amdgcn_readfirstlane(F.tid >> 6);
    F.G = gridDim.x; { const int bx = blockIdx.x; F.vcu = (F.G % 8 == 0) ? (bx % 8) * (F.G / 8) + bx / 8 : bx; }
    F.ws = args.ws; F.ctl = (unsigned*)(args.ws + WS_CTL); F.in = args.in; F.out = args.out; F.zi = 0;
    for (int u = F.tid; u < 512; u += NTHR) ((LAS unsigned*)(F.lds + MISC_OFF))[u] = 0u;
    __syncthreads();

    const int lo = args.ph_lo, hi = args.ph_hi;
    XcdBarrier bar; bar.bar = F.ctl + CW_BAR; bar.x = 0; bar.st = nullptr;
    if (hi - lo > 1) bar = xcd_barrier_post(F.ctl + CW_BAR, F.MISC);
#define IN(k) (lo <= (k) && (k) < hi)
#define SEAM(k) do { if (IN(k) && IN((k) + 1)) xcd_barrier(bar, F.wave); } while (0)
    int bx = (int)blockIdx.x; const int vcu0 = F.vcu, wave0 = F.wave; const unsigned xcc0 = bar.x;

    if (EN(0) && IN(0)) { for (int rep = 0; rep < NREP(0); ++rep) { __syncthreads(); p0_prologue(F); } } SEAM(0);
    if (EN(1) && IN(1)) { for (int rep = 0; rep < NREP(1); ++rep) { __syncthreads(); p1_modulate(F); } } SEAM(1);

    for (int layer = 0; layer < DEPTH; ++layer) {
        {
            const int z_ = __builtin_amdgcn_readfirstlane((int)F.MISC[2]);
            F.zi = z_; F.ws = args.ws + z_; F.out = args.out + z_; F.ctl = (unsigned*)(F.ws + WS_CTL); bar.bar = F.ctl + CW_BAR;
            F.G = (int)gridDim.x + z_; F.vcu = vcu0 + z_; bx = (int)blockIdx.x + z_; F.lds = (LAS unsigned char*)lds_raw + z_; F.MISC = (volatile LAS unsigned*)(F.lds + MISC_OFF); bar.st = F.MISC; bar.x = xcc0 + (unsigned)z_; F.wave = wave0 + z_; }
        const int pb = 2 + 8 * layer, kind = layer % 3, jj = layer / 3; const bool last = layer == DEPTH - 1;
        const int nrows = last ? T_LAT : T_ALL;
        if (IN(pb + 0)) for (int rep = 0; rep < NREP(kind == 0 ? 2 : (kind == 1 ? 3 : 4)); ++rep) {
            if (EN(2) && kind == 0) {
                const unsigned char* W8 = WSP(const unsigned char, WS_WQKV) + (size_t)jj * 3072 * 1024; const float* sw = WSP(const float, WS_WQKVS) + jj * 3072;
                { DenseSched S; S.init8(WSP(const unsigned char, WS_U), W8, T_ALL, 2048, 1024, 1024, F.G, bx);
                  EpiQK8 E{WSP(unsigned char, WS_Q), WSP(const float, WS_ROPE), sw};
                  g8::gemm_phase(F.lds, S, E, F.wave); }
                { VtSched S; S.init(W8 + (size_t)2048 * 1024, WSP(const unsigned char, WS_U), F.G, bx);
                  EpiVt8 E{WSP(unsigned char, WS_V), sw + 2048};
                  g8::gemm_phase(F.lds, S, E, F.wave); }
            } else if (EN(3) && kind == 1) {
                F1Sched S; S.init(WSP(const bf16_t, WS_ACS), WSP(const bf16_t, WS_U), F.G, bx);
                EpiFp8T<0> E{WSP(unsigned char, WS_YT), 8192, 1.0f};
                g8::gemm_phase(F.lds, S, E, F.wave);
            } else if (EN(4) && kind == 2) {
                GatedSched S; S.init8(WSP(const unsigned char, WS_U), WSP(const unsigned char, WS_PW1), T_ALL, 1024, 1024, 1024, F.G, bx);
                EpiGlu8 E{WSP(bf16_t, WS_G), 1024, F.in[F.zi + I_CBPW1], WSP(const float, WS_PW1S), 1024};
                g8::gemm_phase(F.lds, S, E, F.wave);
            }
        }
        SEAM(pb + 0);
        if (IN(pb + 1)) for (int rep = 0; rep < NREP(kind == 0 ? 5 : (kind == 1 ? 6 : 7)); ++rep) {
            if (EN(5) && kind == 0) {
                const float li = 0.8f - 0.6f * __expf(-0.3f * (float)layer);
                const int ln_ = hidden_tid(F.wave) & 63; const float d1 = wave_sum(F.in[F.zi + I_LQ1][jj * 64 + ln_] * F.in[F.zi + I_LK1][jj * 64 + ln_]), d2 = wave_sum(F.in[F.zi + I_LQ2][jj * 64 + ln_] * F.in[F.zi + I_LK2][jj * 64 + ln_]);
                att::Params P{WSP(const unsigned char, WS_Q), WSP(const unsigned char, WS_K), WSP(const unsigned char, WS_V), WSP(unsigned char, WS_MIX), WSP(float, WS_ASCR), F.in[F.zi + I_SUBLN] + jj * 128, __expf(d1) - __expf(d2) + li, (1.0f - li) * MIX_PRESCALE, F.wave};
                const int nun = last ? 1024 : 1024 + 64;
#if ATT_PROBE
                for (int un = F.vcu; un < nun; un += F.G) {
                    int b, h, q0, tb;
                    if (un < 1024) { b = un >> 7; h = (un >> 4) & 7; q0 = b * SEQ + (un & 15) * 256; tb = 0; } else { const int q = un - 1024; b = q >> 3; h = q & 7; q0 = T_LAT + b * CTXL; tb = 64; }
                    for (int c = 0; c < 2; ++c) att::unit<8, ATT_PROBE>(P, b, h, c, q0, tb, 68, F.lds);
                }
                __syncthreads();
#endif
                for (int un = F.vcu; un < nun; un += F.G) {
                    int b, h, q0, tb;
                    if (un < 1024) { b = un >> 7; h = (un >> 4) & 7; q0 = b * SEQ + (un & 15) * 256; tb = 0; } else { const int q = un - 1024; b = q >> 3; h = q & 7; q0 = T_LAT + b * CTXL; tb = 64; }
                    for (int c = 0; c < 2; ++c) att::unit<8>(P, b, h, c, q0, tb, 68, F.lds);
                }
            } else if (EN(6) && kind == 1) {
                F2Sched S; S.init(WSP(const unsigned char, WS_DFTN), WSP(const unsigned char, WS_YT), F.G, bx); EpiFp8T<2> E{WSP(unsigned char, WS_MIX), 1024, MIX_PRESCALE / DFT_PRESCALE}; g8::gemm_phase(F.lds, S, E, F.wave);
            } else if (EN(7) && kind == 2) {
                __syncthreads(); phase_dwconv(F);
            }
        }
        SEAM(pb + 1);
        if (EN(8) && IN(pb + 2)) for (int rep = 0; rep < NREP(8); ++rep) {
            const unsigned char* Bt = WSP(const unsigned char, 0) + (kind == 0 ? WS_WO + (size_t)jj * 1024 * 1024 : (kind == 1 ? WS_WF : WS_PW2));
            const float* wsc = WSP(const float, WS_WZS) + (kind == 0 ? jj : kind + 1) * 1024;
            const float* bias = kind == 0 ? (const float*)(F.ws + WS_CTL + 524288) : (kind == 1 ? F.in[F.zi + I_FB] : F.in[F.zi + I_CBPW2]);
            DenseSched S; S.init8(WSP(const unsigned char, WS_MIX), Bt, nrows, 1024, 1024, 1024, F.G, bx);
            EpiBf16T<2> E{WSP(bf16_t, WS_Y), 1024, bias, 0, wsc, 1.0f / MIX_PRESCALE};
            g8::gemm_phase(F.lds, S, E, F.wave);
        }
        SEAM(pb + 2);
        if (EN(9) && IN(pb + 3)) { for (int rep = 0; rep < NREP(9); ++rep) { __syncthreads(); phase_ln1_router(F, layer, nrows, rep == 0); } } SEAM(pb + 3);
        if (EN(10) && IN(pb + 4)) { phase_assign(F, layer, nrows); } SEAM(pb + 4);
        if (EN(11) && IN(pb + 5)) for (int rep = 0; rep < NREP(11); ++rep) {
            volatile LAS int* ts = MK_MULTI ? moe_tables(F, layer) : (volatile LAS int*)(F.lds + MISC_OFF + 256);
            MoeSched<true> S; S.init(WSP(const char, WS_V2), WSP(const char, WS_W1) + (size_t)layer * 32 * 2048 * 1024, WSP(const int, WS_ROWTOK), ts, F.G, bx, F.wave);
            EpiGatedI8 E{WSP(unsigned char, WS_H), F.in[F.zi + I_MB1] + (size_t)layer * 32 * 2048, WSP(const float, WS_W1S) + (size_t)layer * 32 * 2048, WSP(const float, WS_SAP)};
#if MOE_PROBE
            { EpiGatedI8T<(MOE_PROBE >> 4)> EP{E.O, E.bias, E.sw, E.sap};
              g8::gemm_phase<EpiGatedI8T<(MOE_PROBE >> 4)>, MoeSched<true>, (MOE_PROBE & 15)>(F.lds, S, EP, F.wave); __syncthreads(); }
#endif
            g8::gemm_phase(F.lds, S, E, F.wave);
        }
        SEAM(pb + 5);
        if (EN(12) && IN(pb + 6)) for (int rep = 0; rep < NREP(12); ++rep) {
            volatile LAS int* ts = MK_MULTI ? moe_tables(F, layer) : (volatile LAS int*)(F.lds + MISC_OFF + 256);
            MoeSched<false> S; S.init(WSP(const char, WS_H), WSP(const char, WS_W2) + (size_t)layer * 32 * 1024 * 1024, nullptr, ts, F.G, bx, F.wave);
            EpiY2 E{WSP(unsigned char, WS_Y2), F.in[F.zi + I_MB2] + (size_t)layer * 32 * 1024, WSP(const float, WS_W2S) + (size_t)layer * 32 * 1024};
            g8::gemm_phase(F.lds, S, E, F.wave);
        }
        SEAM(pb + 6);
        if (EN(13) && IN(pb + 7)) { for (int rep = 0; rep < NREP(13); ++rep) { __syncthreads(); phase_combine_ln2(F, layer, nrows); } } SEAM(pb + 7);
    }
#undef IN
#undef SEAM
}

extern "C" void kernel_launch(void* const* d_in, const int* in_sizes, int n_in, void* d_out, int out_size, void* d_ws, size_t ws_size, hipStream_t stream) {
    static int grid = 0;
    if (grid == 0) {
        if (n_in != 33 || out_size != T_LAT * D || ws_size < WS_END) { fprintf(stderr, "kernel_launch: unexpected shapes (n_in %d, out %d, ws %zu < %zu); nothing launched\n", n_in, out_size, ws_size, (size_t)WS_END); grid = -1; return; }
        int dev = 0, cus = 0, per_cu = 0;
        if (hipGetDevice(&dev) != hipSuccess || hipDeviceGetAttribute(&cus, hipDeviceAttributeMultiprocessorCount, dev) != hipSuccess) { grid = -1; return; }
        if (hipFuncSetAttribute((const void*)fwd, hipFuncAttributeMaxDynamicSharedMemorySize, LDS_BYTES) != hipSuccess) { fprintf(stderr, "kernel_launch: hipFuncSetAttribute failed\n"); grid = -1; return; }
        if (hipOccupancyMaxActiveBlocksPerMultiprocessor(&per_cu, (const void*)fwd, NTHR, LDS_BYTES) != hipSuccess || per_cu < 1) fprintf(stderr, "kernel_launch: occupancy query says %d blocks per CU\n", per_cu);
        (void)hipGetLastError();
        grid = cus < 256 ? cus : 256;
    }
    if (grid < 0) return;
    if (hipMemsetAsync((char*)d_ws + WS_CTL, 0, CTL_ZERO_BYTES, stream) != hipSuccess) return;
    Args a{};
    for (int i = 0; i < 33; ++i) a.in[i] = (const float*)d_in[i];
    a.out = (float*)d_out; a.ws = (unsigned char*)d_ws;
#if MK_MULTI
    for (int p = 0; p < NPHASE; ++p) { a.ph_lo = p; a.ph_hi = p + 1; hipLaunchKernelGGL(fwd, dim3(grid), dim3(NTHR), LDS_BYTES, stream, a); }
#else
    a.ph_lo = 0; a.ph_hi = NPHASE;
    hipLaunchKernelGGL(fwd, dim3(grid), dim3(NTHR), LDS_BYTES, stream, a);
#endif
    const hipError_t le = hipPeekAtLastError();
    if (le != hipSuccess) fprintf(stderr, "kernel_launch: launch failed: %s\n", hipGetErrorName(le));
}
```

```cpp
#include <hip/hip_runtime.h>
#include <cstdio>
#include <cstdint>

#ifndef MK_MULTI
#define MK_MULTI 0
#endif
#ifndef PH_MASK
#define PH_MASK 0xffffffffu
#endif
#define EN(k) (((PH_MASK) >> (k)) & 1u)
#ifndef REP_MASK
#define REP_MASK 0u
#endif
#ifndef MOE_PROBE
#define MOE_PROBE 0
#endif
#ifndef ATT_GSH
#define ATT_GSH 0
#endif
#ifndef ATT_PROBE
#define ATT_PROBE 0
#endif
#define NREP(k) ((((REP_MASK) >> (k)) & 1u) ? 2 : 1)

#define LAS __attribute__((address_space(3)))
#define GAS __attribute__((address_space(1)))
typedef unsigned short bf16_t;
typedef short bf16x8 __attribute__((ext_vector_type(8)));
typedef short s16x4 __attribute__((ext_vector_type(4)));
typedef float f32x2 __attribute__((ext_vector_type(2)));
typedef float f32x4 __attribute__((ext_vector_type(4)));
typedef float f32x16 __attribute__((ext_vector_type(16)));
typedef unsigned u32x2 __attribute__((ext_vector_type(2)));
typedef unsigned u32x4 __attribute__((ext_vector_type(4)));
typedef int i32x4 __attribute__((ext_vector_type(4)));
typedef int i32x8 __attribute__((ext_vector_type(8)));

constexpr int D = 1024, NB = 8, SEQ = 4096, CTXL = 256, DEPTH = 4;
constexpr int T_LAT = NB * SEQ, T_CTX = NB * CTXL, T_ALL = T_LAT + T_CTX;
constexpr int NE = 32, TOPK = 4, P_MAX = 147456;
constexpr float LN_EPS = 1e-5f;
constexpr float DN_ALPHA = 1.6817928305074290f;
constexpr float ATT_C2 = 0.125f * 1.4426950408889634f;
constexpr int NWAVES = 8, NTHR = 512;
constexpr float H_PRESCALE = 7.5f, FP8_TOP = 440.0f, Q_PRESCALE = 16.0f;
constexpr float MIX_PRESCALE = 1.0f;
constexpr float Y2_PRESCALE = 16.0f;
constexpr float DFT_PRESCALE = 64.0f;
constexpr int VT_PITCH = 4352;

constexpr size_t MiB = 1u << 20;
constexpr size_t WS_CTL = 0, CTL_ZERO_BYTES = 1 * MiB;
constexpr size_t WS_MOD = 1 * MiB;
constexpr size_t WS_ROPE = 2 * MiB;
constexpr size_t WS_ACS = 2 * MiB + 65536;
constexpr size_t WS_DFTN = 4 * MiB;
constexpr size_t WS_WQKV = 72 * MiB;
constexpr size_t WS_WO = 84 * MiB;
constexpr size_t WS_WF = 88 * MiB;
constexpr size_t WS_PW1 = 90 * MiB;
constexpr size_t WS_PW2 = 94 * MiB;
constexpr size_t WS_W1 = 96 * MiB;
constexpr size_t WS_W2 = 608 * MiB;
constexpr size_t WS_X = 864 * MiB;
constexpr size_t WS_X1 = 1000 * MiB;
constexpr size_t WS_U = 1136 * MiB;
constexpr size_t WS_Q = 1204 * MiB, WS_K = 1272 * MiB, WS_V = 1340 * MiB;
constexpr size_t WS_MIX = 1408 * MiB;
constexpr size_t WS_Y = 1476 * MiB;
constexpr size_t WS_V2 = 1544 * MiB;
constexpr size_t WS_G = 1612 * MiB;
constexpr size_t WS_YT = 1680 * MiB;
constexpr size_t WS_YTC = 1808 * MiB;
constexpr size_t WS_H = 1936 * MiB;
constexpr size_t WS_Y2 = 2224 * MiB;
constexpr size_t WS_TOPK = 2512 * MiB;
constexpr size_t WS_GATE = 2513 * MiB;
constexpr size_t WS_POS = 2514 * MiB;
constexpr size_t WS_ROWTOK = 2515 * MiB;
constexpr size_t WS_ASCR = 2516 * MiB;
constexpr size_t WS_W1S = 2548 * MiB;
constexpr size_t WS_V2S = 2549 * MiB;
constexpr size_t WS_W2S = 2550 * MiB;
constexpr size_t WS_WQKVS = 2551 * MiB;
constexpr size_t WS_PW1S = 2551 * MiB + 65536;
constexpr size_t WS_WZS = 2551 * MiB + 131072;
constexpr size_t WS_SAP = 2552 * MiB;
constexpr size_t WS_END = 2553 * MiB;
constexpr int CW_TMO = 0, CW_BAR = 4096, CW_CNT = 16384, CW_CUR = 16384 + 1024;

constexpr int LDS_BYTES = 147456;
constexpr int RING_BYTES = 131072;
constexpr int MISC_OFF = LDS_BYTES - 2048;

#define RLX_AGENT __ATOMIC_RELAXED, __HIP_MEMORY_SCOPE_AGENT
#define LDS_WAIT() asm volatile("s_waitcnt lgkmcnt(0)" ::: "memory")
#define VM_WAIT() asm volatile("s_waitcnt vmcnt(0)" ::: "memory")
__device__ __forceinline__ unsigned cvt_pk_bf16(float lo, float hi) { unsigned r; asm volatile("v_cvt_pk_bf16_f32 %0, %1, %2" : "=v"(r) : "v"(lo), "v"(hi)); return r; }
__device__ __forceinline__ float bf_lo(unsigned w) { return __uint_as_float(w << 16); }
__device__ __forceinline__ float bf_hi(unsigned w) { return __uint_as_float(w & 0xffff0000u); }
template <int M> __device__ __forceinline__ float sx(float v) { return __int_as_float(__builtin_amdgcn_ds_swizzle(__float_as_int(v), 0x1f | (M << 10))); }
__device__ __forceinline__ float sum32x(float v) { auto rr = __builtin_amdgcn_permlane32_swap(__float_as_uint(v), __float_as_uint(v), false, false); return __uint_as_float(rr[0]) + __uint_as_float(rr[1]); }
__device__ __forceinline__ float wave_max(float v) { v = fmaxf(v, sx<1>(v)); v = fmaxf(v, sx<2>(v)); v = fmaxf(v, sx<4>(v)); v = fmaxf(v, sx<8>(v)); v = fmaxf(v, sx<16>(v));
    auto rr = __builtin_amdgcn_permlane32_swap(__float_as_uint(v), __float_as_uint(v), false, false); return fmaxf(__uint_as_float(rr[0]), __uint_as_float(rr[1])); }
__device__ __forceinline__ unsigned pack_i8x4(float a, float b, float c, float d) {
    int hi_ = 127, lo_ = -127; asm volatile("" : "+s"(hi_), "+s"(lo_));
    const int ia = max(lo_, min(hi_, __float2int_rn(a))), ib = max(lo_, min(hi_, __float2int_rn(b))), ic = max(lo_, min(hi_, __float2int_rn(c))), id = max(lo_, min(hi_, __float2int_rn(d)));
    return (unsigned)(ia & 255) | ((unsigned)(ib & 255) << 8) | ((unsigned)(ic & 255) << 16) | ((unsigned)id << 24); }
__device__ __forceinline__ unsigned pack_fp8x4(float a, float b, float c, float d) { int w = 0; w = __builtin_amdgcn_cvt_pk_fp8_f32(a, b, w, false); w = __builtin_amdgcn_cvt_pk_fp8_f32(c, d, w, true); return (unsigned)w; }
__device__ __forceinline__ float wave_sum(float v) { v += sx<1>(v); v += sx<2>(v); v += sx<4>(v); v += sx<8>(v); v += sx<16>(v); return sum32x(v); }
__device__ __forceinline__ float ln_eps() { float e = LN_EPS; asm volatile("" : "+s"(e)); return e; }
__device__ __forceinline__ int hidden_tid(int wave) { int l; asm volatile("v_mbcnt_lo_u32_b32 %0, -1, 0\n\tv_mbcnt_hi_u32_b32 %0, -1, %0" : "=v"(l)); return wave * 64 + l; }
__device__ __forceinline__ float fast_sigmoid(float x) { return __builtin_amdgcn_rcpf(1.0f + __builtin_amdgcn_exp2f(-1.4426950408889634f * x)); }

#define XB_TMO      128
#define XB_XCNT(j)  (256  + 64 * (j))
#define XB_XSUB(j)  (1280 + 64 * (j))
#define XB_XGEN(j)  (2304 + 64 * (j))
#define XB_TOP      3328
#define XB_TOPGEN   3392
#define XCD_BAR_WORDS 3456
#define XB_SPIN_CAP (1u << 18)
__device__ __forceinline__ unsigned xb_ld(unsigned* p)              { return __hip_atomic_load(p, __ATOMIC_RELAXED, __HIP_MEMORY_SCOPE_AGENT); }
__device__ __forceinline__ unsigned xb_add(unsigned* p, unsigned v) { return __hip_atomic_fetch_add(p, v, __ATOMIC_RELAXED, __HIP_MEMORY_SCOPE_AGENT); }
__device__ __forceinline__ unsigned xb_xcc_id() { return (unsigned)__builtin_amdgcn_s_getreg((3 << 11) | 20) & 0xFu; }
#define XB_SPIN(cond, bar) do { unsigned _sp = 0; while (cond) { __builtin_amdgcn_s_sleep(1); \
    if ((++_sp & 255u) == 0u) { if (xb_ld(&(bar)[XB_TMO])) break; if (_sp > XB_SPIN_CAP) { atomicAdd(&(bar)[XB_TMO], 1u); break; } } } } while (0)
struct XcdBarrier { unsigned* bar; unsigned x; volatile LAS unsigned* st; };
__device__ __forceinline__ XcdBarrier xcd_barrier_post(unsigned* bar, volatile LAS unsigned* st) {
    XcdBarrier b; b.bar = bar; b.x = xb_xcc_id(); b.st = st;
    if (threadIdx.x == 0) (void)xb_add(&bar[XB_XCNT(b.x)], 1u);
    return b;
}
__device__ __forceinline__ void xcd_barrier_complete(unsigned* bar, unsigned x, unsigned& nloc, unsigned& nx) {
    const unsigned G = gridDim.x * gridDim.y * gridDim.z;
    unsigned sum, cnt, mine, sp = 0u;
    for (;;) {
        sum = 0u; cnt = 0u; mine = 0u;
#pragma unroll
        for (unsigned j = 0; j < 16; ++j) { const unsigned c = xb_ld(&bar[XB_XCNT(j)]); sum += c; cnt += (c > 0u) ? 1u : 0u; mine = (j == x) ? c : mine; }
        if (sum == G) break;
        __builtin_amdgcn_s_sleep(1);
        if ((++sp & 255u) == 0u) { if (xb_ld(&bar[XB_TMO])) break; if (sp > XB_SPIN_CAP) { atomicAdd(&bar[XB_TMO], 1u); break; } }
    }
    nloc = mine > 0u ? mine : 1u; nx = cnt > 0u ? cnt : 1u;
}
__device__ __forceinline__ void xcd_barrier(const XcdBarrier& b, int wave_) {
    asm volatile("s_waitcnt vmcnt(0)" ::: "memory");
    __syncthreads();
    if (hidden_tid(wave_) == 0) {
        unsigned* bar = b.bar;
        __builtin_amdgcn_s_waitcnt(0);
        unsigned nloc = b.st[0], nx = b.st[1];
        if (nloc == 0u) { xcd_barrier_complete(bar, b.x, nloc, nx); b.st[0] = nloc; b.st[1] = nx; }
        const unsigned old = xb_add(&bar[XB_XSUB(b.x)], 1u);
        const unsigned gen = old / nloc;
        if (old + 1u == (gen + 1u) * nloc) {
            __builtin_amdgcn_fence(__ATOMIC_RELEASE, "agent");
            asm volatile("s_waitcnt vmcnt(0)" ::: "memory");
            const unsigned og = xb_add(&bar[XB_TOP], 1u);
            const unsigned tg = og / nx;
            if (og + 1u == (tg + 1u) * nx) xb_add(&bar[XB_TOPGEN], 1u);
            else XB_SPIN(xb_ld(&bar[XB_TOPGEN]) == tg, bar);
            __builtin_amdgcn_fence(__ATOMIC_ACQUIRE, "agent");
            xb_add(&bar[XB_XGEN(b.x)], 1u);
            asm volatile("s_waitcnt vmcnt(0)" ::: "memory");
        } else {
            XB_SPIN(xb_ld(&bar[XB_XGEN(b.x)]) == gen, bar);
            __builtin_amdgcn_fence(__ATOMIC_ACQUIRE, "agent");
            asm volatile("s_waitcnt vmcnt(0)" ::: "memory");
        }
    }
    __syncthreads();
}

namespace g8 {
constexpr int BM = 256, BK = 64, HALF = 128, HTB = HALF * BK * 2, NXCD = 8, WGM = 8, PF_OFF = 8 * HTB, PF_BLK = 3072;
__host__ __device__ __forceinline__ int lds_byte(int r, int c) { const int st = (r >> 4) * 2 + (c >> 5), rr = r & 15, cc = c & 31, ob = rr * 64 + cc * 2; return st * 1024 + (ob ^ (((ob >> 9) & 1) << 5)); }
__host__ __device__ __forceinline__ void stage_rc(int b, int& R, int& C) { const int st = b / 1024, sb = b % 1024, swz = sb ^ (((sb >> 9) & 1) << 5); R = (st >> 1) * 16 + swz / 64; C = (st & 1) * 32 + (swz % 64) / 2; }
__host__ __device__ __forceinline__ int perm32(int rho) { const int n = rho >> 4, i = rho & 15; return 8 * (i >> 2) + 4 * n + (i & 3); }

struct GU { unsigned a, b, ooff; int row0, col0, aux; };

struct DenseOrder {
    int nM, nN, nwg, G, c;
    __device__ __forceinline__ void init(int M, int N, int G_, int c_) { nM = M / BM; nN = N / BM; nwg = nM * nN; G = G_; c = c_; }
    __device__ __forceinline__ bool tile(int i, int& pm, int& pn) const {
        const long L = (long)i * G + c; if (L >= nwg) return false;
        int wgid = (int)L; { const int q = nwg / NXCD, r = nwg % NXCD, xcd = wgid % NXCD, off = wgid / NXCD; wgid = (xcd < r ? xcd * (q + 1) : r * (q + 1) + (xcd - r) * q) + off; }
        const int nig = WGM * nN, gid = wgid / nig, fm = gid * WGM, gsz = (nM - fm) < WGM ? (nM - fm) : WGM;
        pm = fm + ((wgid % nig) % gsz); pn = (wgid % nig) / gsz; return true;
    }
};

template <int MODE> struct Mma;
template <> struct Mma<0> { typedef f32x4 acc_t; static __device__ __forceinline__ f32x4 run(const bf16x8 (&a)[2], const bf16x8 (&b)[2], f32x4 c, int) {
    c = __builtin_amdgcn_mfma_f32_16x16x32_bf16(a[0], b[0], c, 0, 0, 0); return __builtin_amdgcn_mfma_f32_16x16x32_bf16(a[1], b[1], c, 0, 0, 0); } };
template <> struct Mma<1> { typedef i32x4 acc_t; static __device__ __forceinline__ i32x4 run(const bf16x8 (&a)[2], const bf16x8 (&b)[2], i32x4 c, int) {
    c = __builtin_amdgcn_mfma_i32_16x16x64_i8(__builtin_bit_cast(i32x4, a[0]), __builtin_bit_cast(i32x4, b[0]), c, 0, 0, 0); return __builtin_amdgcn_mfma_i32_16x16x64_i8(__builtin_bit_cast(i32x4, a[1]), __builtin_bit_cast(i32x4, b[1]), c, 0, 0, 0); } };
template <> struct Mma<2> { typedef f32x4 acc_t; static __device__ __forceinline__ f32x4 run(const bf16x8 (&a)[2], const bf16x8 (&b)[2], f32x4 c, int sc1) {
    const i32x4 a0 = __builtin_bit_cast(i32x4, a[0]), a1 = __builtin_bit_cast(i32x4, a[1]), b0 = __builtin_bit_cast(i32x4, b[0]), b1 = __builtin_bit_cast(i32x4, b[1]);
    const i32x8 av = (i32x8){a0[0], a0[1], a0[2], a0[3], a1[0], a1[1], a1[2], a1[3]}, bv = (i32x8){b0[0], b0[1], b0[2], b0[3], b1[0], b1[1], b1[2], b1[3]};
    return __builtin_amdgcn_mfma_scale_f32_16x16x128_f8f6f4(av, bv, c, 0, 0, 0, sc1, 0, sc1); } };
template <class Epi, class Sched, int PROBE = 0>
__device__ __forceinline__ void gemm_phase(LAS unsigned char* lds, const Sched& S, const Epi& E, int wave_) {
    typedef typename Mma<Epi::MODE>::acc_t acc_t;
    int mxs = 0x7f7f7f7f; asm volatile("" : "+v"(mxs));
    constexpr bool GATHER = Sched::GATHER;
    const int tid = hidden_tid(wave_), wid = wave_, lane = tid & 63, wr = wid >> 2, wc = wid & 3, fr = lane & 15, fq = lane >> 4;
    unsigned voffA[2], voffB[2]; int RA[2];
#pragma unroll
    for (int i = 0; i < 2; ++i) { int R, C; stage_rc(tid * 16 + i * 8192, R, C); const int Rb = Epi::PERM ? ((R & ~31) + perm32(R & 31)) : R;
        voffA[i] = (GATHER ? 0u : (unsigned)R * S.lda) + (unsigned)C * 2u; voffB[i] = (unsigned)Rb * S.ldb + (unsigned)C * 2u; RA[i] = R; }
    constexpr unsigned kstep = (unsigned)(BK * 2);
    const unsigned hsA = GATHER ? 0u : S.hstepA, hsB = S.hstepB;
    const unsigned ldsw = (unsigned)wid * 1024u;
    const unsigned ldsb = (unsigned)(unsigned long)lds + ldsw;
    const int aoff = lds_byte(wr * 64 + fr, fq * 8), boff = lds_byte(wc * 32 + fr, fq * 8);
    const char* const Ab = S.A; const char* const Bb = S.Bt;
#define G8_SA(b, h) (((b) * 2 + (h)) * HTB)
#define G8_SB(b, h) ((4 + (b) * 2 + (h)) * HTB)
#define G8_STAGE(bufoff, gbase, soff, voff) do { const char* gp_ = (gbase) + (size_t)(soff); _Pragma("unroll") for (int _i = 0; _i < 2; ++_i) { unsigned keep_ = 0; \
        asm volatile("s_mov_b32 m0, %2\n\ts_nop 4\n\tglobal_load_lds_dwordx4 %0, %1" :: "v"((voff)[_i]), "s"(gp_), "s"(ldsb + (unsigned)((bufoff) + _i * 8192)) : "memory"); (void)keep_; } } while (0)
#define G8_LDA(dst, b, h) do { _Pragma("unroll") for (int m = 0; m < 4; ++m) _Pragma("unroll") for (int k = 0; k < 2; ++k) dst[m][k] = *(const LAS bf16x8*)(lds + G8_SA(b, h) + aoff + m * 2048 + k * 1024); } while (0)
#define G8_LDB(dst, b, h) do { _Pragma("unroll") for (int n = 0; n < 2; ++n) _Pragma("unroll") for (int k = 0; k < 2; ++k) dst[n][k] = *(const LAS bf16x8*)(lds + G8_SB(b, h) + boff + n * 2048 + k * 1024); } while (0)
#define G8_MMA(ai, bj, At, Bt) do { __builtin_amdgcn_s_setprio(1); _Pragma("unroll") for (int m = 0; m < 4; ++m) _Pragma("unroll") for (int n = 0; n < 2; ++n) { \
        if (PROBE & 2) { asm volatile("" :: "v"(Bt[n][0]), "v"(Bt[n][1]), "v"(At[m][0]), "v"(At[m][1])); } else acc[ai][bj][m][n] = Mma<Epi::MODE>::run(Bt[n], At[m], acc[ai][bj][m][n], mxs); } __builtin_amdgcn_s_setprio(0); } while (0)
#define G8_WAIT_V(n) asm volatile("s_waitcnt vmcnt(" #n ")" ::: "memory")
#define G8_WAIT_L(n) asm volatile("s_waitcnt lgkmcnt(" #n ")" ::: "memory")
#define G8_BAR __builtin_amdgcn_s_barrier()
#define G8_SCHED __builtin_amdgcn_sched_barrier(0)
    GU cur, nxt; int ui = 0;
    if (!S.next(0, cur)) return;
    acc_t acc[2][2][4][2];
#pragma unroll
    for (int a = 0; a < 2; ++a)
#pragma unroll
        for (int b = 0; b < 2; ++b)
#pragma unroll
            for (int m = 0; m < 4; ++m)
#pragma unroll
                for (int n = 0; n < 2; ++n) {
                    if constexpr (Epi::MODE == 0) acc[a][b][m][n] = (acc_t){0, 0, 0, 0};
                    else {
#pragma unroll
                        for (int j = 0; j < 4; ++j) { decltype(acc[a][b][m][n][j] + acc[a][b][m][n][j]) zv; asm volatile("v_mov_b32 %0, 0" : "=v"(zv)); acc[a][b][m][n][j] = zv; } } }
    bf16x8 At[4][2], B0[2][2], B1[2][2];
    unsigned cA = cur.a, cB = cur.b;
    unsigned c0[2], c1[2], n0[2], n1[2];
    if constexpr (GATHER) {
#pragma unroll
        for (int i = 0; i < 2; ++i) { const int r0 = S.rowtok[cur.row0 + RA[i]], r1 = S.rowtok[cur.row0 + HALF + RA[i]];
            c0[i] = (unsigned)r0 * S.lda + voffA[i]; c1[i] = (unsigned)r1 * S.lda + voffA[i]; n0[i] = c0[i]; n1[i] = c1[i]; }
    } else {
#pragma unroll
        for (int i = 0; i < 2; ++i) { c0[i] = voffA[i]; c1[i] = voffA[i]; n0[i] = voffA[i]; n1[i] = voffA[i]; }
    }
    G8_STAGE(G8_SB(0, 0), Bb, cB, voffB); G8_STAGE(G8_SB(0, 1), Bb, cB + hsB, voffB); G8_STAGE(G8_SA(0, 0), Ab, cA, c0); G8_STAGE(G8_SA(0, 1), Ab, cA + hsA, c1);
    if (wr == 1) G8_BAR;
    G8_WAIT_V(2); G8_BAR;
    G8_STAGE(G8_SB(1, 0), Bb, cB + kstep, voffB); G8_STAGE(G8_SA(1, 0), Ab, cA + kstep, c0); G8_STAGE(G8_SB(1, 1), Bb, cB + hsB + kstep, voffB);
    G8_WAIT_V(6); G8_BAR;
    for (;;) {
        const bool has_next = S.next(ui + 1, nxt);
        const unsigned nA = has_next ? nxt.a : cA, nB = has_next ? nxt.b : cB;
        const int nt = Sched::VAR_NT ? cur.aux : S.nt;
        if constexpr (Epi::PF) E.prefetch(cur, wave_, (unsigned)(unsigned long)lds + (unsigned)(PF_OFF + (ui & 1) * PF_BLK));
        for (int t = 0; t < nt; t += 2) {
            const bool last = (t == nt - 2);
            const unsigned a1 = cA + (unsigned)(t + 1) * kstep;
            const unsigned a2 = last ? nA : cA + (unsigned)(t + 2) * kstep, b2 = last ? nB : cB + (unsigned)(t + 2) * kstep;
            const unsigned a3 = a2 + kstep, b3 = b2 + kstep;
            unsigned s0[2], s1[2];
            if constexpr (GATHER) {
                if (last && has_next) {
#pragma unroll
                    for (int i = 0; i < 2; ++i) { const int r0 = S.rowtok[nxt.row0 + RA[i]], r1 = S.rowtok[nxt.row0 + HALF + RA[i]];
                        n0[i] = (unsigned)r0 * S.lda + voffA[i]; n1[i] = (unsigned)r1 * S.lda + voffA[i]; }
                }
#pragma unroll
                for (int i = 0; i < 2; ++i) { s0[i] = last ? n0[i] : c0[i]; s1[i] = last ? n1[i] : c1[i]; }
            } else {
#pragma unroll
                for (int i = 0; i < 2; ++i) { s0[i] = voffA[i]; s1[i] = voffA[i]; }
            }
            G8_LDB(B0, 0, 0); G8_LDB(B1, 0, 1); G8_SCHED; G8_LDA(At, 0, 0);
            G8_STAGE(G8_SA(1, 1), Ab, a1 + hsA, c1);
            G8_WAIT_V(8); G8_WAIT_L(0); G8_BAR; G8_MMA(0, 0, At, B0); G8_MMA(0, 1, At, B1); G8_BAR; G8_SCHED;
            G8_LDA(At, 0, 1); G8_STAGE(G8_SB(0, 0), Bb, b2, voffB); G8_STAGE(G8_SB(0, 1), Bb, b2 + hsB, voffB); G8_STAGE(G8_SA(0, 0), Ab, a2, s0);
            G8_WAIT_V(8); G8_WAIT_L(0); G8_BAR; G8_MMA(1, 0, At, B0); G8_MMA(1, 1, At, B1); G8_BAR; G8_SCHED;
            G8_LDB(B0, 1, 0); G8_LDB(B1, 1, 1); G8_SCHED; G8_LDA(At, 1, 0); G8_STAGE(G8_SA(0, 1), Ab, a2 + hsA, s1);
            G8_WAIT_V(8); G8_WAIT_L(0); G8_BAR; G8_MMA(0, 0, At, B0); G8_MMA(0, 1, At, B1); G8_BAR; G8_SCHED;
            G8_LDA(At, 1, 1); G8_STAGE(G8_SB(1, 0), Bb, b3, voffB); G8_STAGE(G8_SB(1, 1), Bb, b3 + hsB, voffB); G8_STAGE(G8_SA(1, 0), Ab, a3, s0);
            G8_WAIT_V(8); G8_WAIT_L(0); G8_BAR; G8_MMA(1, 0, At, B0); G8_MMA(1, 1, At, B1); G8_BAR; G8_SCHED;
        }
        if (wr == 0) G8_BAR;
        if (!(PROBE & 1)) E(acc, cur, wave_, lds + (Epi::PF ? (ui & 1) * PF_BLK : 0));
        if (!has_next) break;
#pragma unroll
        for (int a = 0; a < 2; ++a)
#pragma unroll
            for (int b = 0; b < 2; ++b)
#pragma unroll
                for (int m = 0; m < 4; ++m)
#pragma unroll
                    for (int n = 0; n < 2; ++n) {
                        if constexpr (Epi::MODE == 0) acc[a][b][m][n] = (acc_t){0, 0, 0, 0};
                        else {
#pragma unroll
                            for (int j = 0; j < 4; ++j) { decltype(acc[a][b][m][n][j] + acc[a][b][m][n][j]) zv; asm volatile("v_mov_b32 %0, 0" : "=v"(zv)); acc[a][b][m][n][j] = zv; } } }
        cur = nxt; cA = nA; cB = nB; ++ui;
        if constexpr (GATHER) {
#pragma unroll
            for (int i = 0; i < 2; ++i) { c0[i] = n0[i]; c1[i] = n1[i]; }
        }
        if (wr == 1) G8_BAR;
    }
    G8_WAIT_V(0);
    G8_BAR;
#undef G8_SA
#undef G8_SB
#undef G8_STAGE
#undef G8_LDA
#undef G8_LDB
#undef G8_MMA
#undef G8_WAIT_V
#undef G8_WAIT_L
#undef G8_BAR
#undef G8_SCHED
}
}

using g8::GU;
#define EPI_LANE_IDS() const int tz_ = hidden_tid(wave_); const int wid_ = wave_, lane_ = tz_ & 63, wr = wid_ >> 2, wc = wid_ & 3, fr = lane_ & 15, fq = lane_ >> 4
template <int MODE_ = 0> struct EpiBf16T {          static constexpr int MODE = MODE_; static constexpr bool PF = false;
    static constexpr bool PERM = true;
    bf16_t* O; int ldc; const float* bias; int bstride; const float* scale; float smul;
    __device__ __forceinline__ void operator()(const f32x4 (&acc)[2][2][4][2], const GU& u, int wave_, LAS unsigned char* lds_) const {
        EPI_LANE_IDS();
        const int cl = wc * 32 + 8 * fq;
        bf16_t* Ob = O + u.ooff;
#pragma unroll
        for (int bj = 0; bj < 2; ++bj) {
            f32x4 bv[2], sv[2];
#pragma unroll
            for (int n = 0; n < 2; ++n) { bv[n] = bias ? *(const f32x4*)(bias + (size_t)u.aux * bstride + u.col0 + cl + bj * 128 + 4 * n) : (f32x4){0.f, 0.f, 0.f, 0.f};
                sv[n] = scale ? *(const f32x4*)(scale + (size_t)u.aux * bstride + u.col0 + cl + bj * 128 + 4 * n) * smul : (f32x4){smul, smul, smul, smul}; }
#pragma unroll
            for (int ai = 0; ai < 2; ++ai)
#pragma unroll
                for (int m = 0; m < 4; ++m) { bf16_t* rowp = Ob + (unsigned)((ai * 128 + wr * 64 + m * 16 + fr) * ldc + cl) + bj * 128;
                    const f32x4 v0 = acc[ai][bj][m][0] * sv[0] + bv[0], v1 = acc[ai][bj][m][1] * sv[1] + bv[1];
                    u32x4 w; w.x = cvt_pk_bf16(v0[0], v0[1]); w.y = cvt_pk_bf16(v0[2], v0[3]); w.z = cvt_pk_bf16(v1[0], v1[1]); w.w = cvt_pk_bf16(v1[2], v1[3]);
                    *(u32x4*)rowp = w; }
        }
    }
};
typedef EpiBf16T<0> EpiBf16;
struct EpiGlu8 { static constexpr bool PF = false;
    static constexpr bool PERM = true; static constexpr int MODE = 2;
    bf16_t* O; int ldc; const float* bias; const float* sw; int half;
    __device__ __forceinline__ void operator()(const f32x4 (&acc)[2][2][4][2], const GU& u, int wave_, LAS unsigned char* lds_) const {
        EPI_LANE_IDS();
        const int cl = wc * 32 + 8 * fq;
        f32x4 bv[2][2], sv[2][2];
#pragma unroll
        for (int bj = 0; bj < 2; ++bj)
#pragma unroll
            for (int n = 0; n < 2; ++n) { bv[bj][n] = *(const f32x4*)(bias + u.col0 + cl + bj * half + 4 * n); sv[bj][n] = *(const f32x4*)(sw + u.col0 + cl + bj * half + 4 * n); }
        bf16_t* Ob = O + u.ooff;
#pragma unroll
        for (int ai = 0; ai < 2; ++ai)
#pragma unroll
            for (int m = 0; m < 4; ++m) { bf16_t* rowp = Ob + (unsigned)((ai * 128 + wr * 64 + m * 16 + fr) * ldc + cl);
                float o[8];
#pragma unroll
                for (int n = 0; n < 2; ++n) { const f32x4 a = acc[ai][0][m][n] * sv[0][n] + bv[0][n], g = acc[ai][1][m][n] * sv[1][n] + bv[1][n];
#pragma unroll
                    for (int j = 0; j < 4; ++j) o[4 * n + j] = a[j] * fast_sigmoid(g[j]); }
                u32x4 w; w.x = cvt_pk_bf16(o[0], o[1]); w.y = cvt_pk_bf16(o[2], o[3]); w.z = cvt_pk_bf16(o[4], o[5]); w.w = cvt_pk_bf16(o[6], o[7]);
                *(u32x4*)rowp = w; }
    }
};
#define EPI_DMA16(gptr, ldsaddr) asm volatile("s_mov_b32 m0, %1\n\ts_nop 4\n\tglobal_load_lds_dwordx4 %0, off" :: "v"(gptr), "s"(ldsaddr) : "memory")
struct EpiY2 { static constexpr bool PF = true;
    static constexpr bool PERM = true; static constexpr int MODE = 2;
    unsigned char* O; const float* bias; const float* scale;
    __device__ __forceinline__ void prefetch(const GU& u, int wave_, unsigned ldsaddr) const {
        const int l_ = hidden_tid(wave_) & 63;
        if (wave_ == 0) { const float* p = bias + (size_t)u.aux * 1024 + u.col0 + 4 * l_; EPI_DMA16(p, ldsaddr); }
        else if (wave_ == 1) { const float* p = scale + (size_t)u.aux * 1024 + u.col0 + 4 * l_; EPI_DMA16(p, ldsaddr + 1024u); }
    }
    __device__ __forceinline__ void operator()(const f32x4 (&acc)[2][2][4][2], const GU& u, int wave_, LAS unsigned char* lds_) const {
        EPI_LANE_IDS();
        const int cl = wc * 32 + 8 * fq;
        unsigned char* Ob = O + u.ooff; const LAS float* pf = (const LAS float*)(lds_ + g8::PF_OFF);
#pragma unroll
        for (int bj = 0; bj < 2; ++bj) {
            f32x4 bv[2], sv[2];
#pragma unroll
            for (int n = 0; n < 2; ++n) { bv[n] = *(const LAS f32x4*)(pf + cl + bj * 128 + 4 * n) * Y2_PRESCALE;
                sv[n] = *(const LAS f32x4*)(pf + 256 + cl + bj * 128 + 4 * n) * (Y2_PRESCALE / H_PRESCALE); }
#pragma unroll
            for (int ai = 0; ai < 2; ++ai)
#pragma unroll
                for (int m = 0; m < 4; m += 2) {
                    const f32x4 a0 = acc[ai][bj][m][0] * sv[0] + bv[0], a1 = acc[ai][bj][m][1] * sv[1] + bv[1], b0 = acc[ai][bj][m + 1][0] * sv[0] + bv[0], b1 = acc[ai][bj][m + 1][1] * sv[1] + bv[1];
                    const unsigned pa0 = pack_fp8x4(a0[0], a0[1], a0[2], a0[3]), pa1 = pack_fp8x4(a1[0], a1[1], a1[2], a1[3]), pb0 = pack_fp8x4(b0[0], b0[1], b0[2], b0[3]), pb1 = pack_fp8x4(b1[0], b1[1], b1[2], b1[3]);
                    const bool odd = (fq & 1) != 0;
                    const unsigned k0 = odd ? pb0 : pa0, k1 = odd ? pb1 : pa1, s0 = odd ? pa0 : pb0, s1 = odd ? pa1 : pb1;
                    const unsigned r0 = __float_as_uint(sx<16>(__uint_as_float(s0))), r1 = __float_as_uint(sx<16>(__uint_as_float(s1)));
                    const u32x4 w = odd ? (u32x4){r0, r1, k0, k1} : (u32x4){k0, k1, r0, r1};
                    unsigned char* rowp = Ob + (unsigned)((ai * 128 + wr * 64 + (m + (odd ? 1 : 0)) * 16 + fr) * 1024 + (cl - (odd ? 8 : 0))) + bj * 128;
                    *(u32x4*)rowp = w; }
        }
    }
};
template <int MODE_ = 0> struct EpiFp8T { static constexpr bool PF = false;
    static constexpr bool PERM = true; static constexpr int MODE = MODE_;
    unsigned char* O; int ldc; float smul;
    __device__ __forceinline__ void operator()(const f32x4 (&acc)[2][2][4][2], const GU& u, int wave_, LAS unsigned char* lds_) const {
        EPI_LANE_IDS();
        const int cl = wc * 32 + 8 * fq;
        unsigned char* Ob = O + u.ooff;
#pragma unroll
        for (int ai = 0; ai < 2; ++ai)
#pragma unroll
            for (int m = 0; m < 4; ++m) { unsigned char* rowp = Ob + (unsigned)((ai * 128 + wr * 64 + m * 16 + fr) * ldc + cl);
#pragma unroll
                for (int bj = 0; bj < 2; ++bj) { const f32x4 v0 = acc[ai][bj][m][0] * smul, v1 = acc[ai][bj][m][1] * smul;
                    *(u32x2*)(rowp + bj * 128) = (u32x2){pack_fp8x4(v0[0], v0[1], v0[2], v0[3]), pack_fp8x4(v1[0], v1[1], v1[2], v1[3])}; } }
    }
};
template <int PV = 0> struct EpiGatedI8T { static constexpr bool PF = true;
    static constexpr bool PERM = true; static constexpr int MODE = 1;
    unsigned char* O; const float* bias; const float* sw; const float* sap;
    __device__ __forceinline__ void prefetch(const GU& u, int wave_, unsigned ldsaddr) const {
        const int l_ = hidden_tid(wave_) & 63;
        if (wave_ == 0) { const float* p = bias + (size_t)u.aux * 2048 + u.col0 + (l_ >> 5) * 1024 + 4 * (l_ & 31); EPI_DMA16(p, ldsaddr); }
        else if (wave_ == 1) { const float* p = sw + (size_t)u.aux * 2048 + u.col0 + (l_ >> 5) * 1024 + 4 * (l_ & 31); EPI_DMA16(p, ldsaddr + 1024u); }
        else if (wave_ == 2) { const float* p = sap + u.row0 + 4 * l_; EPI_DMA16(p, ldsaddr + 2048u); }
    }
    __device__ __forceinline__ void operator()(const i32x4 (&acc)[2][2][4][2], const GU& u, int wave_, LAS unsigned char* lds_) const {
        EPI_LANE_IDS();
        const int cl = wc * 32 + 8 * fq; const LAS float* pf = (const LAS float*)(lds_ + g8::PF_OFF);
        f32x4 bv[2][2], sv[2][2]; float sr[2][4];
#pragma unroll
        for (int bj = 0; bj < 2; ++bj)
#pragma unroll
            for (int n = 0; n < 2; ++n) { if (PV & 1) { bv[bj][n] = (f32x4){0.f, 0.f, 0.f, 0.f}; sv[bj][n] = (f32x4){1.f, 1.f, 1.f, 1.f}; } else { bv[bj][n] = *(const LAS f32x4*)(pf + bj * 128 + cl + 4 * n); sv[bj][n] = *(const LAS f32x4*)(pf + 256 + bj * 128 + cl + 4 * n); } }
#pragma unroll
        for (int ai = 0; ai < 2; ++ai)
#pragma unroll
            for (int m = 0; m < 4; ++m) sr[ai][m] = (PV & 1) ? 1.0f : pf[512 + ai * 128 + wr * 64 + m * 16 + fr];
        unsigned char* Ob = O + u.ooff;
        float C_SIG = -1.702f * 1.4426950408889634f, K2 = H_PRESCALE / (-1.702f * 1.4426950408889634f), c7s = 7.0f * (-1.702f * 1.4426950408889634f), glo = -6.0f * (H_PRESCALE / (-1.702f * 1.4426950408889634f)), ghi = 8.0f * (H_PRESCALE / (-1.702f * 1.4426950408889634f));
        asm volatile("" : "+s"(C_SIG), "+s"(K2), "+s"(c7s), "+s"(glo), "+s"(ghi));
        if (!(PV & 1)) {
#pragma unroll
            for (int n = 0; n < 2; ++n) { sv[0][n] = sv[0][n] * C_SIG; bv[0][n] = bv[0][n] * C_SIG; sv[1][n] = sv[1][n] * K2; bv[1][n] = bv[1][n] * K2 + K2; } }
#pragma unroll
        for (int ai = 0; ai < 2; ++ai)
#pragma unroll
            for (int m = 0; m < 4; ++m) { const int rl = ai * 128 + wr * 64 + m * 16 + fr; const float srow = sr[ai][m];
                unsigned char* rowp = Ob + (unsigned)(rl * 1024 + cl);
                float o[8];
#pragma unroll
                for (int n = 0; n < 2; ++n) {
#pragma unroll
                    for (int j = 0; j < 4; ++j) { const float a = ((float)acc[ai][0][m][n][j] * sv[0][n][j]) * srow + bv[0][n][j], g = ((float)acc[ai][1][m][n][j] * sv[1][n][j]) * srow + bv[1][n][j];
                        if (PV & 4) { o[4 * n + j] = a + g; } else {
                        const float gl = fmaxf(a, c7s), li = __builtin_amdgcn_fmed3f(g, glo, ghi);
                        const float sg = __builtin_amdgcn_rcpf(1.0f + __builtin_amdgcn_exp2f(gl));
                        o[4 * n + j] = (gl * sg) * li; } } }
                int w0 = 0, w1 = 0; w0 = __builtin_amdgcn_cvt_pk_fp8_f32(o[0], o[1], w0, false); w0 = __builtin_amdgcn_cvt_pk_fp8_f32(o[2], o[3], w0, true);
                w1 = __builtin_amdgcn_cvt_pk_fp8_f32(o[4], o[5], w1, false); w1 = __builtin_amdgcn_cvt_pk_fp8_f32(o[6], o[7], w1, true);
                if (PV & 2) { asm volatile("" :: "v"(w0), "v"(w1)); } else *(u32x2*)rowp = (u32x2){(unsigned)w0, (unsigned)w1}; }
    }
};
typedef EpiGatedI8T<0> EpiGatedI8;
struct EpiQK8 { static constexpr bool PF = false;
    static constexpr bool PERM = false; static constexpr int MODE = 2;
    unsigned char* Q; const float* rope; const float* sw;
    __device__ __forceinline__ void operator()(const f32x4 (&acc)[2][2][4][2], const GU& u, int wave_, LAS unsigned char* lds_) const {
        EPI_LANE_IDS();
        const int which = u.col0 >> 10, colw = u.col0 & 1023;
        unsigned char* base = Q + (size_t)which * (WS_K - WS_Q);
        const bool dorope = u.row0 < T_LAT;
        const float sc = which == 0 ? ATT_C2 * Q_PRESCALE : 1.0f;
#pragma unroll
        for (int bj = 0; bj < 2; ++bj) {
            const f32x4 s1 = *(const f32x4*)(sw + u.col0 + bj * 128 + wc * 32 + 4 * fq) * sc, s2 = *(const f32x4*)(sw + u.col0 + bj * 128 + wc * 32 + 16 + 4 * fq) * sc;
#pragma unroll
            for (int ai = 0; ai < 2; ++ai)
#pragma unroll
                for (int m = 0; m < 4; ++m) { const int row = u.row0 + ai * 128 + wr * 64 + m * 16 + fr;
                    float one_ = 1.0f; asm volatile("" : "+s"(one_));
                    f32x4 cs0 = (f32x4){one_, 0.f, one_, 0.f}, cs1 = cs0;
                    if (dorope) { const int t = row & (SEQ - 1); const int pos = (wc & 1) ? (t & 63) : (t >> 6); const float* rp = rope + (pos * 16 + 4 * fq) * 2; cs0 = *(const f32x4*)rp; cs1 = *(const f32x4*)(rp + 4); }
                    const float cj[4] = {cs0[0], cs0[2], cs1[0], cs1[2]}, sj[4] = {cs0[1], cs0[3], cs1[1], cs1[3]};
                    const f32x4 x1 = acc[ai][bj][m][0] * s1, x2 = acc[ai][bj][m][1] * s2; float o1[4], o2[4];
#pragma unroll
                    for (int j = 0; j < 4; ++j) { o1[j] = x1[j] * cj[j] - x2[j] * sj[j]; o2[j] = x2[j] * cj[j] + x1[j] * sj[j]; }
                    unsigned char* rowp = base + (size_t)row * D + colw + bj * 128 + wc * 32 + 4 * fq;
                    *(unsigned*)rowp = pack_fp8x4(o1[0], o1[1], o1[2], o1[3]); *(unsigned*)(rowp + 16) = pack_fp8x4(o2[0], o2[1], o2[2], o2[3]);
                    if (m & 1) __builtin_amdgcn_sched_barrier(0); }
        }
    }
};
struct EpiVt8 { static constexpr bool PF = false;
    static constexpr bool PERM = true; static constexpr int MODE = 2;
    unsigned char* Vt; const float* sw;
    __device__ __forceinline__ void operator()(const f32x4 (&acc)[2][2][4][2], const GU& u, int wave_, LAS unsigned char* lds_) const {
        EPI_LANE_IDS();
        unsigned char* Ob = Vt + u.ooff; const float* swp = sw + u.row0;
        const int k0 = wc * 32 + 8 * fq, kk = k0 & 63;
        const unsigned pcol = (unsigned)((k0 & ~63) + 16 * (kk >> 5) + 4 * ((kk >> 3) & 3));
#pragma unroll
        for (int ai = 0; ai < 2; ++ai)
#pragma unroll
            for (int m = 0; m < 4; ++m) { const int r = ai * 128 + wr * 64 + m * 16 + fr; const float sr = swp[r];
                const unsigned ro = (unsigned)r * (unsigned)VT_PITCH + pcol;
#pragma unroll
                for (int bj = 0; bj < 2; ++bj) { const f32x4 v0 = acc[ai][bj][m][0] * sr, v1 = acc[ai][bj][m][1] * sr;
                    *(unsigned*)(Ob + ro + bj * 128) = pack_fp8x4(v0[0], v0[1], v0[2], v0[3]); *(unsigned*)(Ob + ro + bj * 128 + 32) = pack_fp8x4(v1[0], v1[1], v1[2], v1[3]); }
                __builtin_amdgcn_sched_barrier(0); }
    }
};

struct DenseSched {
    static constexpr bool GATHER = false, VAR_NT = false;
    const char* A; const char* Bt; unsigned lda, ldb, hstepA, hstepB; int nt, ldc; const int* rowtok; g8::DenseOrder ord;
    __device__ __forceinline__ void init(const void* A_, const void* Bt_, int M, int N, int K, int ldc_, int G, int c) {
        A = (const char*)A_; Bt = (const char*)Bt_; lda = (unsigned)K * 2u; ldb = lda; hstepA = 128u * lda; hstepB = hstepA; nt = K / 64; ldc = ldc_; rowtok = nullptr; ord.init(M, N, G, c); }
    __device__ __forceinline__ void init8(const void* A_, const void* Bt_, int M, int N, int Kbytes, int ldc_, int G, int c) {
        A = (const char*)A_; Bt = (const char*)Bt_; lda = (unsigned)Kbytes; ldb = lda; hstepA = 128u * lda; hstepB = hstepA; nt = Kbytes / 128; ldc = ldc_; rowtok = nullptr; ord.init(M, N, G, c); }
    __device__ __forceinline__ bool next(int i, GU& u) const { int pm, pn; if (!ord.tile(i, pm, pn)) return false;
        u.a = (unsigned)pm * 2u * hstepA; u.b = (unsigned)pn * 2u * hstepB; u.row0 = pm * 256; u.col0 = pn * 256; u.ooff = (unsigned)(pm * 256) * (unsigned)ldc + (unsigned)(pn * 256); u.aux = 0; return true; }
};
__device__ __forceinline__ bool xcd_local(int i, int G, int c, int total, int& Li) {
    if ((G & 7) == 0 && (total & 7) == 0) { const int per = total >> 3, off = i * (G >> 3) + (c >> 3); if (off >= per) return false; Li = (c & 7) * per + off; return true; }
    const long L = (long)i * G + c; if (L >= total) return false; Li = (int)L; return true;
}
struct VtSched {
    static constexpr bool GATHER = false, VAR_NT = false;
    const char* A; const char* Bt; unsigned lda, ldb, hstepA, hstepB; int nt, ldc; const int* rowtok; int G, c;
    __device__ __forceinline__ void init(const void* Wv, const void* U, int G_, int c_) { A = (const char*)Wv; Bt = (const char*)U; lda = 1024u; ldb = 1024u; hstepA = 128u * 1024u; hstepB = hstepA; nt = 8; ldc = VT_PITCH; rowtok = nullptr; G = G_; c = c_; }
    __device__ __forceinline__ bool next(int i, GU& u) const {
        const long L = (long)i * G + c; if (L >= 4 * 136) return false; const int Li = (int)L, pm = Li & 3, pn = Li >> 2;
        const int b = pn < 128 ? (pn >> 4) : pn - 128, n0 = pn < 128 ? (pn & 15) * 256 : SEQ;
        u.a = (unsigned)pm * 256u * 1024u; u.b = (unsigned)pn * 256u * 1024u; u.row0 = pm * 256; u.col0 = 0; u.aux = 0;
        u.ooff = (unsigned)(b * 1024 + pm * 256) * (unsigned)VT_PITCH + (unsigned)n0; return true; }
};
struct GatedSched {
    static constexpr bool GATHER = false, VAR_NT = false;
    const char* A; const char* Bt; unsigned lda, ldb, hstepA, hstepB; int nt, ldc; const int* rowtok; g8::DenseOrder ord;
    __device__ __forceinline__ void init(const void* A_, const void* Bt_, int M, int N2, int K, int ldc_, int G, int c) {
        A = (const char*)A_; Bt = (const char*)Bt_; lda = (unsigned)K * 2u; ldb = lda; hstepA = 128u * lda; hstepB = (unsigned)N2 * ldb; nt = K / 64; ldc = ldc_; rowtok = nullptr; ord.init(M, 2 * N2, G, c); }
    __device__ __forceinline__ void init8(const void* A_, const void* Bt_, int M, int N2, int Kbytes, int ldc_, int G, int c) {
        A = (const char*)A_; Bt = (const char*)Bt_; lda = (unsigned)Kbytes; ldb = lda; hstepA = 128u * lda; hstepB = (unsigned)N2 * ldb; nt = Kbytes / 128; ldc = ldc_; rowtok = nullptr; ord.init(M, 2 * N2, G, c); }
    __device__ __forceinline__ bool next(int i, GU& u) const { int pm, pn; if (!ord.tile(i, pm, pn)) return false;
        u.a = (unsigned)pm * 2u * hstepA; u.b = (unsigned)pn * 128u * ldb; u.row0 = pm * 256; u.col0 = pn * 128; u.ooff = (unsigned)(pm * 256) * (unsigned)ldc + (unsigned)(pn * 128); u.aux = 0; return true; }
};
template <bool G1> struct MoeSched {
    static constexpr bool GATHER = G1, VAR_NT = false;
    const char* A; const char* Bt; unsigned lda, ldb, hstepA, hstepB; int nt, ldc; const int* rowtok;
    int G, c, NCT, wv; const volatile LAS int* tsp;
    __device__ __forceinline__ void init(const void* A_, const void* Bt_, const int* rowtok_, const volatile LAS int* tstart, int G_, int c_, int wave_) {
        A = (const char*)A_; Bt = (const char*)Bt_; lda = 1024u; ldb = lda; hstepA = 128u * lda; hstepB = G1 ? 1024u * ldb : 128u * ldb; nt = 8; ldc = 1024; rowtok = rowtok_;
        G = G_; c = c_; NCT = G1 ? 8 : 4; wv = wave_; tsp = tstart; }
    __device__ __forceinline__ bool next(int i, GU& u) const {
        const int l = hidden_tid(wv) & 63; const int vts = l <= 32 ? tsp[l] : 0x7fffffff;
        const int total = __builtin_amdgcn_readlane(vts, 32) * NCT; int Li;
        if ((G & 7) == 0) {
            const int x = c & 7, j = c >> 3, q = total >> 3, r = total & 7; const int len = q + (x < r ? 1 : 0), start = x * q + (x < r ? x : r), off = i * (G >> 3) + j;
            if (off >= len) return false; Li = start + off; }
        else { const long L = (long)i * G + c; if (L >= total) return false; Li = (int)L; }
        const unsigned long long mk = __ballot(l < 32 && vts * NCT <= Li);
        const int e = __popcll(mk) - 1; const int t0 = __builtin_amdgcn_readlane(vts, e);
        const int loc = Li - t0 * NCT, rt = loc / NCT, ct = loc - rt * NCT;
        const int prow = (t0 + rt) * 256;
        u.row0 = prow; u.aux = e;
        if (G1) { u.a = 0u; u.b = ((unsigned)e * 2048u + (unsigned)ct * 128u) * 1024u; u.col0 = ct * 128; u.ooff = (unsigned)prow * 1024u + (unsigned)ct * 128u; }
        else { u.a = (unsigned)prow * 1024u; u.b = ((unsigned)e * 1024u + (unsigned)ct * 256u) * 1024u; u.col0 = ct * 256; u.ooff = (unsigned)prow * 1024u + (unsigned)ct * 256u; }
        return true; }
};
struct F1Sched {
    static constexpr bool GATHER = false, VAR_NT = false;
    const char* A; const char* Bt; unsigned lda, ldb, hstepA, hstepB; int nt, ldc; const int* rowtok; int G, c;
    __device__ __forceinline__ void init(const void* acs, const void* U, int G_, int c_) { A = (const char*)acs; Bt = (const char*)U; lda = 512u; ldb = 2048u; hstepA = 128u * 512u; hstepB = 128u * 2048u; nt = 4; ldc = 8192; rowtok = nullptr; G = G_; c = c_; }
    __device__ __forceinline__ bool next(int i, GU& u) const {
        int Li; if (!xcd_local(i, G, c, 1024 + 64, Li)) return false;
        if (Li < 1024) { const int sub = Li & 7, tt = (Li >> 3) & 15, b = Li >> 7, cs = sub >> 2, mt = sub & 3;
            u.a = (unsigned)cs * 131072u; u.b = (unsigned)(b * SEQ + tt * 256) * 2048u + (unsigned)mt * 512u; u.row0 = mt * 256; u.col0 = 0; u.aux = 0;
            u.ooff = (unsigned)(b * 1024 + mt * 256) * 8192u + (unsigned)(cs * 4096 + tt * 256); }
        else { Li -= 1024; const int sub = Li & 7, b = Li >> 3, cs = sub >> 2, mt = sub & 3;
            u.a = (unsigned)cs * 131072u; u.b = (unsigned)(T_LAT + b * CTXL) * 2048u + (unsigned)mt * 512u; u.row0 = mt * 256; u.col0 = 0; u.aux = 0;
            u.ooff = 8u * 1024u * 8192u + (unsigned)(b * 1024 + mt * 256) * 8192u + (unsigned)(cs * 256); }
        return true; }
};
static_assert(WS_K - WS_Q == WS_V - WS_K, "Q, K, V equally spaced");
static_assert(WS_YTC >= WS_YT + (size_t)2 * 8 * 1024 * 8192, "ctx Yt follows lat Yt (8 MiB x 8 after it)");
struct F2Sched {
    static constexpr bool GATHER = false, VAR_NT = true;
    const char* A; const char* Bt; unsigned lda, ldb, hstepA, hstepB; int nt, ldc; const int* rowtok; int G, c;
    __device__ __forceinline__ void init(const void* dft, const void* Yt, int G_, int c_) { A = (const char*)dft; Bt = (const char*)Yt;
        lda = 8192u; ldb = 8192u; hstepA = 128u * 8192u; hstepB = hstepA; nt = 0; ldc = 1024; rowtok = nullptr; G = G_; c = c_; }
    __device__ __forceinline__ bool next(int i, GU& u) const {
        int Li;
        if ((G & 7) == 0) { const int off = i * (G >> 3) + (c >> 3); if (off >= 68) return false; Li = off < 64 ? (c & 7) * 64 + off : 512 + (c & 7) * 4 + (off - 64); }
        else { const long L = (long)i * G + c; if (L >= 512 + 32) return false; Li = (int)L; }
        if (Li < 512) { const int ct = Li & 3, kt = (Li >> 2) & 15, b = Li >> 6;
            u.a = (unsigned)kt * 256u * 8192u; u.b = (unsigned)(b * 1024 + ct * 256) * 8192u; u.row0 = b * SEQ + kt * 256; u.col0 = ct * 256; u.aux = 64; }
        else { Li -= 512; const int ct = Li & 3, b = Li >> 2;
            u.a = 4096u * 8192u; u.b = (unsigned)(8 * 1024 + b * 1024 + ct * 256) * 8192u; u.row0 = T_LAT + b * CTXL; u.col0 = ct * 256; u.aux = 4; }
        u.ooff = (unsigned)u.row0 * 1024u + (unsigned)u.col0; return true; }
};
namespace att {
constexpr int SLOTK = 4096, SLOTV = 8192, NSLOT = 4, PFD = NSLOT - 1;
constexpr int LDS_K = 0, LDS_V = NSLOT * SLOTK, LDS_WS = LDS_V + NSLOT * SLOTV, LDS_OST = LDS_WS + NWAVES * 256, LDS_END = LDS_OST + NWAVES * 8192;
static_assert(LDS_END <= MISC_OFF, "attention LDS map");
__device__ __forceinline__ int crow(int r, int hi) { return (r & 3) + 8 * (r >> 2) + 4 * hi; }
struct Params { const unsigned char* Q; const unsigned char* K; const unsigned char* Vt; unsigned char* O; float* scr; const float* subln_g; float lam, outscale; int wave; };
__device__ __forceinline__ float max3f(float a, float b, float c) { float r; asm("v_max3_f32 %0, %1, %2, %3" : "=v"(r) : "v"(a), "v"(b), "v"(c)); return r; }
__device__ __forceinline__ i32x8 cat8(i32x4 a, i32x4 b) { return (i32x8){a[0], a[1], a[2], a[3], b[0], b[1], b[2], b[3]}; }

template <int THRL, int VAR = 0>
__device__ __forceinline__ void unit(const Params& P, int b, int h, int c, int qrow0, int t_begin, int t_end, LAS unsigned char* lds) {
    const int tid = hidden_tid(P.wave), lane = tid & 63, r32 = lane & 31, hi = lane >> 5; const int wid = P.wave; const int grp = (wid >> ATT_GSH) & 1; const bool dk = wid < 4;
    LAS float* wsf = (LAS float*)(lds + LDS_WS) + wid * 64;
    const int drow = lane >> 2, dsw = (lane & 3) ^ ((lane >> 4) & 3);
    const unsigned koff = (unsigned)(16 * (wid & 3) + drow) * 1024u + (unsigned)(h * 128 + c * 64 + 16 * dsw);
    const unsigned voff = (unsigned)((b * 1024 + h * 128 + 16 * wid + drow) * VT_PITCH + 16 * dsw);
    const char* Kb = (const char*)P.K; const char* Vb = (const char*)P.Vt; const unsigned lds0 = (unsigned)(unsigned long)lds;
#define ATT_KROW0(t) ((t) < 64 ? b * SEQ + 64 * (t) : T_LAT + b * CTXL + 64 * ((t) - 64))
#define ATT_GLDS(sbase, vo, ldsaddr) do { unsigned keep_ = 0; asm volatile("s_mov_b32 m0, %2\n\ts_nop 4\n\tglobal_load_lds_dwordx4 %0, %1" :: "v"(vo), "s"(sbase), "s"(ldsaddr) : "memory"); (void)keep_; } while (0)
#define ATT_DMA_K(t, slot) do { if (dk) { const char* kp_ = Kb + (size_t)(ATT_KROW0(t)) * 1024; ATT_GLDS(kp_, koff, lds0 + (unsigned)(LDS_K + (slot) * SLOTK + wid * 1024)); } } while (0)
#define ATT_DMA_V(t, slot) do { const char* vp_ = Vb + (size_t)(t) * 64; ATT_GLDS(vp_, voff, lds0 + (unsigned)(LDS_V + (slot) * SLOTV + wid * 1024)); } while (0)
#define ATT_BAR() asm volatile("s_waitcnt lgkmcnt(0)\n\ts_barrier" ::: "memory")
#define ATT_VM(N) asm volatile("s_waitcnt vmcnt(" #N ")" ::: "memory")
#define ATT_VMN(N) asm volatile("s_waitcnt vmcnt(%0)" :: "n"(N) : "memory")
    const int T = t_end - t_begin;
#pragma unroll
    for (int j = 0; j < PFD; ++j) { if (j < T) ATT_DMA_K(t_begin + j, j); if (j < PFD - 1 && j < T) ATT_DMA_V(t_begin + j, j); }
    i32x8 qf;
    { const unsigned char* Qw = P.Q + (size_t)(qrow0 + wid * 32 + r32) * D + h * 128 + c * 64 + hi * 32; qf = cat8(*(const i32x4*)Qw, *(const i32x4*)(Qw + 16)); }
    f32x16 o[4], negm;
#pragma unroll
    for (int r = 0; r < 16; ++r) { negm[r] = 0.f;
#pragma unroll
        for (int d0 = 0; d0 < 4; ++d0) o[d0][r] = 0.f; }
    float mhat = 0.f;
    f32x16 lacc;
#pragma unroll
    for (int r = 0; r < 16; ++r) lacc[r] = 0.f;
    i32x8 ones; { int o1_ = 0x38383838; asm volatile("" : "+v"(o1_)); ones = (i32x8){o1_, o1_, o1_, o1_, o1_, o1_, o1_, o1_}; }
    const int fsw = (r32 >> 2) & 3;
    const int foff0 = r32 * 64 + ((2 * hi) ^ fsw) * 16, foff1 = r32 * 64 + ((2 * hi + 1) ^ fsw) * 16;
    int sc_s = 0x7d7d7d7d, sc_1 = 0x7f7f7f7f; asm volatile("" : "+v"(sc_s), "+v"(sc_1));
    f32x16 p0, p1; i32x8 pa;
#pragma unroll
    for (int r = 0; r < 16; ++r) { p0[r] = 0.f; p1[r] = 0.f; }
#pragma unroll
    for (int k = 0; k < 8; ++k) pa[k] = 0;
#define ATT_SOFTMAX(FIRST) do { \
        float rm, rm1 = max3f(p0[3], p0[4], p0[5]), rm2 = max3f(p0[6], p0[7], p0[8]), rm3 = max3f(p0[9], p0[10], p0[11]);     \
        rm = max3f(p0[0], p0[1], p0[2]); rm = max3f(rm, p0[12], p0[13]); rm1 = max3f(rm1, p0[14], p0[15]); rm2 = max3f(rm2, p1[0], p1[1]); rm3 = max3f(rm3, p1[2], p1[3]); \
        rm = max3f(rm, p1[4], p1[5]); rm1 = max3f(rm1, p1[6], p1[7]); rm2 = max3f(rm2, p1[8], p1[9]); rm3 = max3f(rm3, p1[10], p1[11]); \
        rm = max3f(rm, p1[12], p1[13]); rm1 = max3f(rm1, p1[14], p1[15]); rm = max3f(rm, rm1, rm2); rm = max3f(rm, rm3, rm3); \
        { auto rr = __builtin_amdgcn_permlane32_swap(__float_as_uint(rm), __float_as_uint(rm), false, false); rm = max3f(__uint_as_float(rr[0]), __uint_as_float(rr[1]), __uint_as_float(rr[1])); } \
        if ((FIRST) || __any(rm > (float)THRL)) { \
            const float dl = (FIRST) ? rm : fmaxf(rm, 0.f), f = (FIRST) ? 1.0f : __builtin_amdgcn_exp2f(-dl);     \
            mhat += dl; \
            _Pragma("unroll") for (int r = 0; r < 16; ++r) { p0[r] -= dl; p1[r] -= dl; negm[r] = -mhat; } \
            if (hi == 0) wsf[r32] = f; \
            LDS_WAIT(); \
            _Pragma("unroll") for (int r = 0; r < 16; ++r) { const float fr_ = wsf[crow(r, hi)]; \
                lacc[r] *= fr_; \
                _Pragma("unroll") for (int d0 = 0; d0 < 4; ++d0) o[d0][r] *= fr_; } \
        } \
        _Pragma("unroll") for (int r = 0; r < 16; ++r) { p0[r] = __builtin_amdgcn_exp2f(p0[r]); p1[r] = __builtin_amdgcn_exp2f(p1[r]); } \
        _Pragma("unroll") for (int q = 0; q < 4; ++q) { pa[q] = (int)pack_fp8x4(p0[4 * q], p0[4 * q + 1], p0[4 * q + 2], p0[4 * q + 3]); pa[4 + q] = (int)pack_fp8x4(p1[4 * q], p1[4 * q + 1], p1[4 * q + 2], p1[4 * q + 3]); } \
    } while (0)
    ATT_VM(0); ATT_BAR();
    int sk = 0, sv = NSLOT - 1;
    for (int s = 0; s <= T; ++s) {
#define ATT_ISSUE() do { const int k2 = sk == 0 ? NSLOT - 1 : sk - 1, v1 = k2 == 0 ? NSLOT - 1 : k2 - 1;     \
          if (VAR != 3) { if (s + PFD < T) ATT_DMA_K(t_begin + s + PFD, k2); \
          if (s + PFD - 1 < T) ATT_DMA_V(t_begin + s + PFD - 1, v1); } } while (0)
        if (VAR != 1 && VAR != 5) { if (grp == 1 && s > 0) ATT_SOFTMAX(s == 1); }
        if (grp == 1) ATT_ISSUE();
        i32x8 kf0, kf1;
        if (VAR != 2 && VAR != 5 && s < T) { const LAS unsigned char* Ks = lds + LDS_K + sk * SLOTK;
            kf0 = cat8(*(const LAS i32x4*)(Ks + foff0), *(const LAS i32x4*)(Ks + foff1)); kf1 = cat8(*(const LAS i32x4*)(Ks + 2048 + foff0), *(const LAS i32x4*)(Ks + 2048 + foff1)); }
        if (VAR != 2 && VAR != 5 && s < T) {
            __builtin_amdgcn_s_setprio(1);
            p0 = __builtin_amdgcn_mfma_scale_f32_32x32x64_f8f6f4(kf0, qf, negm, 0, 0, 0, sc_s, 0, sc_s);
            p1 = __builtin_amdgcn_mfma_scale_f32_32x32x64_f8f6f4(kf1, qf, negm, 0, 0, 0, sc_s, 0, sc_s);
            __builtin_amdgcn_s_setprio(0);
        }
        if (VAR != 2 && VAR != 5 && s > 0) {
            const LAS unsigned char* Vs = lds + LDS_V + sv * SLOTV;
            i32x8 vf[4];
#pragma unroll
            for (int d0 = 0; d0 < 4; ++d0) vf[d0] = cat8(*(const LAS i32x4*)(Vs + d0 * 2048 + foff0), *(const LAS i32x4*)(Vs + d0 * 2048 + foff1));
            __builtin_amdgcn_s_setprio(1);
#pragma unroll
            for (int d0 = 0; d0 < 4; ++d0) o[d0] = __builtin_amdgcn_mfma_scale_f32_32x32x64_f8f6f4(pa, vf[d0], o[d0], 0, 0, 0, sc_1, 0, sc_1);
            lacc = __builtin_amdgcn_mfma_scale_f32_32x32x64_f8f6f4(pa, ones, lacc, 0, 0, 0, sc_1, 0, sc_1);
            __builtin_amdgcn_s_setprio(0);
        }
        if (VAR != 2 && VAR != 5 && s < T) asm volatile("s_nop 15\n\ts_nop 15" : "+v"(p0), "+v"(p1));
        if (grp == 0) ATT_ISSUE();
        if (VAR != 1 && VAR != 5) { if (grp == 0 && s < T) ATT_SOFTMAX(s == 0); }
        if (s + PFD < T) { if (dk) { ATT_VMN(2 * (PFD - 1)); } else { ATT_VMN(PFD - 1); } } else { ATT_VM(0); }
        if (VAR != 4) ATT_BAR();
        sv = sk; sk = sk == NSLOT - 1 ? 0 : sk + 1;
    }
#undef ATT_SOFTMAX
#undef ATT_ISSUE
    f32x4* scr4 = (f32x4*)(P.scr + (size_t)blockIdx.x * 32768) + tid;
    if (c == 0) {
        float rl[16];
#pragma unroll
        for (int r = 0; r < 16; ++r) rl[r] = __builtin_amdgcn_rcpf(lacc[r]);
#pragma unroll
        for (int d0 = 0; d0 < 4; ++d0)
#pragma unroll
            for (int rq = 0; rq < 4; ++rq) scr4[(d0 * 4 + rq) * 512] = (f32x4){o[d0][4 * rq] * rl[4 * rq], o[d0][4 * rq + 1] * rl[4 * rq + 1], o[d0][4 * rq + 2] * rl[4 * rq + 2], o[d0][4 * rq + 3] * rl[4 * rq + 3]};
    } else {
        f32x4 o0v[16];
#pragma unroll
        for (int q = 0; q < 16; ++q) o0v[q] = scr4[q * 512];
        const float g0 = P.subln_g[r32], g1 = P.subln_g[32 + r32], g2 = P.subln_g[64 + r32], g3 = P.subln_g[96 + r32];
        LAS unsigned char* stg = lds + LDS_OST + wid * 4096;
#pragma unroll
        for (int r = 0; r < 16; ++r) { const float rl = __builtin_amdgcn_rcpf(lacc[r]) * P.lam; float dv[4]; float ss = 0.f;
#pragma unroll
            for (int d0 = 0; d0 < 4; ++d0) { const float o0 = o0v[d0 * 4 + (r >> 2)][r & 3]; dv[d0] = o0 - o[d0][r] * rl; ss += dv[d0] * dv[d0]; }
            ss += sx<1>(ss); ss += sx<2>(ss); ss += sx<4>(ss); ss += sx<8>(ss); ss += sx<16>(ss);
            const float sc = rsqrtf(ss * (1.0f / 128.0f) + ln_eps()) * P.outscale; const int orow = crow(r, hi);
            { const unsigned pk_ = pack_fp8x4(dv[0] * sc * g0, dv[1] * sc * g1, dv[2] * sc * g2, dv[3] * sc * g3);
              stg[orow * 128 + r32] = (unsigned char)(pk_ & 0xffu); stg[orow * 128 + 32 + r32] = (unsigned char)((pk_ >> 8) & 0xffu);
              stg[orow * 128 + 64 + r32] = (unsigned char)((pk_ >> 16) & 0xffu); stg[orow * 128 + 96 + r32] = (unsigned char)(pk_ >> 24); }
            if ((r & 3) == 3) __builtin_amdgcn_sched_barrier(0); }
        LDS_WAIT();
        unsigned char* Ow = P.O + (size_t)(qrow0 + wid * 32) * D + h * 128;
#pragma unroll
        for (int i = 0; i < 4; ++i) { const int id = i * 64 + lane, row = id >> 3, ch = id & 7; const u32x4 v = *(const LAS u32x4*)(stg + row * 128 + ch * 16); *(u32x4*)(Ow + (size_t)row * D + ch * 16) = v; }
    }
    asm volatile("s_waitcnt vmcnt(0) lgkmcnt(0)\n\ts_barrier" ::: "memory");
#undef ATT_DMA_K
#undef ATT_GLDS
#undef ATT_DMA_V
#undef ATT_KROW0
#undef ATT_BAR
#undef ATT_VM
#undef ATT_VMN
}
}

struct Args { const float* in[33]; float* out; unsigned char* ws; int ph_lo, ph_hi; };
enum { I_X = 0, I_C, I_CTX, I_CCTX, I_WMOD, I_BMOD, I_LN1G, I_LN1B, I_LN2G, I_LN2B, I_AQKV, I_AWO, I_LQ1, I_LK1, I_LQ2, I_LK2, I_SUBLN, I_FW, I_FB,
       I_CPW1, I_CBPW1, I_CWDW, I_CBDW, I_CLNG, I_CLNB, I_CPW2, I_CBPW2, I_RW, I_RB, I_MW1, I_MB1, I_MW2, I_MB2 };
struct Frame {
    LAS unsigned char* lds; volatile LAS unsigned* MISC; unsigned* ctl; unsigned char* ws;
    int tid, lane, wave, vcu, G, zi;
    const float* const* in; float* out;
};
#define WSP(T, off) ((T*)(F.ws + (off)))
#define MODP(layer, ci, chunk) (WSP(const float, WS_MOD) + ((size_t)(layer) * 9 + (ci)) * 6144 + (chunk) * 1024)

__device__ __forceinline__ void ld_row_f32(const float* p, int lane, f32x4 (&v)[4]) {
#pragma unroll
    for (int j = 0; j < 4; ++j) v[j] = *(const f32x4*)(p + 4 * lane + 256 * j);
}
__device__ __forceinline__ void ld_row_bf16(const bf16_t* p, int lane, f32x4 (&v)[4]) {
#pragma unroll
    for (int j = 0; j < 4; ++j) { const u32x2 w = *(const u32x2*)(p + 4 * lane + 256 * j); v[j] = (f32x4){bf_lo(w.x), bf_hi(w.x), bf_lo(w.y), bf_hi(w.y)}; }
}
__device__ __forceinline__ void ld_row_fp8(const unsigned char* p, int lane, f32x4 (&v)[4]) {
#pragma unroll
    for (int j = 0; j < 4; ++j) { const int w = *(const int*)(p + 4 * lane + 256 * j); const f32x2 lo = __builtin_amdgcn_cvt_pk_f32_fp8(w, false), hi = __builtin_amdgcn_cvt_pk_f32_fp8(w, true); v[j] = (f32x4){lo.x, lo.y, hi.x, hi.y}; }
}
__device__ __forceinline__ void st_row_f32(float* p, int lane, const f32x4 (&v)[4]) {
#pragma unroll
    for (int j = 0; j < 4; ++j) *(f32x4*)(p + 4 * lane + 256 * j) = v[j];
}
__device__ __forceinline__ void st_row_bf16(bf16_t* p, int lane, const f32x4 (&v)[4]) {
#pragma unroll
    for (int j = 0; j < 4; ++j) { u32x2 w; w.x = cvt_pk_bf16(v[j][0], v[j][1]); w.y = cvt_pk_bf16(v[j][2], v[j][3]); *(u32x2*)(p + 4 * lane + 256 * j) = w; }
}
__device__ __forceinline__ void st_row_fp8(unsigned char* p, int lane, const f32x4 (&v)[4]) {
#pragma unroll
    for (int j = 0; j < 4; ++j) *(unsigned*)(p + 4 * lane + 256 * j) = pack_fp8x4(v[j][0], v[j][1], v[j][2], v[j][3]);
}
__device__ __forceinline__ void layer_norm_row(f32x4 (&v)[4], const float* g, const float* b, int lane) {
    float s = 0.f;
#pragma unroll
    for (int j = 0; j < 4; ++j) s += (v[j][0] + v[j][1]) + (v[j][2] + v[j][3]);
    const float mean = wave_sum(s) * (1.0f / D); float q = 0.f;
#pragma unroll
    for (int j = 0; j < 4; ++j) { v[j] = v[j] - mean; q += (v[j][0] * v[j][0] + v[j][1] * v[j][1]) + (v[j][2] * v[j][2] + v[j][3] * v[j][3]); }
    const float rstd = rsqrtf(wave_sum(q) * (1.0f / D) + ln_eps());
#pragma unroll
    for (int j = 0; j < 4; ++j) { const f32x4 gg = *(const f32x4*)(g + 4 * lane + 256 * j), bb = *(const f32x4*)(b + 4 * lane + 256 * j); v[j] = v[j] * rstd * gg + bb; }
}
__device__ __forceinline__ void ld_vec(const float* p, int lane, f32x4 (&v)[4]) {
#pragma unroll
    for (int j = 0; j < 4; ++j) v[j] = *(const f32x4*)(p + 4 * lane + 256 * j);
}
__device__ __forceinline__ void layer_norm_row_r(f32x4 (&v)[4], const f32x4 (&g)[4], const f32x4 (&b)[4]) {
    float s = 0.f;
#pragma unroll
    for (int j = 0; j < 4; ++j) s += (v[j][0] + v[j][1]) + (v[j][2] + v[j][3]);
    const float mean = wave_sum(s) * (1.0f / D); float q = 0.f;
#pragma unroll
    for (int j = 0; j < 4; ++j) { v[j] = v[j] - mean; q += (v[j][0] * v[j][0] + v[j][1] * v[j][1]) + (v[j][2] * v[j][2] + v[j][3] * v[j][3]); }
    const float rstd = rsqrtf(wave_sum(q) * (1.0f / D) + ln_eps());
#pragma unroll
    for (int j = 0; j < 4; ++j) v[j] = v[j] * rstd * g[j] + b[j];
}
__device__ __forceinline__ void ld_rowB_f32(const float* p, int lane, f32x4 (&v)[4]) {
#pragma unroll
    for (int i = 0; i < 4; ++i) v[i] = *(const f32x4*)(p + 16 * lane + 4 * i);
}
__device__ __forceinline__ void st_rowB_f32(float* p, int lane, const f32x4 (&v)[4]) {
#pragma unroll
    for (int i = 0; i < 4; ++i) *(f32x4*)(p + 16 * lane + 4 * i) = v[i];
}
__device__ __forceinline__ void ld_rowB_fp8(const unsigned char* p, int lane, f32x4 (&v)[4]) {
    const u32x4 w = *(const u32x4*)(p + 16 * lane);
#pragma unroll
    for (int i = 0; i < 4; ++i) { const f32x2 lo = __builtin_amdgcn_cvt_pk_f32_fp8((int)w[i], false), hi = __builtin_amdgcn_cvt_pk_f32_fp8((int)w[i], true); v[i] = (f32x4){lo.x, lo.y, hi.x, hi.y}; }
}
__device__ __forceinline__ void ld_rowB_bf16(const bf16_t* p, int lane, f32x4 (&v)[4]) {
    const u32x4 w0 = *(const u32x4*)(p + 16 * lane), w1 = *(const u32x4*)(p + 16 * lane + 8);
    v[0] = (f32x4){bf_lo(w0.x), bf_hi(w0.x), bf_lo(w0.y), bf_hi(w0.y)}; v[1] = (f32x4){bf_lo(w0.z), bf_hi(w0.z), bf_lo(w0.w), bf_hi(w0.w)};
    v[2] = (f32x4){bf_lo(w1.x), bf_hi(w1.x), bf_lo(w1.y), bf_hi(w1.y)}; v[3] = (f32x4){bf_lo(w1.z), bf_hi(w1.z), bf_lo(w1.w), bf_hi(w1.w)};
}
__device__ __forceinline__ int permB(int c) { return 4 * (c >> 4) + 256 * ((c >> 2) & 3) + (c & 3); }
__device__ __forceinline__ void st_rowB_fp8(unsigned char* p, int lane, const f32x4 (&v)[4]) {
    *(u32x4*)(p + 16 * lane) = (u32x4){pack_fp8x4(v[0][0], v[0][1], v[0][2], v[0][3]), pack_fp8x4(v[1][0], v[1][1], v[1][2], v[1][3]), pack_fp8x4(v[2][0], v[2][1], v[2][2], v[2][3]), pack_fp8x4(v[3][0], v[3][1], v[3][2], v[3][3])};
}
__device__ __forceinline__ void st_rowB_bf16(bf16_t* p, int lane, const f32x4 (&v)[4]) {
    *(u32x4*)(p + 16 * lane) = (u32x4){cvt_pk_bf16(v[0][0], v[0][1]), cvt_pk_bf16(v[0][2], v[0][3]), cvt_pk_bf16(v[1][0], v[1][1]), cvt_pk_bf16(v[1][2], v[1][3])};
    *(u32x4*)(p + 16 * lane + 8) = (u32x4){cvt_pk_bf16(v[2][0], v[2][1]), cvt_pk_bf16(v[2][2], v[2][3]), cvt_pk_bf16(v[3][0], v[3][1]), cvt_pk_bf16(v[3][2], v[3][3])};
}
__device__ __forceinline__ const float* xrow_in(const Frame& F, int layer, int row) {
    if (layer == 0) return row < T_LAT ? F.in[F.zi + I_X] + (size_t)row * D : F.in[F.zi + I_CTX] + (size_t)(row - T_LAT) * D;
    return WSP(const float, WS_X) + (size_t)row * D;
}
__device__ __forceinline__ int cond_of(int row) { return row < T_LAT ? (row >> 12) : 8; }

__device__ __forceinline__ void transpose_family(const Frame& F, const float* src, int nmat, int K, int N, bf16_t* dst, LAS float* scr) {
    const int lane = hidden_tid(F.wave) & 63; const int gw = F.vcu * NWAVES + F.wave, NGW = F.G * NWAVES;
    const int nkb = K / 64, nnb = N / 64, per = nkb * nnb; const long items = (long)nmat * per;
    for (long it = gw; it < items; it += NGW) {
        const int mat = (int)(it / per), r = (int)(it % per), kb = r / nnb, nb = r % nnb, k0 = kb * 64, n0 = nb * 64;
        const float* W = src + (size_t)mat * K * N; bf16_t* WT = dst + (size_t)mat * K * N;
        f32x4 v[16];
#pragma unroll
        for (int i = 0; i < 16; ++i) v[i] = *(const f32x4*)(W + (size_t)(k0 + 4 * i + (lane >> 4)) * N + n0 + 4 * (lane & 15));
#pragma unroll
        for (int i = 0; i < 16; ++i) { LAS float* s = scr + (4 * i + (lane >> 4)) * 65 + 4 * (lane & 15); s[0] = v[i][0]; s[1] = v[i][1]; s[2] = v[i][2]; s[3] = v[i][3]; }
        LDS_WAIT(); asm volatile("" ::: "memory");
        const int kc = lane & 7;
#pragma unroll
        for (int jj = 0; jj < 8; ++jj) { const int n = (lane >> 3) + 8 * jj; const LAS float* s = scr + (8 * kc) * 65 + n;
            u32x4 o; o.x = cvt_pk_bf16(s[0], s[65]); o.y = cvt_pk_bf16(s[2 * 65], s[3 * 65]); o.z = cvt_pk_bf16(s[4 * 65], s[5 * 65]); o.w = cvt_pk_bf16(s[6 * 65], s[7 * 65]);
            *(u32x4*)(WT + (size_t)(n0 + n) * K + k0 + 8 * kc) = o; }
        LDS_WAIT(); asm volatile("" ::: "memory");
    }
}
template <bool FP8> __device__ __forceinline__ void quant_w(Frame& F, const float* src, int nmat, int N, unsigned char* dst, float* scales, int rot = 0) {
    const int tid = hidden_tid(F.wave), lane = tid & 63, wave = __builtin_amdgcn_readfirstlane(tid >> 6);
    LAS float* scr = (LAS float*)(F.lds + wave * 16640);
    LAS float* cmaxp = (LAS float*)(F.lds + 133120);
    LAS float* finv = (LAS float*)(F.lds + 133120 + 2048);
    const int strips = N / 64;
    for (int it = (F.vcu + F.G - rot % F.G) % F.G; it < nmat * strips; it += F.G) {
        const int mat = it / strips, n0 = (it % strips) * 64;
        const float* W = src + (size_t)mat * 1024 * N + n0 + 4 * (lane & 15);
        f32x4 v[32];
#pragma unroll
        for (int i = 0; i < 32; ++i) v[i] = *(const f32x4*)(W + (size_t)(wave * 128 + 4 * i + (lane >> 4)) * N);
        float mx0 = 0.f, mx1 = 0.f, mx2 = 0.f, mx3 = 0.f;
#pragma unroll
        for (int i = 0; i < 32; ++i) { mx0 = fmaxf(mx0, fabsf(v[i][0])); mx1 = fmaxf(mx1, fabsf(v[i][1])); mx2 = fmaxf(mx2, fabsf(v[i][2])); mx3 = fmaxf(mx3, fabsf(v[i][3])); }
        mx0 = fmaxf(mx0, sx<16>(mx0)); mx1 = fmaxf(mx1, sx<16>(mx1)); mx2 = fmaxf(mx2, sx<16>(mx2)); mx3 = fmaxf(mx3, sx<16>(mx3));
        { auto r0 = __builtin_amdgcn_permlane32_swap(__float_as_uint(mx0), __float_as_uint(mx0), false, false); mx0 = fmaxf(__uint_as_float(r0[0]), __uint_as_float(r0[1]));
          auto r1 = __builtin_amdgcn_permlane32_swap(__float_as_uint(mx1), __float_as_uint(mx1), false, false); mx1 = fmaxf(__uint_as_float(r1[0]), __uint_as_float(r1[1]));
          auto r2 = __builtin_amdgcn_permlane32_swap(__float_as_uint(mx2), __float_as_uint(mx2), false, false); mx2 = fmaxf(__uint_as_float(r2[0]), __uint_as_float(r2[1]));
          auto r3 = __builtin_amdgcn_permlane32_swap(__float_as_uint(mx3), __float_as_uint(mx3), false, false); mx3 = fmaxf(__uint_as_float(r3[0]), __uint_as_float(r3[1])); }
        if (lane < 16) *(LAS f32x4*)(cmaxp + wave * 64 + 4 * lane) = (f32x4){mx0, mx1, mx2, mx3};
        __syncthreads();
        if (tid < 64) { float m = cmaxp[tid];
#pragma unroll
            for (int w = 1; w < 8; ++w) m = fmaxf(m, cmaxp[w * 64 + tid]);
            const float sc = m > 0.f ? m * (1.0f / (FP8 ? FP8_TOP : 127.0f)) : 1.0f; scales[(size_t)mat * N + n0 + tid] = sc; finv[tid] = 1.0f / sc; }
        __syncthreads();
        unsigned char* Wq = dst + (size_t)mat * N * 1024;
#pragma unroll
        for (int kb2 = 0; kb2 < 2; ++kb2) { const int k0 = wave * 128 + kb2 * 64;
#pragma unroll
            for (int i = 0; i < 16; ++i) { LAS float* sp = scr + (4 * i + (lane >> 4)) * 65 + 4 * (lane & 15); sp[0] = v[16 * kb2 + i][0]; sp[1] = v[16 * kb2 + i][1]; sp[2] = v[16 * kb2 + i][2]; sp[3] = v[16 * kb2 + i][3]; }
            LDS_WAIT(); asm volatile("" ::: "memory");
            const int kc = lane & 3;
#pragma unroll
            for (int jj = 0; jj < 4; ++jj) { const int n = (lane >> 2) + 16 * jj; const LAS float* sp = scr + (16 * kc) * 65 + n; const float fi = finv[n];
                u32x4 o;
                if (FP8) { o.x = pack_fp8x4(sp[0] * fi, sp[65] * fi, sp[2 * 65] * fi, sp[3 * 65] * fi); o.y = pack_fp8x4(sp[4 * 65] * fi, sp[5 * 65] * fi, sp[6 * 65] * fi, sp[7 * 65] * fi);
                    o.z = pack_fp8x4(sp[8 * 65] * fi, sp[9 * 65] * fi, sp[10 * 65] * fi, sp[11 * 65] * fi); o.w = pack_fp8x4(sp[12 * 65] * fi, sp[13 * 65] * fi, sp[14 * 65] * fi, sp[15 * 65] * fi); }
                else { o.x = pack_i8x4(sp[0] * fi, sp[65] * fi, sp[2 * 65] * fi, sp[3 * 65] * fi); o.y = pack_i8x4(sp[4 * 65] * fi, sp[5 * 65] * fi, sp[6 * 65] * fi, sp[7 * 65] * fi);
                    o.z = pack_i8x4(sp[8 * 65] * fi, sp[9 * 65] * fi, sp[10 * 65] * fi, sp[11 * 65] * fi); o.w = pack_i8x4(sp[12 * 65] * fi, sp[13 * 65] * fi, sp[14 * 65] * fi, sp[15 * 65] * fi); }
                *(u32x4*)(Wq + (size_t)(n0 + n) * 1024 + k0 + 16 * kc) = o; }
            LDS_WAIT(); asm volatile("" ::: "memory");
        }
        __syncthreads();
    }
}
__device__ __forceinline__ void p0_prologue(Frame& F) {
    const int tid = hidden_tid(F.wave), lane = tid & 63, wave = __builtin_amdgcn_readfirstlane(tid >> 6);
    LAS float* sc = (LAS float*)F.lds;
    LAS float* red = (LAS float*)(F.lds + 40960);
    for (int i = tid; i < 9 * 1024; i += NTHR) { const float cv = i < 8192 ? F.in[F.zi + I_C][i] : F.in[F.zi + I_CCTX][i - 8192]; sc[i] = cv * fast_sigmoid(cv); }
    __syncthreads();
    for (int it = F.vcu; it < 4 * 96; it += F.G) {
        const int layer = it / 96, n = (it % 96) * 64 + lane;
        const float* W = F.in[F.zi + I_WMOD] + (size_t)layer * 1024 * 6144 + n;
        float a[9];
#pragma unroll
        for (int r = 0; r < 9; ++r) a[r] = 0.f;
#pragma unroll 8
        for (int k = wave * 128; k < wave * 128 + 128; ++k) { const float w = W[(size_t)k * 6144];
#pragma unroll
            for (int r = 0; r < 9; ++r) a[r] += sc[r * 1024 + k] * w; }
#pragma unroll
        for (int r = 0; r < 9; ++r) red[(wave * 9 + r) * 64 + lane] = a[r];
        __syncthreads();
        for (int r = wave; r < 9; r += NWAVES) { float s = F.in[F.zi + I_BMOD][layer * 6144 + n];
#pragma unroll
            for (int w = 0; w < 8; ++w) s += red[(w * 9 + r) * 64 + lane];
            WSP(float, WS_MOD)[((size_t)layer * 9 + r) * 6144 + n] = s; }
        __syncthreads();
    }
    const int gt = F.vcu * NTHR + tid, NGT = F.G * NTHR;
    for (int i = gt; i < 64 * 16; i += NGT) { const int pos = i >> 4, f = i & 15; const float inv = __powf(10000.0f, -(float)f / 16.0f); float s, c; sincosf((float)pos * inv, &s, &c);
        WSP(float, WS_ROPE)[2 * i] = c; WSP(float, WS_ROPE)[2 * i + 1] = s; }
    for (int i = gt; i < 2 * 256 * 256; i += NGT) { const int cs = i >> 16, r = (i >> 8) & 255, k = i & 255; float v = 0.f;
        if ((r >> 7) == (k >> 7)) { const int m = ((r & 127) * (k & 127)) & 127; v = (cs ? sinpif((float)m / 64.0f) : cospif((float)m / 64.0f)) * 0.08838834764831845f; }
        WSP(bf16_t, WS_ACS)[i] = (bf16_t)(cvt_pk_bf16(v, 0.f) & 0xffffu); }
    for (int i = gt; i < 256 * 512; i += NGT) { const int k = i >> 9, j = i & 511, n = j & 255; const int m = (k * n) & 255;
        const float v = (j < 256 ? cospif((float)m / 128.0f) : -sinpif((float)m / 128.0f)) * (0.0625f * DFT_PRESCALE);
        WSP(unsigned char, WS_DFTN)[(size_t)(4096 + k) * 8192 + j] = (unsigned char)(pack_fp8x4(v, 0.f, 0.f, 0.f) & 0xffu); }
    LAS float* tab = (LAS float*)(F.lds + 81920);
    for (int m = tid; m < 4096; m += NTHR) tab[m] = cospif((float)m / 2048.0f) * (0.015625f * DFT_PRESCALE);
    __syncthreads();
    for (int i = gt; i < 4096 * 1024; i += NGT) {
        const int k = i >> 10, j0 = (i & 1023) * 8; unsigned w[2];
#pragma unroll
        for (int q = 0; q < 2; ++q) { float v[4];
#pragma unroll
            for (int e = 0; e < 4; ++e) { const int j = j0 + 4 * q + e, n = j & 4095; const int m = (k * n) & 4095;
                v[e] = j < 4096 ? tab[m] : -tab[(m - 1024) & 4095]; }
            w[q] = pack_fp8x4(v[0], v[1], v[2], v[3]); }
        *(u32x2*)(WSP(unsigned char, WS_DFTN) + (size_t)k * 8192 + j0) = (u32x2){w[0], w[1]}; }
    __syncthreads();
    LAS float* scr = (LAS float*)(F.lds + wave * 16640);
    (void)scr;
    __syncthreads();
    quant_w<true>(F, F.in[F.zi + I_AQKV], 2, 3072, WSP(unsigned char, WS_WQKV), WSP(float, WS_WQKVS));
    quant_w<true>(F, F.in[F.zi + I_CPW1], 1, 2048, WSP(unsigned char, WS_PW1), WSP(float, WS_PW1S), 96);
    quant_w<true>(F, F.in[F.zi + I_AWO], 2, 1024, WSP(unsigned char, WS_WO), WSP(float, WS_WZS), 128);
    quant_w<true>(F, F.in[F.zi + I_FW], 1, 1024, WSP(unsigned char, WS_WF), WSP(float, WS_WZS) + 2048, 160);
    quant_w<true>(F, F.in[F.zi + I_CPW2], 1, 1024, WSP(unsigned char, WS_PW2), WSP(float, WS_WZS) + 3072, 176);
    quant_w<false>(F, F.in[F.zi + I_MW1], 128, 2048, WSP(unsigned char, WS_W1), WSP(float, WS_W1S));
    quant_w<true>(F, F.in[F.zi + I_MW2], 128, 1024, WSP(unsigned char, WS_W2), WSP(float, WS_W2S));
}
__device__ __forceinline__ void p1_modulate(Frame& F) {
    const int lane = hidden_tid(F.wave) & 63; const int gw = F.vcu * NWAVES + F.wave, NGW = F.G * NWAVES;
    const int per = (T_ALL + NGW - 1) / NGW, r0 = gw * per, r1 = min(T_ALL, r0 + per);
    int cic = -1; f32x4 psh[4], psc[4], nx[4];
    if (r0 < r1) ld_rowB_f32(xrow_in(F, 0, r0), lane, nx);
    for (int row = r0; row < r1; ++row) { const int ci = cond_of(row);
        if (ci != cic) { ld_rowB_f32(MODP(0, ci, 0), lane, psh); ld_rowB_f32(MODP(0, ci, 1), lane, psc); cic = ci; }
        f32x4 v[4];
#pragma unroll
        for (int j = 0; j < 4; ++j) v[j] = nx[j];
        ld_rowB_f32(xrow_in(F, 0, row + 1 < r1 ? row + 1 : row), lane, nx);
        st_rowB_bf16(WSP(bf16_t, WS_X) + (size_t)row * D, lane, v);
#pragma unroll
        for (int j = 0; j < 4; ++j) v[j] = v[j] * (1.0f + psc[j]) + psh[j];
        st_rowB_fp8(WSP(unsigned char, WS_U) + (size_t)row * D, lane, v); }
}
struct LRaw { u32x4 x0, x1, y0, y1; };
__device__ __forceinline__ void ln1_load(Frame& F, int row, int lane, LRaw& r) {
    const bf16_t* xp = WSP(const bf16_t, WS_X) + (size_t)row * D + 16 * lane; const bf16_t* yp = WSP(const bf16_t, WS_Y) + (size_t)row * D + 16 * lane;
    r.x0 = *(const u32x4*)xp; r.x1 = *(const u32x4*)(xp + 8); r.y0 = *(const u32x4*)yp; r.y1 = *(const u32x4*)(yp + 8);
}
__device__ __forceinline__ void unpack_bf16x16(const u32x4 w0, const u32x4 w1, f32x4 (&v)[4]) {
    v[0] = (f32x4){bf_lo(w0.x), bf_hi(w0.x), bf_lo(w0.y), bf_hi(w0.y)}; v[1] = (f32x4){bf_lo(w0.z), bf_hi(w0.z), bf_lo(w0.w), bf_hi(w0.w)};
    v[2] = (f32x4){bf_lo(w1.x), bf_hi(w1.x), bf_lo(w1.y), bf_hi(w1.y)}; v[3] = (f32x4){bf_lo(w1.z), bf_hi(w1.z), bf_lo(w1.w), bf_hi(w1.w)};
}
__device__ __forceinline__ void ln1_row(Frame& F, int layer, int row, int lane, const LRaw& raw, const LAS float* lgl, const f32x4 (&g1)[4], const f32x4 (&sc2)[4], const f32x4 (&sh2)[4], f32x4 (&v)[4]) {
    f32x4 y[4];
    unpack_bf16x16(raw.x0, raw.x1, v); unpack_bf16x16(raw.y0, raw.y1, y);
#pragma unroll
    for (int j = 0; j < 4; ++j) v[j] = DN_ALPHA * v[j] + g1[j] * y[j];
    { f32x4 lg[4], lb[4];
#pragma unroll
      for (int j = 0; j < 4; ++j) { lg[j] = *(const LAS f32x4*)(lgl + 4 * lane + 256 * j); lb[j] = *(const LAS f32x4*)(lgl + 1024 + 4 * lane + 256 * j); }
      layer_norm_row_r(v, lg, lb); }
    st_rowB_bf16(WSP(bf16_t, WS_X1) + (size_t)row * D, lane, v);
    float am = 0.f;
#pragma unroll
    for (int j = 0; j < 4; ++j) { v[j] = v[j] * (1.0f + sc2[j]) + sh2[j]; am = fmaxf(am, fmaxf(fmaxf(fabsf(v[j][0]), fabsf(v[j][1])), fmaxf(fabsf(v[j][2]), fabsf(v[j][3])))); }
    am = wave_max(am); const float qs = am > 0.f ? am * (1.0f / 127.0f) : 1.0f, qi = 1.0f / qs;
    *(u32x4*)(WSP(unsigned char, WS_V2) + (size_t)row * D + 16 * lane) = (u32x4){pack_i8x4(v[0][0] * qi, v[0][1] * qi, v[0][2] * qi, v[0][3] * qi), pack_i8x4(v[1][0] * qi, v[1][1] * qi, v[1][2] * qi, v[1][3] * qi),
        pack_i8x4(v[2][0] * qi, v[2][1] * qi, v[2][2] * qi, v[2][3] * qi), pack_i8x4(v[3][0] * qi, v[3][1] * qi, v[3][2] * qi, v[3][3] * qi)};
    if (lane == 0) WSP(float, WS_V2S)[row] = qs;
}
__device__ __forceinline__ float reduce_scatter32(float (&p)[32], int lane) {
    float q16[16], q8[8], q4[4], q2[2];
    { const bool up = (lane & 32) != 0;
#pragma unroll
      for (int i = 0; i < 16; ++i) { const float keep = up ? p[16 + i] : p[i], send = up ? p[i] : p[16 + i];
          auto rr = __builtin_amdgcn_permlane32_swap(__float_as_uint(send), __float_as_uint(send), false, false); q16[i] = keep + (up ? __uint_as_float(rr[0]) : __uint_as_float(rr[1])); } }
    { const bool up = (lane & 16) != 0;
#pragma unroll
      for (int i = 0; i < 8; ++i) { const float keep = up ? q16[8 + i] : q16[i], send = up ? q16[i] : q16[8 + i]; q8[i] = keep + sx<16>(send); } }
    { const bool up = (lane & 8) != 0;
#pragma unroll
      for (int i = 0; i < 4; ++i) { const float keep = up ? q8[4 + i] : q8[i], send = up ? q8[i] : q8[4 + i]; q4[i] = keep + sx<8>(send); } }
    { const bool up = (lane & 4) != 0;
#pragma unroll
      for (int i = 0; i < 2; ++i) { const float keep = up ? q4[2 + i] : q4[i], send = up ? q4[i] : q4[2 + i]; q2[i] = keep + sx<4>(send); } }
    float r; { const bool up = (lane & 2) != 0; const float keep = up ? q2[1] : q2[0], send = up ? q2[0] : q2[1]; r = keep + sx<2>(send); }
    return r + sx<1>(r);
}
__device__ __forceinline__ void route_token(Frame& F, int row, int lane, float lg, LAS float* ws, volatile LAS int* hist) {
    const int e = (lane >> 1) & 31;
    if ((lane & 1) == 0) ws[e] = lg;
    LDS_WAIT();
    int rank = 0;
#pragma unroll
    for (int q = 0; q < 8; ++q) { const f32x4 o = *(const LAS f32x4*)(ws + 4 * q);
#pragma unroll
        for (int j = 0; j < 4; ++j) { const int e2 = 4 * q + j; rank += (o[j] > lg || (o[j] == lg && e2 < e)) ? 1 : 0; } }
    if (rank < 4 && (lane & 1) == 0) ws[32 + rank] = lg;
    LDS_WAIT();
    const f32x4 tv = *(const LAS f32x4*)(ws + 32);
    const float e1 = __expf(tv[1] - tv[0]), e2 = __expf(tv[2] - tv[0]), e3 = __expf(tv[3] - tv[0]); const float inv = 1.0f / (1.0f + e1 + e2 + e3);
    if (rank < 4 && (lane & 1) == 0) {
        WSP(int, WS_TOPK)[(size_t)row * 4 + rank] = e; WSP(float, WS_GATE)[(size_t)row * 4 + rank] = __expf(lg - tv[0]) * inv;
        int one_ = 1; asm volatile("" : "+v"(one_)); __hip_atomic_fetch_add((LAS int*)(hist + e), one_, __ATOMIC_RELAXED, __HIP_MEMORY_SCOPE_WORKGROUP); }
}
__device__ __forceinline__ void phase_ln1_router(Frame& F, int layer, int nrows, bool count) {
    const int tid = hidden_tid(F.wave), lane = tid & 63;
    LAS float* wt = (LAS float*)F.lds;
    LAS float* wsc = (LAS float*)(F.lds + 131072) + F.wave * 128;
    volatile LAS int* hist = (volatile LAS int*)(F.lds + MISC_OFF + 64);
    const float* Wr = F.in[F.zi + I_RW] + (size_t)layer * 1024 * 32;
    for (int i = tid; i < 32768; i += NTHR) wt[(i & 31) * 1024 + permB(i >> 5)] = Wr[i];
    if (tid < 32) hist[tid] = 0;
    { u32x4* rt = WSP(u32x4, WS_ROWTOK); int gstep = F.G * NTHR; asm volatile("" : "+s"(gstep));
      unsigned zz = 0u; asm volatile("" : "+v"(zz));
#pragma clang loop vectorize(disable) unroll(disable)
      for (int p = F.vcu * NTHR + tid; p < P_MAX / 4; p += gstep) rt[p] = (u32x4){zz, zz, zz, zz}; }
    LAS float* lgl = (LAS float*)(F.lds + 131072 + 4096);
    for (int i = tid; i < 2048; i += NTHR) lgl[(i & 1024) + permB(i & 1023)] = i < 1024 ? F.in[F.zi + I_LN1G][layer * D + i] : F.in[F.zi + I_LN1B][layer * D + i - 1024];
    __syncthreads();
    f32x4 pg1[4], psc[4], psh[4];
    const float rbias = F.in[F.zi + I_RB][layer * 32 + ((lane >> 1) & 31)];
    const int gw = F.vcu * NWAVES + F.wave, NGW = F.G * NWAVES;
    const int npairs = nrows / 2, per = (npairs + NGW - 1) / NGW, p0 = gw * per, p1 = min(npairs, p0 + per);
    int cic = -1;
    LRaw ra, rb;
    if (p0 < p1) { ln1_load(F, 2 * p0, lane, ra); ln1_load(F, 2 * p0 + 1, lane, rb); }
    for (int pr = p0; pr < p1; ++pr) {
        const int ci = cond_of(2 * pr);
        if (ci != cic) { ld_rowB_f32(MODP(layer, ci, 2), lane, pg1); ld_rowB_f32(MODP(layer, ci, 4), lane, psc); ld_rowB_f32(MODP(layer, ci, 3), lane, psh); cic = ci; }
        f32x4 va[4], vb[4];
        ln1_row(F, layer, 2 * pr, lane, ra, lgl, pg1, psc, psh, va); ln1_row(F, layer, 2 * pr + 1, lane, rb, lgl, pg1, psc, psh, vb);
        { const int pn = pr + 1 < p1 ? pr + 1 : pr; ln1_load(F, 2 * pn, lane, ra); ln1_load(F, 2 * pn + 1, lane, rb); }
        float pa[32], pb[32];
#pragma unroll
        for (int e = 0; e < 32; ++e) { f32x2 sa = (f32x2){0.f, 0.f}, sb = sa;
#pragma unroll
            for (int j = 0; j < 4; ++j) { const f32x4 w = *(const LAS f32x4*)(wt + e * 1024 + 4 * lane + 256 * j);
                const f32x2 wl = __builtin_shufflevector(w, w, 0, 1), wh = __builtin_shufflevector(w, w, 2, 3);
                sa = __builtin_elementwise_fma(__builtin_shufflevector(va[j], va[j], 0, 1), wl, sa); sa = __builtin_elementwise_fma(__builtin_shufflevector(va[j], va[j], 2, 3), wh, sa);
                sb = __builtin_elementwise_fma(__builtin_shufflevector(vb[j], vb[j], 0, 1), wl, sb); sb = __builtin_elementwise_fma(__builtin_shufflevector(vb[j], vb[j], 2, 3), wh, sb); }
            pa[e] = sa.x + sa.y; pb[e] = sb.x + sb.y; }
        const float la = reduce_scatter32(pa, lane) + rbias, lbv = reduce_scatter32(pb, lane) + rbias;
        route_token(F, 2 * pr, lane, la, wsc, hist); route_token(F, 2 * pr + 1, lane, lbv, wsc + 64, hist);
    }
    __syncthreads();
    if (tid < 32 && count) { const int hv = hist[tid]; if (hv) __hip_atomic_fetch_add(F.ctl + CW_CNT + layer * 32 + tid, (unsigned)hv, RLX_AGENT); }
}
__device__ __forceinline__ volatile LAS int* moe_tables(Frame& F, int layer) {
    volatile LAS int* ts = (volatile LAS int*)(F.lds + MISC_OFF + 256);
    if (hidden_tid(F.wave) == 0) { int acc = 0; for (int e = 0; e < 32; ++e) { ts[e] = acc; acc += ((int)__hip_atomic_load(F.ctl + CW_CNT + layer * 32 + e, RLX_AGENT) + 255) >> 8; } ts[32] = acc; }
    __syncthreads();
    return ts;
}
__device__ __forceinline__ void phase_assign(Frame& F, int layer, int nrows) {
    const int tid = hidden_tid(F.wave);
    volatile LAS int* ts = moe_tables(F, layer);
    volatile LAS int* lcnt = (volatile LAS int*)(F.lds + MISC_OFF + 512);
    volatile LAS int* lbase = (volatile LAS int*)(F.lds + MISC_OFF + 640);
    if (tid < 32) lcnt[tid] = 0;
    __syncthreads();
    const int chunk = (nrows + F.G - 1) / F.G, r0 = F.vcu * chunk, r1 = min(nrows, r0 + chunk);
    const int* tk = WSP(const int, WS_TOPK);
    int one_ = 1; asm volatile("" : "+v"(one_));
    for (int i = r0 * 4 + tid; i < r1 * 4; i += NTHR) __hip_atomic_fetch_add((LAS int*)(lcnt + tk[i]), one_, __ATOMIC_RELAXED, __HIP_MEMORY_SCOPE_WORKGROUP);
    __syncthreads();
    if (tid < 32) { const int n = lcnt[tid]; int base = ts[tid] * 256; if (n) base += (int)__hip_atomic_fetch_add(F.ctl + CW_CUR + layer * 32 + tid, (unsigned)n, RLX_AGENT); lbase[tid] = base; lcnt[tid] = 0; }
    __syncthreads();
    int* rt = WSP(int, WS_ROWTOK); int* pos = WSP(int, WS_POS); float* sap = WSP(float, WS_SAP); const float* sa = WSP(const float, WS_V2S);
    for (int i = r0 * 4 + tid; i < r1 * 4; i += NTHR) { const int e = tk[i]; const int p = lbase[e] + __hip_atomic_fetch_add((LAS int*)(lcnt + e), one_, __ATOMIC_RELAXED, __HIP_MEMORY_SCOPE_WORKGROUP); rt[p] = i >> 2; pos[i] = p; sap[p] = sa[i >> 2]; }
}
__device__ __forceinline__ void combine_row(Frame& F, int layer, int row, int lane, bool last, bool fp8u, const int4 ps, const f32x4 gt, const f32x4 (&lg)[4], const f32x4 (&lb)[4], const f32x4 (&pg2)[4], const f32x4 (&psc)[4], const f32x4 (&psh)[4]) {
    const int pk[4] = {ps.x, ps.y, ps.z, ps.w};
    f32x4 y[4][4], v[4];
    ld_rowB_bf16(WSP(const bf16_t, WS_X1) + (size_t)row * D, lane, v);
#pragma unroll
    for (int k = 0; k < 4; ++k) ld_rowB_fp8(WSP(const unsigned char, WS_Y2) + (size_t)pk[k] * D, lane, y[k]);
    f32x4 a[4];
#pragma unroll
    for (int j = 0; j < 4; ++j) { a[j] = (gt[0] * y[0][j] + gt[1] * y[1][j]) + (gt[2] * y[2][j] + gt[3] * y[3][j]); v[j] = DN_ALPHA * v[j] + (pg2[j] * (1.0f / Y2_PRESCALE)) * a[j]; }
    layer_norm_row_r(v, lg, lb);
    if (last) { st_rowB_f32(F.out + (size_t)row * D, lane, v); }
    else { st_rowB_bf16(WSP(bf16_t, WS_X) + (size_t)row * D, lane, v);
#pragma unroll
        for (int j = 0; j < 4; ++j) v[j] = v[j] * (1.0f + psc[j]) + psh[j];
        if (fp8u) st_rowB_fp8(WSP(unsigned char, WS_U) + (size_t)row * D, lane, v);
        else st_rowB_bf16(WSP(bf16_t, WS_U) + (size_t)row * D, lane, v); }
}
__device__ __forceinline__ void phase_combine_ln2(Frame& F, int layer, int nrows) {
    const int lane = hidden_tid(F.wave) & 63; const bool last = layer == DEPTH - 1; const bool fp8u = (layer + 1) % 3 != 1;
    f32x4 lg[4], lb[4], pg2[4], psc[4], psh[4]; ld_rowB_f32(F.in[F.zi + I_LN2G] + layer * D, lane, lg); ld_rowB_f32(F.in[F.zi + I_LN2B] + layer * D, lane, lb);
    const int gw = F.vcu * NWAVES + F.wave, NGW = F.G * NWAVES;
    const int npairs = nrows / 2, per = (npairs + NGW - 1) / NGW, p0 = gw * per, p1 = min(npairs, p0 + per);
    const int4* posp = WSP(const int4, WS_POS); const f32x4* gatp = WSP(const f32x4, WS_GATE);
    int cic = -1;
    int4 psa, psb; f32x4 gta, gtb;
    if (p0 < p1) { psa = posp[2 * p0]; psb = posp[2 * p0 + 1]; gta = gatp[2 * p0]; gtb = gatp[2 * p0 + 1]; }
    for (int pr = p0; pr < p1; ++pr) {
        const int ci = cond_of(2 * pr);
        if (ci != cic) { ld_rowB_f32(MODP(layer, ci, 5), lane, pg2); if (!last) { ld_rowB_f32(MODP(layer + 1, ci, 1), lane, psc); ld_rowB_f32(MODP(layer + 1, ci, 0), lane, psh); } cic = ci; }
        const int4 ca = psa, cb = psb; const f32x4 ga = gta, gb = gtb;
        const int pn = pr + 1 < p1 ? pr + 1 : pr;
        psa = posp[2 * pn]; psb = posp[2 * pn + 1]; gta = gatp[2 * pn]; gtb = gatp[2 * pn + 1];
        combine_row(F, layer, 2 * pr, lane, last, fp8u, ca, ga, lg, lb, pg2, psc, psh);
        combine_row(F, layer, 2 * pr + 1, lane, last, fp8u, cb, gb, lg, lb, pg2, psc, psh);
    }
}
__device__ __forceinline__ void phase_dwconv(Frame& F) {
    const int tid = hidden_tid(F.wave), lane = tid & 63, wave = __builtin_amdgcn_readfirstlane(tid >> 6);
    LAS unsigned* tile = (LAS unsigned*)F.lds;
    LAS float* red = (LAS float*)(F.lds + 126976);
    const float* wdw = F.in[F.zi + I_CWDW]; f32x2 wv[31];
#pragma unroll
    for (int j = 0; j < 31; ++j) { unsigned bo = (unsigned)(j * D + 2 * tid) * 4u; asm volatile("" : "+v"(bo));
        wv[j] = *(const f32x2*)((const char*)wdw + bo); }
    const f32x2 bdw = *(const f32x2*)(F.in[F.zi + I_CBDW] + 2 * tid), lng = *(const f32x2*)(F.in[F.zi + I_CLNG] + 2 * tid), lnb = *(const f32x2*)(F.in[F.zi + I_CLNB] + 2 * tid);
    const bf16_t* Gin = WSP(const bf16_t, WS_G); unsigned char* outp = WSP(unsigned char, WS_MIX);
    for (int un = F.vcu; un < 1024 + 64; un += F.G) {
        int seq0, slen, t0;
        if (un < 1024) { seq0 = (un >> 7) * SEQ; slen = SEQ; t0 = (un & 127) * 32; } else { const int q = un - 1024; seq0 = T_LAT + (q >> 3) * CTXL; slen = CTXL; t0 = (q & 7) * 32; }
        __syncthreads();
        { const int rb_ = tid >> 7, ch = tid & 127;
#pragma unroll 1
          for (int qb = 0; qb < 4; ++qb) { u32x4 v[4];
#pragma unroll
              for (int u = 0; u < 4; ++u) { const int r = rb_ + 4 * (4 * qb + u), t = t0 - 15 + r; const int tc = t < 0 ? 0 : (t >= slen ? slen - 1 : t);
                  v[u] = *(const u32x4*)(Gin + (size_t)(seq0 + tc) * D + ch * 8); }
#pragma unroll
              for (int u = 0; u < 4; ++u) { const int r = rb_ + 4 * (4 * qb + u), t = t0 - 15 + r; const bool ok = t >= 0 && t < slen;
                  const u32x4 w = ok ? v[u] : (u32x4){0u, 0u, 0u, 0u};
                  if (r < 62) *(LAS u32x4*)(tile + r * 512 + ch * 4) = w; } } }
        __syncthreads();
        for (int hf = 0; hf < 2; ++hf) {
            f32x2 ov[16];
#pragma unroll
            for (int t = 0; t < 16; ++t) ov[t] = bdw;
            const LAS unsigned* tp = tile + hf * 16 * 512 + tid;
#pragma unroll
            for (int r = 0; r < 46; ++r) { const unsigned w = tp[r * 512]; const f32x2 xv = (f32x2){bf_lo(w), bf_hi(w)};
#pragma unroll
                for (int t = 0; t < 16; ++t) { const int j = r - t; if (j >= 0 && j < 31) ov[t] = __builtin_elementwise_fma(wv[j], xv, ov[t]); }
                if ((r & 7) == 7) __builtin_amdgcn_sched_barrier(0); }
            float o0[16], o1[16];
#pragma unroll
            for (int t = 0; t < 16; ++t) { o0[t] = ov[t].x; o1[t] = ov[t].y; }
#pragma unroll
            for (int t = 0; t < 16; ++t) { float s = o0[t] + o1[t], q = o0[t] * o0[t] + o1[t] * o1[t]; s = wave_sum(s); q = wave_sum(q);
                if (lane == 0) { red[(wave * 16 + t) * 2] = s; red[(wave * 16 + t) * 2 + 1] = q; } }
            __syncthreads();
#pragma unroll
            for (int t = 0; t < 16; t += 2) { unsigned pk2[2];
#pragma unroll
                for (int u = 0; u < 2; ++u) { float s = 0.f, q = 0.f;
#pragma unroll
                    for (int w = 0; w < 8; ++w) { s += red[(w * 16 + t + u) * 2]; q += red[(w * 16 + t + u) * 2 + 1]; }
                    const float mean = s * (1.0f / D), var = fmaxf(q * (1.0f / D) - mean * mean, 0.f), rstd = rsqrtf(var + ln_eps());
                    const float a0 = (o0[t + u] - mean) * rstd * lng.x + lnb.x, a1 = (o1[t + u] - mean) * rstd * lng.y + lnb.y;
                    pk2[u] = pack_fp8x4(a0 * fast_sigmoid(a0) * MIX_PRESCALE, a1 * fast_sigmoid(a1) * MIX_PRESCALE, 0.f, 0.f) & 0xffffu; }
                const bool odd = (tid & 1) != 0;
                const unsigned got = __float_as_uint(sx<1>(__uint_as_float(odd ? pk2[0] : pk2[1])));
                const unsigned word = odd ? (got | (pk2[1] << 16)) : (pk2[0] | (got << 16));
                *(unsigned*)(outp + (size_t)(seq0 + t0 + hf * 16 + t + (odd ? 1 : 0)) * D + 2 * (tid & ~1)) = word; }
            __syncthreads();
        }
    }
}
constexpr int NPHASE = 2 + 8 * DEPTH;
__global__ void __launch_bounds__(NTHR, 2) fwd(Args args) {
    extern __shared__ __attribute__((aligned(16))) unsigned char lds_raw[];
    Frame F;
    F.lds = (LAS unsigned char*)lds_raw; F.MISC = (volatile LAS unsigned*)(F.lds + MISC_OFF);
    F.tid = threadIdx.x; F.lane = F.tid & 63; F.wave = __builtin_amdgcn_readfirstlane(F.tid >> 6);
    F.G = gridDim.x; { const int bx = blockIdx.x; F.vcu = (F.G % 8 == 0) ? (bx % 8) * (F.G / 8) + bx / 8 : bx; }
    F.ws = args.ws; F.ctl = (unsigned*)(args.ws + WS_CTL); F.in = args.in; F.out = args.out; F.zi = 0;
    for (int u = F.tid; u < 512; u += NTHR) ((LAS unsigned*)(F.lds + MISC_OFF))[u] = 0u;
    __syncthreads();

    const int lo = args.ph_lo, hi = args.ph_hi;
    XcdBarrier bar; bar.bar = F.ctl + CW_BAR; bar.x = 0; bar.st = nullptr;
    if (hi - lo > 1) bar = xcd_barrier_post(F.ctl + CW_BAR, F.MISC);
#define IN(k) (lo <= (k) && (k) < hi)
#define SEAM(k) do { if (IN(k) && IN((k) + 1)) xcd_barrier(bar, F.wave); } while (0)
    int bx = (int)blockIdx.x; const int vcu0 = F.vcu, wave0 = F.wave; const unsigned xcc0 = bar.x;

    if (EN(0) && IN(0)) { for (int rep = 0; rep < NREP(0); ++rep) { __syncthreads(); p0_prologue(F); } } SEAM(0);
    if (EN(1) && IN(1)) { for (int rep = 0; rep < NREP(1); ++rep) { __syncthreads(); p1_modulate(F); } } SEAM(1);

    for (int layer = 0; layer < DEPTH; ++layer) {
        {
            const int z_ = __builtin_amdgcn_readfirstlane((int)F.MISC[2]);
            F.zi = z_; F.ws = args.ws + z_; F.out = args.out + z_; F.ctl = (unsigned*)(F.ws + WS_CTL); bar.bar = F.ctl + CW_BAR;
            F.G = (int)gridDim.x + z_; F.vcu = vcu0 + z_; bx = (int)blockIdx.x + z_; F.lds = (LAS unsigned char*)lds_raw + z_; F.MISC = (volatile LAS unsigned*)(F.lds + MISC_OFF); bar.st = F.MISC; bar.x = xcc0 + (unsigned)z_; F.wave = wave0 + z_; }
        const int pb = 2 + 8 * layer, kind = layer % 3, jj = layer / 3; const bool last = layer == DEPTH - 1;
        const int nrows = last ? T_LAT : T_ALL;
        if (IN(pb + 0)) for (int rep = 0; rep < NREP(kind == 0 ? 2 : (kind == 1 ? 3 : 4)); ++rep) {
            if (EN(2) && kind == 0) {
                const unsigned char* W8 = WSP(const unsigned char, WS_WQKV) + (size_t)jj * 3072 * 1024; const float* sw = WSP(const float, WS_WQKVS) + jj * 3072;
                { DenseSched S; S.init8(WSP(const unsigned char, WS_U), W8, T_ALL, 2048, 1024, 1024, F.G, bx);
                  EpiQK8 E{WSP(unsigned char, WS_Q), WSP(const float, WS_ROPE), sw};
                  g8::gemm_phase(F.lds, S, E, F.wave); }
                { VtSched S; S.init(W8 + (size_t)2048 * 1024, WSP(const unsigned char, WS_U), F.G, bx);
                  EpiVt8 E{WSP(unsigned char, WS_V), sw + 2048};
                  g8::gemm_phase(F.lds, S, E, F.wave); }
            } else if (EN(3) && kind == 1) {
                F1Sched S; S.init(WSP(const bf16_t, WS_ACS), WSP(const bf16_t, WS_U), F.G, bx);
                EpiFp8T<0> E{WSP(unsigned char, WS_YT), 8192, 1.0f};
                g8::gemm_phase(F.lds, S, E, F.wave);
            } else if (EN(4) && kind == 2) {
                GatedSched S; S.init8(WSP(const unsigned char, WS_U), WSP(const unsigned char, WS_PW1), T_ALL, 1024, 1024, 1024, F.G, bx);
                EpiGlu8 E{WSP(bf16_t, WS_G), 1024, F.in[F.zi + I_CBPW1], WSP(const float, WS_PW1S), 1024};
                g8::gemm_phase(F.lds, S, E, F.wave);
            }
        }
        SEAM(pb + 0);
        if (IN(pb + 1)) for (int rep = 0; rep < NREP(kind == 0 ? 5 : (kind == 1 ? 6 : 7)); ++rep) {
            if (EN(5) && kind == 0) {
                const float li = 0.8f - 0.6f * __expf(-0.3f * (float)layer);
                const int ln_ = hidden_tid(F.wave) & 63; const float d1 = wave_sum(F.in[F.zi + I_LQ1][jj * 64 + ln_] * F.in[F.zi + I_LK1][jj * 64 + ln_]), d2 = wave_sum(F.in[F.zi + I_LQ2][jj * 64 + ln_] * F.in[F.zi + I_LK2][jj * 64 + ln_]);
                att::Params P{WSP(const unsigned char, WS_Q), WSP(const unsigned char, WS_K), WSP(const unsigned char, WS_V), WSP(unsigned char, WS_MIX), WSP(float, WS_ASCR), F.in[F.zi + I_SUBLN] + jj * 128, __expf(d1) - __expf(d2) + li, (1.0f - li) * MIX_PRESCALE, F.wave};
                const int nun = last ? 1024 : 1024 + 64;
#if ATT_PROBE
                for (int un = F.vcu; un < nun; un += F.G) {
                    int b, h, q0, tb;
                    if (un < 1024) { b = un >> 7; h = (un >> 4) & 7; q0 = b * SEQ + (un & 15) * 256; tb = 0; } else { const int q = un - 1024; b = q >> 3; h = q & 7; q0 = T_LAT + b * CTXL; tb = 64; }
                    for (int c = 0; c < 2; ++c) att::unit<8, ATT_PROBE>(P, b, h, c, q0, tb, 68, F.lds);
                }
                __syncthreads();
#endif
                for (int un = F.vcu; un < nun; un += F.G) {
                    int b, h, q0, tb;
                    if (un < 1024) { b = un >> 7; h = (un >> 4) & 7; q0 = b * SEQ + (un & 15) * 256; tb = 0; } else { const int q = un - 1024; b = q >> 3; h = q & 7; q0 = T_LAT + b * CTXL; tb = 64; }
                    for (int c = 0; c < 2; ++c) att::unit<8>(P, b, h, c, q0, tb, 68, F.lds);
                }
            } else if (EN(6) && kind == 1) {
                F2Sched S; S.init(WSP(const unsigned char, WS_DFTN), WSP(const unsigned char, WS_YT), F.G, bx); EpiFp8T<2> E{WSP(unsigned char, WS_MIX), 1024, MIX_PRESCALE / DFT_PRESCALE}; g8::gemm_phase(F.lds, S, E, F.wave);
            } else if (EN(7) && kind == 2) {
                __syncthreads(); phase_dwconv(F);
            }
        }
        SEAM(pb + 1);
        if (EN(8) && IN(pb + 2)) for (int rep = 0; rep < NREP(8); ++rep) {
            const unsigned char* Bt = WSP(const unsigned char, 0) + (kind == 0 ? WS_WO + (size_t)jj * 1024 * 1024 : (kind == 1 ? WS_WF : WS_PW2));
            const float* wsc = WSP(const float, WS_WZS) + (kind == 0 ? jj : kind + 1) * 1024;
            const float* bias = kind == 0 ? (const float*)(F.ws + WS_CTL + 524288) : (kind == 1 ? F.in[F.zi + I_FB] : F.in[F.zi + I_CBPW2]);
            DenseSched S; S.init8(WSP(const unsigned char, WS_MIX), Bt, nrows, 1024, 1024, 1024, F.G, bx);
            EpiBf16T<2> E{WSP(bf16_t, WS_Y), 1024, bias, 0, wsc, 1.0f / MIX_PRESCALE};
            g8::gemm_phase(F.lds, S, E, F.wave);
        }
        SEAM(pb + 2);
        if (EN(9) && IN(pb + 3)) { for (int rep = 0; rep < NREP(9); ++rep) { __syncthreads(); phase_ln1_router(F, layer, nrows, rep == 0); } } SEAM(pb + 3);
        if (EN(10) && IN(pb + 4)) { phase_assign(F, layer, nrows); } SEAM(pb + 4);
        if (EN(11) && IN(pb + 5)) for (int rep = 0; rep < NREP(11); ++rep) {
            volatile LAS int* ts = MK_MULTI ? moe_tables(F, layer) : (volatile LAS int*)(F.lds + MISC_OFF + 256);
            MoeSched<true> S; S.init(WSP(const char, WS_V2), WSP(const char, WS_W1) + (size_t)layer * 32 * 2048 * 1024, WSP(const int, WS_ROWTOK), ts, F.G, bx, F.wave);
            EpiGatedI8 E{WSP(unsigned char, WS_H), F.in[F.zi + I_MB1] + (size_t)layer * 32 * 2048, WSP(const float, WS_W1S) + (size_t)layer * 32 * 2048, WSP(const float, WS_SAP)};
#if MOE_PROBE
            { EpiGatedI8T<(MOE_PROBE >> 4)> EP{E.O, E.bias, E.sw, E.sap};
              g8::gemm_phase<EpiGatedI8T<(MOE_PROBE >> 4)>, MoeSched<true>, (MOE_PROBE & 15)>(F.lds, S, EP, F.wave); __syncthreads(); }
#endif
            g8::gemm_phase(F.lds, S, E, F.wave);
        }
        SEAM(pb + 5);
        if (EN(12) && IN(pb + 6)) for (int rep = 0; rep < NREP(12); ++rep) {
            volatile LAS int* ts = MK_MULTI ? moe_tables(F, layer) : (volatile LAS int*)(F.lds + MISC_OFF + 256);
            MoeSched<false> S; S.init(WSP(const char, WS_H), WSP(const char, WS_W2) + (size_t)layer * 32 * 1024 * 1024, nullptr, ts, F.G, bx, F.wave);
            EpiY2 E{WSP(unsigned char, WS_Y2), F.in[F.zi + I_MB2] + (size_t)layer * 32 * 1024, WSP(const float, WS_W2S) + (size_t)layer * 32 * 1024};
            g8::gemm_phase(F.lds, S, E, F.wave);
        }
        SEAM(pb + 6);
        if (EN(13) && IN(pb + 7)) { for (int rep = 0; rep < NREP(13); ++rep) { __syncthreads(); phase_combine_ln2(F, layer, nrows); } } SEAM(pb + 7);
    }
#undef IN
#undef SEAM
}

extern "C" void kernel_launch(void* const* d_in, const int* in_sizes, int n_in, void* d_out, int out_size, void* d_ws, size_t ws_size, hipStream_t stream) {
    static int grid = 0;
    if (grid == 0) {
        if (n_in != 33 || out_size != T_LAT * D || ws_size < WS_END) { fprintf(stderr, "kernel_launch: unexpected shapes (n_in %d, out %d, ws %zu < %zu); nothing launched\n", n_in, out_size, ws_size, (size_t)WS_END); grid = -1; return; }
        int dev = 0, cus = 0, per_cu = 0;
        if (hipGetDevice(&dev) != hipSuccess || hipDeviceGetAttribute(&cus, hipDeviceAttributeMultiprocessorCount, dev) != hipSuccess) { grid = -1; return; }
        if (hipFuncSetAttribute((const void*)fwd, hipFuncAttributeMaxDynamicSharedMemorySize, LDS_BYTES) != hipSuccess) { fprintf(stderr, "kernel_launch: hipFuncSetAttribute failed\n"); grid = -1; return; }
        if (hipOccupancyMaxActiveBlocksPerMultiprocessor(&per_cu, (const void*)fwd, NTHR, LDS_BYTES) != hipSuccess || per_cu < 1) fprintf(stderr, "kernel_launch: occupancy query says %d blocks per CU\n", per_cu);
        (void)hipGetLastError();
        grid = cus < 256 ? cus : 256;
    }
    if (grid < 0) return;
    if (hipMemsetAsync((char*)d_ws + WS_CTL, 0, CTL_ZERO_BYTES, stream) != hipSuccess) return;
    Args a{};
    for (int i = 0; i < 33; ++i) a.in[i] = (const float*)d_in[i];
    a.out = (float*)d_out; a.ws = (unsigned char*)d_ws;
#if MK_MULTI
    for (int p = 0; p < NPHASE; ++p) { a.ph_lo = p; a.ph_hi = p + 1; hipLaunchKernelGGL(fwd, dim3(grid), dim3(NTHR), LDS_BYTES, stream, a); }
#else
    a.ph_lo = 0; a.ph_hi = NPHASE;
    hipLaunchKernelGGL(fwd, dim3(grid), dim3(NTHR), LDS_BYTES, stream, a);
#endif
    const hipError_t le = hipPeekAtLastError();
    if (le != hipSuccess) fprintf(stderr, "kernel_launch: launch failed: %s\n", hipGetErrorName(le));
}
```

```cpp
#include <hip/hip_runtime.h>
#include <cstdio>
#include <cstdint>

#ifndef MK_MULTI
#define MK_MULTI 0
#endif
#ifndef PH_MASK
#define PH_MASK 0xffffffffu
#endif
#define EN(k) (((PH_MASK) >> (k)) & 1u)
#ifndef REP_MASK
#define REP_MASK 0u
#endif
#ifndef MOE_PROBE
#define MOE_PROBE 0
#endif
#ifndef ATT_GSH
#define ATT_GSH 0
#endif
#ifndef ATT_PROBE
#define ATT_PROBE 0
#endif
#define NREP(k) ((((REP_MASK) >> (k)) & 1u) ? 2 : 1)

#define LAS __attribute__((address_space(3)))
#define GAS __attribute__((address_space(1)))
typedef unsigned short bf16_t;
typedef short bf16x8 __attribute__((ext_vector_type(8)));
typedef short s16x4 __attribute__((ext_vector_type(4)));
typedef float f32x2 __attribute__((ext_vector_type(2)));
typedef float f32x4 __attribute__((ext_vector_type(4)));
typedef float f32x16 __attribute__((ext_vector_type(16)));
typedef unsigned u32x2 __attribute__((ext_vector_type(2)));
typedef unsigned u32x4 __attribute__((ext_vector_type(4)));
typedef int i32x4 __attribute__((ext_vector_type(4)));
typedef int i32x8 __attribute__((ext_vector_type(8)));

constexpr int D = 1024, NB = 8, SEQ = 4096, CTXL = 256, DEPTH = 4;
constexpr int T_LAT = NB * SEQ, T_CTX = NB * CTXL, T_ALL = T_LAT + T_CTX;
constexpr int NE = 32, TOPK = 4, P_MAX = 147456;
constexpr float LN_EPS = 1e-5f;
constexpr float DN_ALPHA = 1.6817928305074290f;
constexpr float ATT_C2 = 0.125f * 1.4426950408889634f;
constexpr int NWAVES = 8, NTHR = 512;
constexpr float H_PRESCALE = 7.5f, FP8_TOP = 440.0f, Q_PRESCALE = 16.0f;
constexpr float MIX_PRESCALE = 1.0f;
constexpr float Y2_PRESCALE = 16.0f;
constexpr float DFT_PRESCALE = 64.0f;
constexpr int VT_PITCH = 4352;

constexpr size_t MiB = 1u << 20;
constexpr size_t WS_CTL = 0, CTL_ZERO_BYTES = 1 * MiB;
constexpr size_t WS_MOD = 1 * MiB;
constexpr size_t WS_ROPE = 2 * MiB;
constexpr size_t WS_ACS = 2 * MiB + 65536;
constexpr size_t WS_DFTN = 4 * MiB;
constexpr size_t WS_WQKV = 72 * MiB;
constexpr size_t WS_WO = 84 * MiB;
constexpr size_t WS_WF = 88 * MiB;
constexpr size_t WS_PW1 = 90 * MiB;
constexpr size_t WS_PW2 = 94 * MiB;
constexpr size_t WS_W1 = 96 * MiB;
constexpr size_t WS_W2 = 608 * MiB;
constexpr size_t WS_X = 864 * MiB;
constexpr size_t WS_X1 = 1000 * MiB;
constexpr size_t WS_U = 1136 * MiB;
constexpr size_t WS_Q = 1204 * MiB, WS_K = 1272 * MiB, WS_V = 1340 * MiB;
constexpr size_t WS_MIX = 1408 * MiB;
constexpr size_t WS_Y = 1476 * MiB;
constexpr size_t WS_V2 = 1544 * MiB;
constexpr size_t WS_G = 1612 * MiB;
constexpr size_t WS_YT = 1680 * MiB;
constexpr size_t WS_YTC = 1808 * MiB;
constexpr size_t WS_H = 1936 * MiB;
constexpr size_t WS_Y2 = 2224 * MiB;
constexpr size_t WS_TOPK = 2512 * MiB;
constexpr size_t WS_GATE = 2513 * MiB;
constexpr size_t WS_POS = 2514 * MiB;
constexpr size_t WS_ROWTOK = 2515 * MiB;
constexpr size_t WS_ASCR = 2516 * MiB;
constexpr size_t WS_W1S = 2548 * MiB;
constexpr size_t WS_V2S = 2549 * MiB;
constexpr size_t WS_W2S = 2550 * MiB;
constexpr size_t WS_WQKVS = 2551 * MiB;
constexpr size_t WS_PW1S = 2551 * MiB + 65536;
constexpr size_t WS_WZS = 2551 * MiB + 131072;
constexpr size_t WS_SAP = 2552 * MiB;
constexpr size_t WS_END = 2553 * MiB;
constexpr int CW_TMO = 0, CW_BAR = 4096, CW_CNT = 16384, CW_CUR = 16384 + 1024;

constexpr int LDS_BYTES = 147456;
constexpr int RING_BYTES = 131072;
constexpr int MISC_OFF = LDS_BYTES - 2048;

#define RLX_AGENT __ATOMIC_RELAXED, __HIP_MEMORY_SCOPE_AGENT
#define LDS_WAIT() asm volatile("s_waitcnt lgkmcnt(0)" ::: "memory")
#define VM_WAIT() asm volatile("s_waitcnt vmcnt(0)" ::: "memory")
__device__ __forceinline__ unsigned cvt_pk_bf16(float lo, float hi) { unsigned r; asm volatile("v_cvt_pk_bf16_f32 %0, %1, %2" : "=v"(r) : "v"(lo), "v"(hi)); return r; }
__device__ __forceinline__ float bf_lo(unsigned w) { return __uint_as_float(w << 16); }
__device__ __forceinline__ float bf_hi(unsigned w) { return __uint_as_float(w & 0xffff0000u); }
template <int M> __device__ __forceinline__ float sx(float v) { return __int_as_float(__builtin_amdgcn_ds_swizzle(__float_as_int(v), 0x1f | (M << 10))); }
template <int CTRL> __device__ __forceinline__ float dppf(float v) { return __int_as_float(__builtin_amdgcn_update_dpp(0, __float_as_int(v), CTRL, 0xF, 0xF, false)); }
template <> __device__ __forceinline__ float sx<1>(float v) { return dppf<0xB1>(v); }
template <> __device__ __forceinline__ float sx<2>(float v) { return dppf<0x4E>(v); }
__device__ __forceinline__ float ar4(float v) { return dppf<0x141>(v); }
__device__ __forceinline__ float ar8(float v) { return dppf<0x140>(v); }
__device__ __forceinline__ float sum32x(float v) { auto rr = __builtin_amdgcn_permlane32_swap(__float_as_uint(v), __float_as_uint(v), false, false); return __uint_as_float(rr[0]) + __uint_as_float(rr[1]); }
__device__ __forceinline__ float wave_max(float v) { v = fmaxf(v, sx<1>(v)); v = fmaxf(v, sx<2>(v)); v = fmaxf(v, ar4(v)); v = fmaxf(v, ar8(v)); v = fmaxf(v, sx<16>(v));
    auto rr = __builtin_amdgcn_permlane32_swap(__float_as_uint(v), __float_as_uint(v), false, false); return fmaxf(__uint_as_float(rr[0]), __uint_as_float(rr[1])); }
__device__ __forceinline__ unsigned pack_i8x4(float a, float b, float c, float d) {
    int hi_ = 127, lo_ = -127; asm volatile("" : "+s"(hi_), "+s"(lo_));
    const int ia = max(lo_, min(hi_, __float2int_rn(a))), ib = max(lo_, min(hi_, __float2int_rn(b))), ic = max(lo_, min(hi_, __float2int_rn(c))), id = max(lo_, min(hi_, __float2int_rn(d)));
    return (unsigned)(ia & 255) | ((unsigned)(ib & 255) << 8) | ((unsigned)(ic & 255) << 16) | ((unsigned)id << 24); }
__device__ __forceinline__ unsigned pack_fp8x4(float a, float b, float c, float d) { int w = 0; w = __builtin_amdgcn_cvt_pk_fp8_f32(a, b, w, false); w = __builtin_amdgcn_cvt_pk_fp8_f32(c, d, w, true); return (unsigned)w; }
__device__ __forceinline__ float wave_sum(float v) { v += sx<1>(v); v += sx<2>(v); v += ar4(v); v += ar8(v); v += sx<16>(v); return sum32x(v); }
__device__ __forceinline__ float ln_eps() { float e = LN_EPS; asm volatile("" : "+s"(e)); return e; }
__device__ __forceinline__ int hidden_tid(int wave) { int l; asm volatile("v_mbcnt_lo_u32_b32 %0, -1, 0\n\tv_mbcnt_hi_u32_b32 %0, -1, %0" : "=v"(l)); return wave * 64 + l; }
__device__ __forceinline__ float fast_sigmoid(float x) { return __builtin_amdgcn_rcpf(1.0f + __builtin_amdgcn_exp2f(-1.4426950408889634f * x)); }

#define XB_TMO      128
#define XB_XCNT(j)  (256  + 64 * (j))
#define XB_XSUB(j)  (1280 + 64 * (j))
#define XB_XGEN(j)  (2304 + 64 * (j))
#define XB_TOP      3328
#define XB_TOPGEN   3392
#define XCD_BAR_WORDS 3456
#define XB_SPIN_CAP (1u << 18)
__device__ __forceinline__ unsigned xb_ld(unsigned* p)              { return __hip_atomic_load(p, __ATOMIC_RELAXED, __HIP_MEMORY_SCOPE_AGENT); }
__device__ __forceinline__ unsigned xb_add(unsigned* p, unsigned v) { return __hip_atomic_fetch_add(p, v, __ATOMIC_RELAXED, __HIP_MEMORY_SCOPE_AGENT); }
__device__ __forceinline__ unsigned xb_xcc_id() { return (unsigned)__builtin_amdgcn_s_getreg((3 << 11) | 20) & 0xFu; }
#define XB_SPIN(cond, bar) do { unsigned _sp = 0; while (cond) { __builtin_amdgcn_s_sleep(1); \
    if ((++_sp & 255u) == 0u) { if (xb_ld(&(bar)[XB_TMO])) break; if (_sp > XB_SPIN_CAP) { atomicAdd(&(bar)[XB_TMO], 1u); break; } } } } while (0)
struct XcdBarrier { unsigned* bar; unsigned x; volatile LAS unsigned* st; };
__device__ __forceinline__ XcdBarrier xcd_barrier_post(unsigned* bar, volatile LAS unsigned* st) {
    XcdBarrier b; b.bar = bar; b.x = xb_xcc_id(); b.st = st;
    if (threadIdx.x == 0) (void)xb_add(&bar[XB_XCNT(b.x)], 1u);
    return b;
}
__device__ __forceinline__ void xcd_barrier_complete(unsigned* bar, unsigned x, unsigned& nloc, unsigned& nx) {
    const unsigned G = gridDim.x * gridDim.y * gridDim.z;
    unsigned sum, cnt, mine, sp = 0u;
    for (;;) {
        sum = 0u; cnt = 0u; mine = 0u;
#pragma unroll
        for (unsigned j = 0; j < 16; ++j) { const unsigned c = xb_ld(&bar[XB_XCNT(j)]); sum += c; cnt += (c > 0u) ? 1u : 0u; mine = (j == x) ? c : mine; }
        if (sum == G) break;
        __builtin_amdgcn_s_sleep(1);
        if ((++sp & 255u) == 0u) { if (xb_ld(&bar[XB_TMO])) break; if (sp > XB_SPIN_CAP) { atomicAdd(&bar[XB_TMO], 1u); break; } }
    }
    nloc = mine > 0u ? mine : 1u; nx = cnt > 0u ? cnt : 1u;
}
__device__ __forceinline__ void xcd_barrier(const XcdBarrier& b, int wave_) {
    asm volatile("s_waitcnt vmcnt(0)" ::: "memory");
    __syncthreads();
    if (hidden_tid(wave_) == 0) {
        unsigned* bar = b.bar;
        __builtin_amdgcn_s_waitcnt(0);
        unsigned nloc = b.st[0], nx = b.st[1];
        if (nloc == 0u) { xcd_barrier_complete(bar, b.x, nloc, nx); b.st[0] = nloc; b.st[1] = nx; }
        const unsigned old = xb_add(&bar[XB_XSUB(b.x)], 1u);
        const unsigned gen = old / nloc;
        if (old + 1u == (gen + 1u) * nloc) {
            __builtin_amdgcn_fence(__ATOMIC_RELEASE, "agent");
            asm volatile("s_waitcnt vmcnt(0)" ::: "memory");
            const unsigned og = xb_add(&bar[XB_TOP], 1u);
            const unsigned tg = og / nx;
            if (og + 1u == (tg + 1u) * nx) xb_add(&bar[XB_TOPGEN], 1u);
            else XB_SPIN(xb_ld(&bar[XB_TOPGEN]) == tg, bar);
            __builtin_amdgcn_fence(__ATOMIC_ACQUIRE, "agent");
            xb_add(&bar[XB_XGEN(b.x)], 1u);
            asm volatile("s_waitcnt vmcnt(0)" ::: "memory");
        } else {
            XB_SPIN(xb_ld(&bar[XB_XGEN(b.x)]) == gen, bar);
            __builtin_amdgcn_fence(__ATOMIC_ACQUIRE, "agent");
            asm volatile("s_waitcnt vmcnt(0)" ::: "memory");
        }
    }
    __syncthreads();
}

namespace g8 {
constexpr int BM = 256, BK = 64, HALF = 128, HTB = HALF * BK * 2, NXCD = 8, WGM = 8, PF_OFF = 8 * HTB, PF_BLK = 3072;
__host__ __device__ __forceinline__ int lds_byte(int r, int c) { const int st = (r >> 4) * 2 + (c >> 5), rr = r & 15, cc = c & 31, ob = rr * 64 + cc * 2; return st * 1024 + (ob ^ (((ob >> 9) & 1) << 5)); }
__host__ __device__ __forceinline__ void stage_rc(int b, int& R, int& C) { const int st = b / 1024, sb = b % 1024, swz = sb ^ (((sb >> 9) & 1) << 5); R = (st >> 1) * 16 + swz / 64; C = (st & 1) * 32 + (swz % 64) / 2; }
__host__ __device__ __forceinline__ int perm32(int rho) { const int n = rho >> 4, i = rho & 15; return 8 * (i >> 2) + 4 * n + (i & 3); }

struct GU { unsigned a, b, ooff; int row0, col0, aux; };

struct DenseOrder {
    int nM, nN, nwg, G, c;
    __device__ __forceinline__ void init(int M, int N, int G_, int c_) { nM = M / BM; nN = N / BM; nwg = nM * nN; G = G_; c = c_; }
    __device__ __forceinline__ bool tile(int i, int& pm, int& pn) const {
        const long L = (long)i * G + c; if (L >= nwg) return false;
        int wgid = (int)L; { const int q = nwg / NXCD, r = nwg % NXCD, xcd = wgid % NXCD, off = wgid / NXCD; wgid = (xcd < r ? xcd * (q + 1) : r * (q + 1) + (xcd - r) * q) + off; }
        const int nig = WGM * nN, gid = wgid / nig, fm = gid * WGM, gsz = (nM - fm) < WGM ? (nM - fm) : WGM;
        pm = fm + ((wgid % nig) % gsz); pn = (wgid % nig) / gsz; return true;
    }
};

template <int MODE> struct Mma;
template <> struct Mma<0> { typedef f32x4 acc_t; static __device__ __forceinline__ f32x4 run(const bf16x8 (&a)[2], const bf16x8 (&b)[2], f32x4 c, int) {
    c = __builtin_amdgcn_mfma_f32_16x16x32_bf16(a[0], b[0], c, 0, 0, 0); return __builtin_amdgcn_mfma_f32_16x16x32_bf16(a[1], b[1], c, 0, 0, 0); } };
template <> struct Mma<1> { typedef i32x4 acc_t; static __device__ __forceinline__ i32x4 run(const bf16x8 (&a)[2], const bf16x8 (&b)[2], i32x4 c, int) {
    c = __builtin_amdgcn_mfma_i32_16x16x64_i8(__builtin_bit_cast(i32x4, a[0]), __builtin_bit_cast(i32x4, b[0]), c, 0, 0, 0); return __builtin_amdgcn_mfma_i32_16x16x64_i8(__builtin_bit_cast(i32x4, a[1]), __builtin_bit_cast(i32x4, b[1]), c, 0, 0, 0); } };
template <> struct Mma<2> { typedef f32x4 acc_t; static __device__ __forceinline__ f32x4 run(const bf16x8 (&a)[2], const bf16x8 (&b)[2], f32x4 c, int sc1) {
    const i32x4 a0 = __builtin_bit_cast(i32x4, a[0]), a1 = __builtin_bit_cast(i32x4, a[1]), b0 = __builtin_bit_cast(i32x4, b[0]), b1 = __builtin_bit_cast(i32x4, b[1]);
    const i32x8 av = (i32x8){a0[0], a0[1], a0[2], a0[3], a1[0], a1[1], a1[2], a1[3]}, bv = (i32x8){b0[0], b0[1], b0[2], b0[3], b1[0], b1[1], b1[2], b1[3]};
    return __builtin_amdgcn_mfma_scale_f32_16x16x128_f8f6f4(av, bv, c, 0, 0, 0, sc1, 0, sc1); } };
template <class Epi, class Sched, int PROBE = 0>
__device__ __forceinline__ void gemm_phase(LAS unsigned char* lds, const Sched& S, const Epi& E, int wave_) {
    typedef typename Mma<Epi::MODE>::acc_t acc_t;
    int mxs = 0x7f7f7f7f; asm volatile("" : "+v"(mxs));
    constexpr bool GATHER = Sched::GATHER;
    const int tid = hidden_tid(wave_), wid = wave_, lane = tid & 63, wr = wid >> 2, wc = wid & 3, fr = lane & 15, fq = lane >> 4;
    unsigned voffA[2], voffB[2]; int RA[2];
#pragma unroll
    for (int i = 0; i < 2; ++i) { int R, C; stage_rc(tid * 16 + i * 8192, R, C); const int Rb = Epi::PERM ? ((R & ~31) + perm32(R & 31)) : R;
        voffA[i] = (GATHER ? 0u : (unsigned)R * S.lda) + (unsigned)C * 2u; voffB[i] = (unsigned)Rb * S.ldb + (unsigned)C * 2u; RA[i] = R; }
    constexpr unsigned kstep = (unsigned)(BK * 2);
    const unsigned hsA = GATHER ? 0u : S.hstepA, hsB = S.hstepB;
    const unsigned ldsw = (unsigned)wid * 1024u;
    const unsigned ldsb = (unsigned)(unsigned long)lds + ldsw;
    const int aoff = lds_byte(wr * 64 + fr, fq * 8), boff = lds_byte(wc * 32 + fr, fq * 8);
    const char* const Ab = S.A; const char* const Bb = S.Bt;
#define G8_SA(b, h) (((b) * 2 + (h)) * HTB)
#define G8_SB(b, h) ((4 + (b) * 2 + (h)) * HTB)
#define G8_STAGE(bufoff, gbase, soff, voff) do { const char* gp_ = (gbase) + (size_t)(soff); _Pragma("unroll") for (int _i = 0; _i < 2; ++_i) { unsigned keep_ = 0; \
        asm volatile("s_mov_b32 m0, %2\n\ts_nop 4\n\tglobal_load_lds_dwordx4 %0, %1" :: "v"((voff)[_i]), "s"(gp_), "s"(ldsb + (unsigned)((bufoff) + _i * 8192)) : "memory"); (void)keep_; } } while (0)
#define G8_LDA(dst, b, h) do { _Pragma("unroll") for (int m = 0; m < 4; ++m) _Pragma("unroll") for (int k = 0; k < 2; ++k) dst[m][k] = *(const LAS bf16x8*)(lds + G8_SA(b, h) + aoff + m * 2048 + k * 1024); } while (0)
#define G8_LDB(dst, b, h) do { _Pragma("unroll") for (int n = 0; n < 2; ++n) _Pragma("unroll") for (int k = 0; k < 2; ++k) dst[n][k] = *(const LAS bf16x8*)(lds + G8_SB(b, h) + boff + n * 2048 + k * 1024); } while (0)
#define G8_MMA(ai, bj, At, Bt) do { __builtin_amdgcn_s_setprio(1); _Pragma("unroll") for (int m = 0; m < 4; ++m) _Pragma("unroll") for (int n = 0; n < 2; ++n) { \
        if (PROBE & 2) { asm volatile("" :: "v"(Bt[n][0]), "v"(Bt[n][1]), "v"(At[m][0]), "v"(At[m][1])); } else acc[ai][bj][m][n] = Mma<Epi::MODE>::run(Bt[n], At[m], acc[ai][bj][m][n], mxs); } __builtin_amdgcn_s_setprio(0); } while (0)
#define G8_WAIT_V(n) asm volatile("s_waitcnt vmcnt(" #n ")" ::: "memory")
#define G8_WAIT_L(n) asm volatile("s_waitcnt lgkmcnt(" #n ")" ::: "memory")
#define G8_BAR __builtin_amdgcn_s_barrier()
#define G8_SCHED __builtin_amdgcn_sched_barrier(0)
    GU cur, nxt; int ui = 0;
    if (!S.next(0, cur)) return;
    bf16x8 At[4][2], B0[2][2], B1[2][2];
    unsigned cA = cur.a, cB = cur.b;
    unsigned c0[2], c1[2], n0[2], n1[2];
    if constexpr (GATHER) {
#pragma unroll
        for (int i = 0; i < 2; ++i) { const int r0 = S.rowtok[cur.row0 + RA[i]], r1 = S.rowtok[cur.row0 + HALF + RA[i]];
            c0[i] = (unsigned)r0 * S.lda + voffA[i]; c1[i] = (unsigned)r1 * S.lda + voffA[i]; n0[i] = c0[i]; n1[i] = c1[i]; }
    } else {
#pragma unroll
        for (int i = 0; i < 2; ++i) { c0[i] = voffA[i]; c1[i] = voffA[i]; n0[i] = voffA[i]; n1[i] = voffA[i]; }
    }
    G8_STAGE(G8_SB(0, 0), Bb, cB, voffB); G8_STAGE(G8_SB(0, 1), Bb, cB + hsB, voffB); G8_STAGE(G8_SA(0, 0), Ab, cA, c0); G8_STAGE(G8_SA(0, 1), Ab, cA + hsA, c1);
    if (wr == 1) G8_BAR;
    G8_WAIT_V(2); G8_BAR;
    G8_STAGE(G8_SB(1, 0), Bb, cB + kstep, voffB); G8_STAGE(G8_SA(1, 0), Ab, cA + kstep, c0); G8_STAGE(G8_SB(1, 1), Bb, cB + hsB + kstep, voffB);
    G8_WAIT_V(6); G8_BAR;
    acc_t acc[2][2][4][2];
#pragma unroll
    for (int a = 0; a < 2; ++a)
#pragma unroll
        for (int b = 0; b < 2; ++b)
#pragma unroll
            for (int m = 0; m < 4; ++m)
#pragma unroll
                for (int n = 0; n < 2; ++n) {
                    if constexpr (Epi::MODE == 0) acc[a][b][m][n] = (acc_t){0, 0, 0, 0};
                    else {
#pragma unroll
                        for (int j = 0; j < 4; ++j) { decltype(acc[a][b][m][n][j] + acc[a][b][m][n][j]) zv; asm volatile("v_mov_b32 %0, 0" : "=v"(zv)); acc[a][b][m][n][j] = zv; } } }
    for (;;) {
        const bool has_next = S.next(ui + 1, nxt);
        const unsigned nA = has_next ? nxt.a : cA, nB = has_next ? nxt.b : cB;
        const int nt = Sched::VAR_NT ? cur.aux : S.nt;
        if constexpr (Epi::PF) E.prefetch(cur, wave_, (unsigned)(unsigned long)lds + (unsigned)(PF_OFF + (ui & 1) * PF_BLK));
        for (int t = 0; t < nt; t += 2) {
            const bool last = (t == nt - 2);
            const unsigned a1 = cA + (unsigned)(t + 1) * kstep;
            const unsigned a2 = last ? nA : cA + (unsigned)(t + 2) * kstep, b2 = last ? nB : cB + (unsigned)(t + 2) * kstep;
            const unsigned a3 = a2 + kstep, b3 = b2 + kstep;
            unsigned s0[2], s1[2];
            if constexpr (GATHER) {
                if (last && has_next) {
#pragma unroll
                    for (int i = 0; i < 2; ++i) { const int r0 = S.rowtok[nxt.row0 + RA[i]], r1 = S.rowtok[nxt.row0 + HALF + RA[i]];
                        n0[i] = (unsigned)r0 * S.lda + voffA[i]; n1[i] = (unsigned)r1 * S.lda + voffA[i]; }
                }
#pragma unroll
                for (int i = 0; i < 2; ++i) { s0[i] = last ? n0[i] : c0[i]; s1[i] = last ? n1[i] : c1[i]; }
            } else {
#pragma unroll
                for (int i = 0; i < 2; ++i) { s0[i] = voffA[i]; s1[i] = voffA[i]; }
            }
            G8_LDB(B0, 0, 0); G8_LDB(B1, 0, 1); G8_SCHED; G8_LDA(At, 0, 0);
            G8_STAGE(G8_SA(1, 1), Ab, a1 + hsA, c1);
            G8_WAIT_V(8); G8_WAIT_L(0); G8_BAR; G8_MMA(0, 0, At, B0); G8_MMA(0, 1, At, B1); G8_BAR; G8_SCHED;
            G8_LDA(At, 0, 1); G8_STAGE(G8_SB(0, 0), Bb, b2, voffB); G8_STAGE(G8_SB(0, 1), Bb, b2 + hsB, voffB); G8_STAGE(G8_SA(0, 0), Ab, a2, s0);
            G8_WAIT_V(8); G8_WAIT_L(0); G8_BAR; G8_MMA(1, 0, At, B0); G8_MMA(1, 1, At, B1); G8_BAR; G8_SCHED;
            G8_LDB(B0, 1, 0); G8_LDB(B1, 1, 1); G8_SCHED; G8_LDA(At, 1, 0); G8_STAGE(G8_SA(0, 1), Ab, a2 + hsA, s1);
            G8_WAIT_V(8); G8_WAIT_L(0); G8_BAR; G8_MMA(0, 0, At, B0); G8_MMA(0, 1, At, B1); G8_BAR; G8_SCHED;
            G8_LDA(At, 1, 1); G8_STAGE(G8_SB(1, 0), Bb, b3, voffB); G8_STAGE(G8_SB(1, 1), Bb, b3 + hsB, voffB); G8_STAGE(G8_SA(1, 0), Ab, a3, s0);
            G8_WAIT_V(8); G8_WAIT_L(0); G8_BAR; G8_MMA(1, 0, At, B0); G8_MMA(1, 1, At, B1); G8_BAR; G8_SCHED;
        }
        if (wr == 0) G8_BAR;
        if (!(PROBE & 1)) E(acc, cur, wave_, lds + (Epi::PF ? (ui & 1) * PF_BLK : 0));
        if (!has_next) break;
#pragma unroll
        for (int a = 0; a < 2; ++a)
#pragma unroll
            for (int b = 0; b < 2; ++b)
#pragma unroll
                for (int m = 0; m < 4; ++m)
#pragma unroll
                    for (int n = 0; n < 2; ++n) {
                        if constexpr (Epi::MODE == 0) acc[a][b][m][n] = (acc_t){0, 0, 0, 0};
                        else {
#pragma unroll
                            for (int j = 0; j < 4; ++j) { decltype(acc[a][b][m][n][j] + acc[a][b][m][n][j]) zv; asm volatile("v_mov_b32 %0, 0" : "=v"(zv)); acc[a][b][m][n][j] = zv; } } }
        cur = nxt; cA = nA; cB = nB; ++ui;
        if constexpr (GATHER) {
#pragma unroll
            for (int i = 0; i < 2; ++i) { c0[i] = n0[i]; c1[i] = n1[i]; }
        }
        if (wr == 1) G8_BAR;
    }
    G8_WAIT_V(0);
    G8_BAR;
#undef G8_SA
#undef G8_SB
#undef G8_STAGE
#undef G8_LDA
#undef G8_LDB
#undef G8_MMA
#undef G8_WAIT_V
#undef G8_WAIT_L
#undef G8_BAR
#undef G8_SCHED
}
}

using g8::GU;
#define EPI_LANE_IDS() const int tz_ = hidden_tid(wave_); const int wid_ = wave_, lane_ = tz_ & 63, wr = wid_ >> 2, wc = wid_ & 3, fr = lane_ & 15, fq = lane_ >> 4
template <int MODE_ = 0> struct EpiBf16T {          static constexpr int MODE = MODE_; static constexpr bool PF = false;
    static constexpr bool PERM = true;
    bf16_t* O; int ldc; const float* bias; int bstride; const float* scale; float smul;
    __device__ __forceinline__ void operator()(const f32x4 (&acc)[2][2][4][2], const GU& u, int wave_, LAS unsigned char* lds_) const {
        EPI_LANE_IDS();
        const int cl = wc * 32 + 8 * fq;
        bf16_t* Ob = O + u.ooff;
#pragma unroll
        for (int bj = 0; bj < 2; ++bj) {
            f32x4 bv[2], sv[2];
#pragma unroll
            for (int n = 0; n < 2; ++n) { bv[n] = bias ? *(const f32x4*)(bias + (size_t)u.aux * bstride + u.col0 + cl + bj * 128 + 4 * n) : (f32x4){0.f, 0.f, 0.f, 0.f};
                sv[n] = scale ? *(const f32x4*)(scale + (size_t)u.aux * bstride + u.col0 + cl + bj * 128 + 4 * n) * smul : (f32x4){smul, smul, smul, smul}; }
#pragma unroll
            for (int ai = 0; ai < 2; ++ai)
#pragma unroll
                for (int m = 0; m < 4; ++m) { bf16_t* rowp = Ob + (unsigned)((ai * 128 + wr * 64 + m * 16 + fr) * ldc + cl) + bj * 128;
                    const f32x4 v0 = acc[ai][bj][m][0] * sv[0] + bv[0], v1 = acc[ai][bj][m][1] * sv[1] + bv[1];
                    u32x4 w; w.x = cvt_pk_bf16(v0[0], v0[1]); w.y = cvt_pk_bf16(v0[2], v0[3]); w.z = cvt_pk_bf16(v1[0], v1[1]); w.w = cvt_pk_bf16(v1[2], v1[3]);
                    *(u32x4*)rowp = w; }
        }
    }
};
typedef EpiBf16T<0> EpiBf16;
struct EpiGlu8 { static constexpr bool PF = false;
    static constexpr bool PERM = true; static constexpr int MODE = 2;
    bf16_t* O; int ldc; const float* bias; const float* sw; int half;
    __device__ __forceinline__ void operator()(const f32x4 (&acc)[2][2][4][2], const GU& u, int wave_, LAS unsigned char* lds_) const {
        EPI_LANE_IDS();
        const int cl = wc * 32 + 8 * fq;
        f32x4 bv[2][2], sv[2][2];
#pragma unroll
        for (int bj = 0; bj < 2; ++bj)
#pragma unroll
            for (int n = 0; n < 2; ++n) { bv[bj][n] = *(const f32x4*)(bias + u.col0 + cl + bj * half + 4 * n); sv[bj][n] = *(const f32x4*)(sw + u.col0 + cl + bj * half + 4 * n); }
        bf16_t* Ob = O + u.ooff;
#pragma unroll
        for (int ai = 0; ai < 2; ++ai)
#pragma unroll
            for (int m = 0; m < 4; ++m) { bf16_t* rowp = Ob + (unsigned)((ai * 128 + wr * 64 + m * 16 + fr) * ldc + cl);
                float o[8];
#pragma unroll
                for (int n = 0; n < 2; ++n) { const f32x4 a = acc[ai][0][m][n] * sv[0][n] + bv[0][n], g = acc[ai][1][m][n] * sv[1][n] + bv[1][n];
#pragma unroll
                    for (int j = 0; j < 4; ++j) o[4 * n + j] = a[j] * fast_sigmoid(g[j]); }
                u32x4 w; w.x = cvt_pk_bf16(o[0], o[1]); w.y = cvt_pk_bf16(o[2], o[3]); w.z = cvt_pk_bf16(o[4], o[5]); w.w = cvt_pk_bf16(o[6], o[7]);
                *(u32x4*)rowp = w; }
    }
};
#define EPI_DMA16(gptr, ldsaddr) asm volatile("s_mov_b32 m0, %1\n\ts_nop 4\n\tglobal_load_lds_dwordx4 %0, off" :: "v"(gptr), "s"(ldsaddr) : "memory")
struct EpiY2 { static constexpr bool PF = true;
    static constexpr bool PERM = true; static constexpr int MODE = 2;
    unsigned char* O; const float* bias; const float* scale;
    __device__ __forceinline__ void prefetch(const GU& u, int wave_, unsigned ldsaddr) const {
        const int l_ = hidden_tid(wave_) & 63;
        if (wave_ == 0) { const float* p = bias + (size_t)u.aux * 1024 + u.col0 + 4 * l_; EPI_DMA16(p, ldsaddr); }
        else if (wave_ == 1) { const float* p = scale + (size_t)u.aux * 1024 + u.col0 + 4 * l_; EPI_DMA16(p, ldsaddr + 1024u); }
    }
    __device__ __forceinline__ void operator()(const f32x4 (&acc)[2][2][4][2], const GU& u, int wave_, LAS unsigned char* lds_) const {
        EPI_LANE_IDS();
        const int cl = wc * 32 + 8 * fq;
        unsigned char* Ob = O + u.ooff; const LAS float* pf = (const LAS float*)(lds_ + g8::PF_OFF);
#pragma unroll
        for (int bj = 0; bj < 2; ++bj) {
            f32x4 bv[2], sv[2];
#pragma unroll
            for (int n = 0; n < 2; ++n) { bv[n] = *(const LAS f32x4*)(pf + cl + bj * 128 + 4 * n) * Y2_PRESCALE;
                sv[n] = *(const LAS f32x4*)(pf + 256 + cl + bj * 128 + 4 * n) * (Y2_PRESCALE / H_PRESCALE); }
#pragma unroll
            for (int ai = 0; ai < 2; ++ai)
#pragma unroll
                for (int m = 0; m < 4; m += 2) {
                    const f32x4 a0 = acc[ai][bj][m][0] * sv[0] + bv[0], a1 = acc[ai][bj][m][1] * sv[1] + bv[1], b0 = acc[ai][bj][m + 1][0] * sv[0] + bv[0], b1 = acc[ai][bj][m + 1][1] * sv[1] + bv[1];
                    const unsigned pa0 = pack_fp8x4(a0[0], a0[1], a0[2], a0[3]), pa1 = pack_fp8x4(a1[0], a1[1], a1[2], a1[3]), pb0 = pack_fp8x4(b0[0], b0[1], b0[2], b0[3]), pb1 = pack_fp8x4(b1[0], b1[1], b1[2], b1[3]);
                    const bool odd = (fq & 1) != 0;
                    const unsigned k0 = odd ? pb0 : pa0, k1 = odd ? pb1 : pa1, s0 = odd ? pa0 : pb0, s1 = odd ? pa1 : pb1;
                    const unsigned r0 = __float_as_uint(sx<16>(__uint_as_float(s0))), r1 = __float_as_uint(sx<16>(__uint_as_float(s1)));
                    const u32x4 w = odd ? (u32x4){r0, r1, k0, k1} : (u32x4){k0, k1, r0, r1};
                    unsigned char* rowp = Ob + (unsigned)((ai * 128 + wr * 64 + (m + (odd ? 1 : 0)) * 16 + fr) * 1024 + (cl - (odd ? 8 : 0))) + bj * 128;
                    *(u32x4*)rowp = w; }
        }
    }
};
template <int MODE_ = 0> struct EpiFp8T { static constexpr bool PF = false;
    static constexpr bool PERM = true; static constexpr int MODE = MODE_;
    unsigned char* O; int ldc; float smul;
    __device__ __forceinline__ void operator()(const f32x4 (&acc)[2][2][4][2], const GU& u, int wave_, LAS unsigned char* lds_) const {
        EPI_LANE_IDS();
        const int cl = wc * 32 + 8 * fq;
        unsigned char* Ob = O + u.ooff;
#pragma unroll
        for (int ai = 0; ai < 2; ++ai)
#pragma unroll
            for (int m = 0; m < 4; ++m) { unsigned char* rowp = Ob + (unsigned)((ai * 128 + wr * 64 + m * 16 + fr) * ldc + cl);
#pragma unroll
                for (int bj = 0; bj < 2; ++bj) { const f32x4 v0 = acc[ai][bj][m][0] * smul, v1 = acc[ai][bj][m][1] * smul;
                    *(u32x2*)(rowp + bj * 128) = (u32x2){pack_fp8x4(v0[0], v0[1], v0[2], v0[3]), pack_fp8x4(v1[0], v1[1], v1[2], v1[3])}; } }
    }
};
template <int PV = 0> struct EpiGatedI8T { static constexpr bool PF = true;
    static constexpr bool PERM = true; static constexpr int MODE = 1;
    unsigned char* O; const float* bias; const float* sw; const float* sap;
    __device__ __forceinline__ void prefetch(const GU& u, int wave_, unsigned ldsaddr) const {
        const int l_ = hidden_tid(wave_) & 63;
        if (wave_ == 0) { const float* p = bias + (size_t)u.aux * 2048 + u.col0 + (l_ >> 5) * 1024 + 4 * (l_ & 31); EPI_DMA16(p, ldsaddr); }
        else if (wave_ == 1) { const float* p = sw + (size_t)u.aux * 2048 + u.col0 + (l_ >> 5) * 1024 + 4 * (l_ & 31); EPI_DMA16(p, ldsaddr + 1024u); }
        else if (wave_ == 2) { const float* p = sap + u.row0 + 4 * l_; EPI_DMA16(p, ldsaddr + 2048u); }
    }
    __device__ __forceinline__ void operator()(const i32x4 (&acc)[2][2][4][2], const GU& u, int wave_, LAS unsigned char* lds_) const {
        EPI_LANE_IDS();
        const int cl = wc * 32 + 8 * fq; const LAS float* pf = (const LAS float*)(lds_ + g8::PF_OFF);
        f32x4 bv[2][2], sv[2][2]; float sr[2][4];
#pragma unroll
        for (int bj = 0; bj < 2; ++bj)
#pragma unroll
            for (int n = 0; n < 2; ++n) { if (PV & 1) { bv[bj][n] = (f32x4){0.f, 0.f, 0.f, 0.f}; sv[bj][n] = (f32x4){1.f, 1.f, 1.f, 1.f}; } else { bv[bj][n] = *(const LAS f32x4*)(pf + bj * 128 + cl + 4 * n); sv[bj][n] = *(const LAS f32x4*)(pf + 256 + bj * 128 + cl + 4 * n); } }
#pragma unroll
        for (int ai = 0; ai < 2; ++ai)
#pragma unroll
            for (int m = 0; m < 4; ++m) sr[ai][m] = (PV & 1) ? 1.0f : pf[512 + ai * 128 + wr * 64 + m * 16 + fr];
        unsigned char* Ob = O + u.ooff;
        float C_SIG = -1.702f * 1.4426950408889634f, K2 = H_PRESCALE / (-1.702f * 1.4426950408889634f), c7s = 7.0f * (-1.702f * 1.4426950408889634f), glo = -6.0f * (H_PRESCALE / (-1.702f * 1.4426950408889634f)), ghi = 8.0f * (H_PRESCALE / (-1.702f * 1.4426950408889634f));
        asm volatile("" : "+s"(C_SIG), "+s"(K2), "+s"(c7s), "+s"(glo), "+s"(ghi));
        if (!(PV & 1)) {
#pragma unroll
            for (int n = 0; n < 2; ++n) { sv[0][n] = sv[0][n] * C_SIG; bv[0][n] = bv[0][n] * C_SIG; sv[1][n] = sv[1][n] * K2; bv[1][n] = bv[1][n] * K2 + K2; } }
#pragma unroll
        for (int ai = 0; ai < 2; ++ai)
#pragma unroll
            for (int m = 0; m < 4; ++m) { const int rl = ai * 128 + wr * 64 + m * 16 + fr; const float srow = sr[ai][m];
                unsigned char* rowp = Ob + (unsigned)(rl * 1024 + cl);
                float o[8];
#pragma unroll
                for (int n = 0; n < 2; ++n) {
#pragma unroll
                    for (int j = 0; j < 4; ++j) { const float a = ((float)acc[ai][0][m][n][j] * sv[0][n][j]) * srow + bv[0][n][j], g = ((float)acc[ai][1][m][n][j] * sv[1][n][j]) * srow + bv[1][n][j];
                        if (PV & 4) { o[4 * n + j] = a + g; } else {
                        const float gl = fmaxf(a, c7s), li = __builtin_amdgcn_fmed3f(g, glo, ghi);
                        const float sg = __builtin_amdgcn_rcpf(1.0f + __builtin_amdgcn_exp2f(gl));
                        o[4 * n + j] = (gl * sg) * li; } } }
                int w0 = 0, w1 = 0; w0 = __builtin_amdgcn_cvt_pk_fp8_f32(o[0], o[1], w0, false); w0 = __builtin_amdgcn_cvt_pk_fp8_f32(o[2], o[3], w0, true);
                w1 = __builtin_amdgcn_cvt_pk_fp8_f32(o[4], o[5], w1, false); w1 = __builtin_amdgcn_cvt_pk_fp8_f32(o[6], o[7], w1, true);
                if (PV & 2) { asm volatile("" :: "v"(w0), "v"(w1)); } else *(u32x2*)rowp = (u32x2){(unsigned)w0, (unsigned)w1}; }
    }
};
typedef EpiGatedI8T<0> EpiGatedI8;
struct EpiQK8 { static constexpr bool PF = false;
    static constexpr bool PERM = false; static constexpr int MODE = 2;
    unsigned char* Q; const float* rope; const float* sw;
    __device__ __forceinline__ void operator()(const f32x4 (&acc)[2][2][4][2], const GU& u, int wave_, LAS unsigned char* lds_) const {
        EPI_LANE_IDS();
        const int which = u.col0 >> 10, colw = u.col0 & 1023;
        unsigned char* base = Q + (size_t)which * (WS_K - WS_Q);
        const bool dorope = u.row0 < T_LAT;
        const float sc = which == 0 ? ATT_C2 * Q_PRESCALE : 1.0f;
#pragma unroll
        for (int bj = 0; bj < 2; ++bj) {
            const f32x4 s1 = *(const f32x4*)(sw + u.col0 + bj * 128 + wc * 32 + 4 * fq) * sc, s2 = *(const f32x4*)(sw + u.col0 + bj * 128 + wc * 32 + 16 + 4 * fq) * sc;
#pragma unroll
            for (int ai = 0; ai < 2; ++ai)
#pragma unroll
                for (int m = 0; m < 4; ++m) { const int row = u.row0 + ai * 128 + wr * 64 + m * 16 + fr;
                    float one_ = 1.0f; asm volatile("" : "+s"(one_));
                    f32x4 cs0 = (f32x4){one_, 0.f, one_, 0.f}, cs1 = cs0;
                    if (dorope) { const int t = row & (SEQ - 1); const int pos = (wc & 1) ? (t & 63) : (t >> 6); const float* rp = rope + (pos * 16 + 4 * fq) * 2; cs0 = *(const f32x4*)rp; cs1 = *(const f32x4*)(rp + 4); }
                    const float cj[4] = {cs0[0], cs0[2], cs1[0], cs1[2]}, sj[4] = {cs0[1], cs0[3], cs1[1], cs1[3]};
                    const f32x4 x1 = acc[ai][bj][m][0] * s1, x2 = acc[ai][bj][m][1] * s2; float o1[4], o2[4];
#pragma unroll
                    for (int j = 0; j < 4; ++j) { o1[j] = x1[j] * cj[j] - x2[j] * sj[j]; o2[j] = x2[j] * cj[j] + x1[j] * sj[j]; }
                    unsigned char* rowp = base + (size_t)row * D + colw + bj * 128 + wc * 32 + 4 * fq;
                    *(unsigned*)rowp = pack_fp8x4(o1[0], o1[1], o1[2], o1[3]); *(unsigned*)(rowp + 16) = pack_fp8x4(o2[0], o2[1], o2[2], o2[3]);
                    if (m & 1) __builtin_amdgcn_sched_barrier(0); }
        }
    }
};
struct EpiVt8 { static constexpr bool PF = false;
    static constexpr bool PERM = true; static constexpr int MODE = 2;
    unsigned char* Vt; const float* sw;
    __device__ __forceinline__ void operator()(const f32x4 (&acc)[2][2][4][2], const GU& u, int wave_, LAS unsigned char* lds_) const {
        EPI_LANE_IDS();
        unsigned char* Ob = Vt + u.ooff; const float* swp = sw + u.row0;
        const int k0 = wc * 32 + 8 * fq, kk = k0 & 63;
        const unsigned pcol = (unsigned)((k0 & ~63) + 16 * (kk >> 5) + 4 * ((kk >> 3) & 3));
#pragma unroll
        for (int ai = 0; ai < 2; ++ai)
#pragma unroll
            for (int m = 0; m < 4; ++m) { const int r = ai * 128 + wr * 64 + m * 16 + fr; const float sr = swp[r];
                const unsigned ro = (unsigned)r * (unsigned)VT_PITCH + pcol;
#pragma unroll
                for (int bj = 0; bj < 2; ++bj) { const f32x4 v0 = acc[ai][bj][m][0] * sr, v1 = acc[ai][bj][m][1] * sr;
                    *(unsigned*)(Ob + ro + bj * 128) = pack_fp8x4(v0[0], v0[1], v0[2], v0[3]); *(unsigned*)(Ob + ro + bj * 128 + 32) = pack_fp8x4(v1[0], v1[1], v1[2], v1[3]); }
                __builtin_amdgcn_sched_barrier(0); }
    }
};

struct DenseSched {
    static constexpr bool GATHER = false, VAR_NT = false;
    const char* A; const char* Bt; unsigned lda, ldb, hstepA, hstepB; int nt, ldc; const int* rowtok; g8::DenseOrder ord;
    __device__ __forceinline__ void init(const void* A_, const void* Bt_, int M, int N, int K, int ldc_, int G, int c) {
        A = (const char*)A_; Bt = (const char*)Bt_; lda = (unsigned)K * 2u; ldb = lda; hstepA = 128u * lda; hstepB = hstepA; nt = K / 64; ldc = ldc_; rowtok = nullptr; ord.init(M, N, G, c); }
    __device__ __forceinline__ void init8(const void* A_, const void* Bt_, int M, int N, int Kbytes, int ldc_, int G, int c) {
        A = (const char*)A_; Bt = (const char*)Bt_; lda = (unsigned)Kbytes; ldb = lda; hstepA = 128u * lda; hstepB = hstepA; nt = Kbytes / 128; ldc = ldc_; rowtok = nullptr; ord.init(M, N, G, c); }
    __device__ __forceinline__ bool next(int i, GU& u) const { int pm, pn; if (!ord.tile(i, pm, pn)) return false;
        u.a = (unsigned)pm * 2u * hstepA; u.b = (unsigned)pn * 2u * hstepB; u.row0 = pm * 256; u.col0 = pn * 256; u.ooff = (unsigned)(pm * 256) * (unsigned)ldc + (unsigned)(pn * 256); u.aux = 0; return true; }
};
__device__ __forceinline__ bool xcd_local(int i, int G, int c, int total, int& Li) {
    if ((G & 7) == 0 && (total & 7) == 0) { const int per = total >> 3, off = i * (G >> 3) + (c >> 3); if (off >= per) return false; Li = (c & 7) * per + off; return true; }
    const long L = (long)i * G + c; if (L >= total) return false; Li = (int)L; return true;
}
struct VtSched {
    static constexpr bool GATHER = false, VAR_NT = false;
    const char* A; const char* Bt; unsigned lda, ldb, hstepA, hstepB; int nt, ldc; const int* rowtok; int G, c;
    __device__ __forceinline__ void init(const void* Wv, const void* U, int G_, int c_) { A = (const char*)Wv; Bt = (const char*)U; lda = 1024u; ldb = 1024u; hstepA = 128u * 1024u; hstepB = hstepA; nt = 8; ldc = VT_PITCH; rowtok = nullptr; G = G_; c = c_; }
    __device__ __forceinline__ bool next(int i, GU& u) const {
        const long L = (long)i * G + c; if (L >= 4 * 136) return false; const int Li = (int)L, pm = Li & 3, pn = Li >> 2;
        const int b = pn < 128 ? (pn >> 4) : pn - 128, n0 = pn < 128 ? (pn & 15) * 256 : SEQ;
        u.a = (unsigned)pm * 256u * 1024u; u.b = (unsigned)pn * 256u * 1024u; u.row0 = pm * 256; u.col0 = 0; u.aux = 0;
        u.ooff = (unsigned)(b * 1024 + pm * 256) * (unsigned)VT_PITCH + (unsigned)n0; return true; }
};
struct GatedSched {
    static constexpr bool GATHER = false, VAR_NT = false;
    const char* A; const char* Bt; unsigned lda, ldb, hstepA, hstepB; int nt, ldc; const int* rowtok; g8::DenseOrder ord;
    __device__ __forceinline__ void init(const void* A_, const void* Bt_, int M, int N2, int K, int ldc_, int G, int c) {
        A = (const char*)A_; Bt = (const char*)Bt_; lda = (unsigned)K * 2u; ldb = lda; hstepA = 128u * lda; hstepB = (unsigned)N2 * ldb; nt = K / 64; ldc = ldc_; rowtok = nullptr; ord.init(M, 2 * N2, G, c); }
    __device__ __forceinline__ void init8(const void* A_, const void* Bt_, int M, int N2, int Kbytes, int ldc_, int G, int c) {
        A = (const char*)A_; Bt = (const char*)Bt_; lda = (unsigned)Kbytes; ldb = lda; hstepA = 128u * lda; hstepB = (unsigned)N2 * ldb; nt = Kbytes / 128; ldc = ldc_; rowtok = nullptr; ord.init(M, 2 * N2, G, c); }
    __device__ __forceinline__ bool next(int i, GU& u) const { int pm, pn; if (!ord.tile(i, pm, pn)) return false;
        u.a = (unsigned)pm * 2u * hstepA; u.b = (unsigned)pn * 128u * ldb; u.row0 = pm * 256; u.col0 = pn * 128; u.ooff = (unsigned)(pm * 256) * (unsigned)ldc + (unsigned)(pn * 128); u.aux = 0; return true; }
};
template <bool G1> struct MoeSched {
    static constexpr bool GATHER = G1, VAR_NT = false;
    const char* A; const char* Bt; unsigned lda, ldb, hstepA, hstepB; int nt, ldc; const int* rowtok;
    int G, c, NCT, wv; const volatile LAS int* tsp;
    __device__ __forceinline__ void init(const void* A_, const void* Bt_, const int* rowtok_, const volatile LAS int* tstart, int G_, int c_, int wave_) {
        A = (const char*)A_; Bt = (const char*)Bt_; lda = 1024u; ldb = lda; hstepA = 128u * lda; hstepB = G1 ? 1024u * ldb : 128u * ldb; nt = 8; ldc = 1024; rowtok = rowtok_;
        G = G_; c = c_; NCT = G1 ? 8 : 4; wv = wave_; tsp = tstart; }
    __device__ __forceinline__ bool next(int i, GU& u) const {
        const int l = hidden_tid(wv) & 63; const int vts = l <= 32 ? tsp[l] : 0x7fffffff;
        const int total = __builtin_amdgcn_readlane(vts, 32) * NCT; int Li;
        if ((G & 7) == 0) {
            const int x = c & 7, j = c >> 3, q = total >> 3, r = total & 7; const int len = q + (x < r ? 1 : 0), start = x * q + (x < r ? x : r), off = i * (G >> 3) + j;
            if (off >= len) return false; Li = start + off; }
        else { const long L = (long)i * G + c; if (L >= total) return false; Li = (int)L; }
        const unsigned long long mk = __ballot(l < 32 && vts * NCT <= Li);
        const int e = __popcll(mk) - 1; const int t0 = __builtin_amdgcn_readlane(vts, e);
        const int loc = Li - t0 * NCT, rt = loc / NCT, ct = loc - rt * NCT;
        const int prow = (t0 + rt) * 256;
        u.row0 = prow; u.aux = e;
        if (G1) { u.a = 0u; u.b = ((unsigned)e * 2048u + (unsigned)ct * 128u) * 1024u; u.col0 = ct * 128; u.ooff = (unsigned)prow * 1024u + (unsigned)ct * 128u; }
        else { u.a = (unsigned)prow * 1024u; u.b = ((unsigned)e * 1024u + (unsigned)ct * 256u) * 1024u; u.col0 = ct * 256; u.ooff = (unsigned)prow * 1024u + (unsigned)ct * 256u; }
        return true; }
};
struct F1Sched {
    static constexpr bool GATHER = false, VAR_NT = false;
    const char* A; const char* Bt; unsigned lda, ldb, hstepA, hstepB; int nt, ldc; const int* rowtok; int G, c;
    __device__ __forceinline__ void init(const void* acs, const void* U, int G_, int c_) { A = (const char*)acs; Bt = (const char*)U; lda = 512u; ldb = 2048u; hstepA = 128u * 512u; hstepB = 128u * 2048u; nt = 4; ldc = 8192; rowtok = nullptr; G = G_; c = c_; }
    __device__ __forceinline__ bool next(int i, GU& u) const {
        int Li; if (!xcd_local(i, G, c, 1024 + 64, Li)) return false;
        if (Li < 1024) { const int sub = Li & 7, tt = (Li >> 3) & 15, b = Li >> 7, cs = sub >> 2, mt = sub & 3;
            u.a = (unsigned)cs * 131072u; u.b = (unsigned)(b * SEQ + tt * 256) * 2048u + (unsigned)mt * 512u; u.row0 = mt * 256; u.col0 = 0; u.aux = 0;
            u.ooff = (unsigned)(b * 1024 + mt * 256) * 8192u + (unsigned)(cs * 4096 + tt * 256); }
        else { Li -= 1024; const int sub = Li & 7, b = Li >> 3, cs = sub >> 2, mt = sub & 3;
            u.a = (unsigned)cs * 131072u; u.b = (unsigned)(T_LAT + b * CTXL) * 2048u + (unsigned)mt * 512u; u.row0 = mt * 256; u.col0 = 0; u.aux = 0;
            u.ooff = 8u * 1024u * 8192u + (unsigned)(b * 1024 + mt * 256) * 8192u + (unsigned)(cs * 256); }
        return true; }
};
static_assert(WS_K - WS_Q == WS_V - WS_K, "Q, K, V equally spaced");
static_assert(WS_YTC >= WS_YT + (size_t)2 * 8 * 1024 * 8192, "ctx Yt follows lat Yt (8 MiB x 8 after it)");
struct F2Sched {
    static constexpr bool GATHER = false, VAR_NT = true;
    const char* A; const char* Bt; unsigned lda, ldb, hstepA, hstepB; int nt, ldc; const int* rowtok; int G, c;
    __device__ __forceinline__ void init(const void* dft, const void* Yt, int G_, int c_) { A = (const char*)dft; Bt = (const char*)Yt;
        lda = 8192u; ldb = 8192u; hstepA = 128u * 8192u; hstepB = hstepA; nt = 0; ldc = 1024; rowtok = nullptr; G = G_; c = c_; }
    __device__ __forceinline__ bool next(int i, GU& u) const {
        int Li;
        if ((G & 7) == 0) { const int off = i * (G >> 3) + (c >> 3); if (off >= 68) return false; Li = off < 64 ? (c & 7) * 64 + off : 512 + (c & 7) * 4 + (off - 64); }
        else { const long L = (long)i * G + c; if (L >= 512 + 32) return false; Li = (int)L; }
        if (Li < 512) { const int ct = Li & 3, kt = (Li >> 2) & 15, b = Li >> 6;
            u.a = (unsigned)kt * 256u * 8192u; u.b = (unsigned)(b * 1024 + ct * 256) * 8192u; u.row0 = b * SEQ + kt * 256; u.col0 = ct * 256; u.aux = 64; }
        else { Li -= 512; const int ct = Li & 3, b = Li >> 2;
            u.a = 4096u * 8192u; u.b = (unsigned)(8 * 1024 + b * 1024 + ct * 256) * 8192u; u.row0 = T_LAT + b * CTXL; u.col0 = ct * 256; u.aux = 4; }
        u.ooff = (unsigned)u.row0 * 1024u + (unsigned)u.col0; return true; }
};
namespace att {
constexpr int SLOTK = 4096, SLOTV = 8192, NSLOT = 4, PFD = NSLOT - 1;
constexpr int LDS_K = 0, LDS_V = NSLOT * SLOTK, LDS_WS = LDS_V + NSLOT * SLOTV, LDS_OST = LDS_WS + NWAVES * 256, LDS_END = LDS_OST + NWAVES * 8192;
static_assert(LDS_END <= MISC_OFF, "attention LDS map");
__device__ __forceinline__ int crow(int r, int hi) { return (r & 3) + 8 * (r >> 2) + 4 * hi; }
struct Params { const unsigned char* Q; const unsigned char* K; const unsigned char* Vt; unsigned char* O; float* scr; const float* subln_g; float lam, outscale; int wave; };
__device__ __forceinline__ float max3f(float a, float b, float c) { float r; asm("v_max3_f32 %0, %1, %2, %3" : "=v"(r) : "v"(a), "v"(b), "v"(c)); return r; }
__device__ __forceinline__ i32x8 cat8(i32x4 a, i32x4 b) { return (i32x8){a[0], a[1], a[2], a[3], b[0], b[1], b[2], b[3]}; }

template <int THRL, int VAR = 0>
__device__ __forceinline__ void unit(const Params& P, int b, int h, int c, int qrow0, int t_begin, int t_end, LAS unsigned char* lds) {
    const int tid = hidden_tid(P.wave), lane = tid & 63, r32 = lane & 31, hi = lane >> 5; const int wid = P.wave; const int grp = (wid >> ATT_GSH) & 1; const bool dk = wid < 4;
    LAS float* wsf = (LAS float*)(lds + LDS_WS) + wid * 64;
    const int drow = lane >> 2, dsw = (lane & 3) ^ ((lane >> 4) & 3);
    const unsigned koff = (unsigned)(16 * (wid & 3) + drow) * 1024u + (unsigned)(h * 128 + c * 64 + 16 * dsw);
    const unsigned voff = (unsigned)((b * 1024 + h * 128 + 16 * wid + drow) * VT_PITCH + 16 * dsw);
    const char* Kb = (const char*)P.K; const char* Vb = (const char*)P.Vt; const unsigned lds0 = (unsigned)(unsigned long)lds;
#define ATT_KROW0(t) ((t) < 64 ? b * SEQ + 64 * (t) : T_LAT + b * CTXL + 64 * ((t) - 64))
#define ATT_GLDS(sbase, vo, ldsaddr) do { unsigned keep_ = 0; asm volatile("s_mov_b32 m0, %2\n\ts_nop 4\n\tglobal_load_lds_dwordx4 %0, %1" :: "v"(vo), "s"(sbase), "s"(ldsaddr) : "memory"); (void)keep_; } while (0)
#define ATT_DMA_K(t, slot) do { if (dk) { const char* kp_ = Kb + (size_t)(ATT_KROW0(t)) * 1024; ATT_GLDS(kp_, koff, lds0 + (unsigned)(LDS_K + (slot) * SLOTK + wid * 1024)); } } while (0)
#define ATT_DMA_V(t, slot) do { const char* vp_ = Vb + (size_t)(t) * 64; ATT_GLDS(vp_, voff, lds0 + (unsigned)(LDS_V + (slot) * SLOTV + wid * 1024)); } while (0)
#define ATT_BAR() asm volatile("s_waitcnt lgkmcnt(0)\n\ts_barrier" ::: "memory")
#define ATT_VM(N) asm volatile("s_waitcnt vmcnt(" #N ")" ::: "memory")
#define ATT_VMN(N) asm volatile("s_waitcnt vmcnt(%0)" :: "n"(N) : "memory")
    const int T = t_end - t_begin;
#pragma unroll
    for (int j = 0; j < PFD; ++j) { if (j < T) ATT_DMA_K(t_begin + j, j); if (j < PFD - 1 && j < T) ATT_DMA_V(t_begin + j, j); }
    i32x8 qf;
    { const unsigned char* Qw = P.Q + (size_t)(qrow0 + wid * 32 + r32) * D + h * 128 + c * 64 + hi * 32; qf = cat8(*(const i32x4*)Qw, *(const i32x4*)(Qw + 16)); }
    f32x16 o[4], negm;
#pragma unroll
    for (int r = 0; r < 16; ++r) { negm[r] = 0.f;
#pragma unroll
        for (int d0 = 0; d0 < 4; ++d0) o[d0][r] = 0.f; }
    float mhat = 0.f;
    f32x16 lacc;
#pragma unroll
    for (int r = 0; r < 16; ++r) lacc[r] = 0.f;
    i32x8 ones; { int o1_ = 0x38383838; asm volatile("" : "+v"(o1_)); ones = (i32x8){o1_, o1_, o1_, o1_, o1_, o1_, o1_, o1_}; }
    const int fsw = (r32 >> 2) & 3;
    const int foff0 = r32 * 64 + ((2 * hi) ^ fsw) * 16, foff1 = r32 * 64 + ((2 * hi + 1) ^ fsw) * 16;
    int sc_s = 0x7d7d7d7d, sc_1 = 0x7f7f7f7f; asm volatile("" : "+v"(sc_s), "+v"(sc_1));
    f32x16 p0, p1; i32x8 pa;
#pragma unroll
    for (int r = 0; r < 16; ++r) { p0[r] = 0.f; p1[r] = 0.f; }
#pragma unroll
    for (int k = 0; k < 8; ++k) pa[k] = 0;
#define ATT_SOFTMAX(FIRST) do { \
        float rm, rm1 = max3f(p0[3], p0[4], p0[5]), rm2 = max3f(p0[6], p0[7], p0[8]), rm3 = max3f(p0[9], p0[10], p0[11]);     \
        rm = max3f(p0[0], p0[1], p0[2]); rm = max3f(rm, p0[12], p0[13]); rm1 = max3f(rm1, p0[14], p0[15]); rm2 = max3f(rm2, p1[0], p1[1]); rm3 = max3f(rm3, p1[2], p1[3]); \
        rm = max3f(rm, p1[4], p1[5]); rm1 = max3f(rm1, p1[6], p1[7]); rm2 = max3f(rm2, p1[8], p1[9]); rm3 = max3f(rm3, p1[10], p1[11]); \
        rm = max3f(rm, p1[12], p1[13]); rm1 = max3f(rm1, p1[14], p1[15]); rm = max3f(rm, rm1, rm2); rm = max3f(rm, rm3, rm3); \
        { auto rr = __builtin_amdgcn_permlane32_swap(__float_as_uint(rm), __float_as_uint(rm), false, false); rm = max3f(__uint_as_float(rr[0]), __uint_as_float(rr[1]), __uint_as_float(rr[1])); } \
        if ((FIRST) || __any(rm > (float)THRL)) { \
            const float dl = (FIRST) ? rm : fmaxf(rm, 0.f), f = (FIRST) ? 1.0f : __builtin_amdgcn_exp2f(-dl);     \
            mhat += dl; \
            _Pragma("unroll") for (int r = 0; r < 16; ++r) { p0[r] -= dl; p1[r] -= dl; negm[r] = -mhat; } \
            if (hi == 0) wsf[r32] = f; \
            LDS_WAIT(); \
            _Pragma("unroll") for (int r = 0; r < 16; ++r) { const float fr_ = wsf[crow(r, hi)]; \
                lacc[r] *= fr_; \
                _Pragma("unroll") for (int d0 = 0; d0 < 4; ++d0) o[d0][r] *= fr_; } \
        } \
        _Pragma("unroll") for (int r = 0; r < 16; ++r) { p0[r] = __builtin_amdgcn_exp2f(p0[r]); p1[r] = __builtin_amdgcn_exp2f(p1[r]); } \
        _Pragma("unroll") for (int q = 0; q < 4; ++q) { pa[q] = (int)pack_fp8x4(p0[4 * q], p0[4 * q + 1], p0[4 * q + 2], p0[4 * q + 3]); pa[4 + q] = (int)pack_fp8x4(p1[4 * q], p1[4 * q + 1], p1[4 * q + 2], p1[4 * q + 3]); } \
    } while (0)
    ATT_VM(0); ATT_BAR();
    int sk = 0, sv = NSLOT - 1;
    for (int s = 0; s <= T; ++s) {
#define ATT_ISSUE() do { const int k2 = sk == 0 ? NSLOT - 1 : sk - 1, v1 = k2 == 0 ? NSLOT - 1 : k2 - 1;     \
          if (VAR != 3) { if (s + PFD < T) ATT_DMA_K(t_begin + s + PFD, k2); \
          if (s + PFD - 1 < T) ATT_DMA_V(t_begin + s + PFD - 1, v1); } } while (0)
        if (VAR != 1 && VAR != 5) { if (grp == 1 && s > 0) ATT_SOFTMAX(s == 1); }
        if (grp == 1) ATT_ISSUE();
        i32x8 kf0, kf1;
        if (VAR != 2 && VAR != 5 && s < T) { const LAS unsigned char* Ks = lds + LDS_K + sk * SLOTK;
            kf0 = cat8(*(const LAS i32x4*)(Ks + foff0), *(const LAS i32x4*)(Ks + foff1)); kf1 = cat8(*(const LAS i32x4*)(Ks + 2048 + foff0), *(const LAS i32x4*)(Ks + 2048 + foff1)); }
        if (VAR != 2 && VAR != 5 && s < T) {
            __builtin_amdgcn_s_setprio(1);
            p0 = __builtin_amdgcn_mfma_scale_f32_32x32x64_f8f6f4(kf0, qf, negm, 0, 0, 0, sc_s, 0, sc_s);
            p1 = __builtin_amdgcn_mfma_scale_f32_32x32x64_f8f6f4(kf1, qf, negm, 0, 0, 0, sc_s, 0, sc_s);
            __builtin_amdgcn_s_setprio(0);
        }
        if (VAR != 2 && VAR != 5 && s > 0) {
            const LAS unsigned char* Vs = lds + LDS_V + sv * SLOTV;
            i32x8 vf[4];
#pragma unroll
            for (int d0 = 0; d0 < 4; ++d0) vf[d0] = cat8(*(const LAS i32x4*)(Vs + d0 * 2048 + foff0), *(const LAS i32x4*)(Vs + d0 * 2048 + foff1));
            __builtin_amdgcn_s_setprio(1);
#pragma unroll
            for (int d0 = 0; d0 < 4; ++d0) o[d0] = __builtin_amdgcn_mfma_scale_f32_32x32x64_f8f6f4(pa, vf[d0], o[d0], 0, 0, 0, sc_1, 0, sc_1);
            lacc = __builtin_amdgcn_mfma_scale_f32_32x32x64_f8f6f4(pa, ones, lacc, 0, 0, 0, sc_1, 0, sc_1);
            __builtin_amdgcn_s_setprio(0);
        }
        if (VAR != 2 && VAR != 5 && s < T) asm volatile("s_nop 15\n\ts_nop 15" : "+v"(p0), "+v"(p1));
        if (grp == 0) ATT_ISSUE();
        if (VAR != 1 && VAR != 5) { if (grp == 0 && s < T) ATT_SOFTMAX(s == 0); }
        if (s + PFD < T) { if (dk) { ATT_VMN(2 * (PFD - 1)); } else { ATT_VMN(PFD - 1); } } else { ATT_VM(0); }
        if (VAR != 4) ATT_BAR();
        sv = sk; sk = sk == NSLOT - 1 ? 0 : sk + 1;
    }
#undef ATT_SOFTMAX
#undef ATT_ISSUE
    f32x4* scr4 = (f32x4*)(P.scr + (size_t)blockIdx.x * 32768) + tid;
    if (c == 0) {
        float rl[16];
#pragma unroll
        for (int r = 0; r < 16; ++r) rl[r] = __builtin_amdgcn_rcpf(lacc[r]);
#pragma unroll
        for (int d0 = 0; d0 < 4; ++d0)
#pragma unroll
            for (int rq = 0; rq < 4; ++rq) scr4[(d0 * 4 + rq) * 512] = (f32x4){o[d0][4 * rq] * rl[4 * rq], o[d0][4 * rq + 1] * rl[4 * rq + 1], o[d0][4 * rq + 2] * rl[4 * rq + 2], o[d0][4 * rq + 3] * rl[4 * rq + 3]};
    } else {
        f32x4 o0v[16];
#pragma unroll
        for (int q = 0; q < 16; ++q) o0v[q] = scr4[q * 512];
        const float g0 = P.subln_g[r32], g1 = P.subln_g[32 + r32], g2 = P.subln_g[64 + r32], g3 = P.subln_g[96 + r32];
        LAS unsigned char* stg = lds + LDS_OST + wid * 4096;
#pragma unroll
        for (int r = 0; r < 16; ++r) { const float rl = __builtin_amdgcn_rcpf(lacc[r]) * P.lam; float dv[4]; float ss = 0.f;
#pragma unroll
            for (int d0 = 0; d0 < 4; ++d0) { const float o0 = o0v[d0 * 4 + (r >> 2)][r & 3]; dv[d0] = o0 - o[d0][r] * rl; ss += dv[d0] * dv[d0]; }
            ss += sx<1>(ss); ss += sx<2>(ss); ss += ar4(ss); ss += ar8(ss); ss += sx<16>(ss);
            const float sc = rsqrtf(ss * (1.0f / 128.0f) + ln_eps()) * P.outscale; const int orow = crow(r, hi);
            { const unsigned pk_ = pack_fp8x4(dv[0] * sc * g0, dv[1] * sc * g1, dv[2] * sc * g2, dv[3] * sc * g3);
              stg[orow * 128 + r32] = (unsigned char)(pk_ & 0xffu); stg[orow * 128 + 32 + r32] = (unsigned char)((pk_ >> 8) & 0xffu);
              stg[orow * 128 + 64 + r32] = (unsigned char)((pk_ >> 16) & 0xffu); stg[orow * 128 + 96 + r32] = (unsigned char)(pk_ >> 24); }
            if ((r & 3) == 3) __builtin_amdgcn_sched_barrier(0); }
        LDS_WAIT();
        unsigned char* Ow = P.O + (size_t)(qrow0 + wid * 32) * D + h * 128;
#pragma unroll
        for (int i = 0; i < 4; ++i) { const int id = i * 64 + lane, row = id >> 3, ch = id & 7; const u32x4 v = *(const LAS u32x4*)(stg + row * 128 + ch * 16); *(u32x4*)(Ow + (size_t)row * D + ch * 16) = v; }
    }
    asm volatile("s_waitcnt vmcnt(0) lgkmcnt(0)\n\ts_barrier" ::: "memory");
#undef ATT_DMA_K
#undef ATT_GLDS
#undef ATT_DMA_V
#undef ATT_KROW0
#undef ATT_BAR
#undef ATT_VM
#undef ATT_VMN
}
}

struct Args { const float* in[33]; float* out; unsigned char* ws; int ph_lo, ph_hi; };
enum { I_X = 0, I_C, I_CTX, I_CCTX, I_WMOD, I_BMOD, I_LN1G, I_LN1B, I_LN2G, I_LN2B, I_AQKV, I_AWO, I_LQ1, I_LK1, I_LQ2, I_LK2, I_SUBLN, I_FW, I_FB,
       I_CPW1, I_CBPW1, I_CWDW, I_CBDW, I_CLNG, I_CLNB, I_CPW2, I_CBPW2, I_RW, I_RB, I_MW1, I_MB1, I_MW2, I_MB2 };
struct Frame {
    LAS unsigned char* lds; volatile LAS unsigned* MISC; unsigned* ctl; unsigned char* ws;
    int tid, lane, wave, vcu, G, zi;
    const float* const* in; float* out;
};
#define WSP(T, off) ((T*)(F.ws + (off)))
#define MODP(layer, ci, chunk) (WSP(const float, WS_MOD) + ((size_t)(layer) * 9 + (ci)) * 6144 + (chunk) * 1024)

__device__ __forceinline__ void ld_row_f32(const float* p, int lane, f32x4 (&v)[4]) {
#pragma unroll
    for (int j = 0; j < 4; ++j) v[j] = *(const f32x4*)(p + 4 * lane + 256 * j);
}
__device__ __forceinline__ void ld_row_bf16(const bf16_t* p, int lane, f32x4 (&v)[4]) {
#pragma unroll
    for (int j = 0; j < 4; ++j) { const u32x2 w = *(const u32x2*)(p + 4 * lane + 256 * j); v[j] = (f32x4){bf_lo(w.x), bf_hi(w.x), bf_lo(w.y), bf_hi(w.y)}; }
}
__device__ __forceinline__ void ld_row_fp8(const unsigned char* p, int lane, f32x4 (&v)[4]) {
#pragma unroll
    for (int j = 0; j < 4; ++j) { const int w = *(const int*)(p + 4 * lane + 256 * j); const f32x2 lo = __builtin_amdgcn_cvt_pk_f32_fp8(w, false), hi = __builtin_amdgcn_cvt_pk_f32_fp8(w, true); v[j] = (f32x4){lo.x, lo.y, hi.x, hi.y}; }
}
__device__ __forceinline__ void st_row_f32(float* p, int lane, const f32x4 (&v)[4]) {
#pragma unroll
    for (int j = 0; j < 4; ++j) *(f32x4*)(p + 4 * lane + 256 * j) = v[j];
}
__device__ __forceinline__ void st_row_bf16(bf16_t* p, int lane, const f32x4 (&v)[4]) {
#pragma unroll
    for (int j = 0; j < 4; ++j) { u32x2 w; w.x = cvt_pk_bf16(v[j][0], v[j][1]); w.y = cvt_pk_bf16(v[j][2], v[j][3]); *(u32x2*)(p + 4 * lane + 256 * j) = w; }
}
__device__ __forceinline__ void st_row_fp8(unsigned char* p, int lane, const f32x4 (&v)[4]) {
#pragma unroll
    for (int j = 0; j < 4; ++j) *(unsigned*)(p + 4 * lane + 256 * j) = pack_fp8x4(v[j][0], v[j][1], v[j][2], v[j][3]);
}
__device__ __forceinline__ void layer_norm_row(f32x4 (&v)[4], const float* g, const float* b, int lane) {
    float s = 0.f;
#pragma unroll
    for (int j = 0; j < 4; ++j) s += (v[j][0] + v[j][1]) + (v[j][2] + v[j][3]);
    const float mean = wave_sum(s) * (1.0f / D); float q = 0.f;
#pragma unroll
    for (int j = 0; j < 4; ++j) { v[j] = v[j] - mean; q += (v[j][0] * v[j][0] + v[j][1] * v[j][1]) + (v[j][2] * v[j][2] + v[j][3] * v[j][3]); }
    const float rstd = rsqrtf(wave_sum(q) * (1.0f / D) + ln_eps());
#pragma unroll
    for (int j = 0; j < 4; ++j) { const f32x4 gg = *(const f32x4*)(g + 4 * lane + 256 * j), bb = *(const f32x4*)(b + 4 * lane + 256 * j); v[j] = v[j] * rstd * gg + bb; }
}
__device__ __forceinline__ void ld_vec(const float* p, int lane, f32x4 (&v)[4]) {
#pragma unroll
    for (int j = 0; j < 4; ++j) v[j] = *(const f32x4*)(p + 4 * lane + 256 * j);
}
__device__ __forceinline__ void layer_norm_row_r(f32x4 (&v)[4], const f32x4 (&g)[4], const f32x4 (&b)[4]) {
    float s = 0.f;
#pragma unroll
    for (int j = 0; j < 4; ++j) s += (v[j][0] + v[j][1]) + (v[j][2] + v[j][3]);
    const float mean = wave_sum(s) * (1.0f / D); float q = 0.f;
#pragma unroll
    for (int j = 0; j < 4; ++j) { v[j] = v[j] - mean; q += (v[j][0] * v[j][0] + v[j][1] * v[j][1]) + (v[j][2] * v[j][2] + v[j][3] * v[j][3]); }
    const float rstd = rsqrtf(wave_sum(q) * (1.0f / D) + ln_eps());
#pragma unroll
    for (int j = 0; j < 4; ++j) v[j] = v[j] * rstd * g[j] + b[j];
}
__device__ __forceinline__ void ld_rowB_f32(const float* p, int lane, f32x4 (&v)[4]) {
#pragma unroll
    for (int i = 0; i < 4; ++i) v[i] = *(const f32x4*)(p + 16 * lane + 4 * i);
}
__device__ __forceinline__ void st_rowB_f32(float* p, int lane, const f32x4 (&v)[4]) {
#pragma unroll
    for (int i = 0; i < 4; ++i) *(f32x4*)(p + 16 * lane + 4 * i) = v[i];
}
__device__ __forceinline__ void ld_rowB_fp8(const unsigned char* p, int lane, f32x4 (&v)[4]) {
    const u32x4 w = *(const u32x4*)(p + 16 * lane);
#pragma unroll
    for (int i = 0; i < 4; ++i) { const f32x2 lo = __builtin_amdgcn_cvt_pk_f32_fp8((int)w[i], false), hi = __builtin_amdgcn_cvt_pk_f32_fp8((int)w[i], true); v[i] = (f32x4){lo.x, lo.y, hi.x, hi.y}; }
}
__device__ __forceinline__ void ld_rowB_bf16(const bf16_t* p, int lane, f32x4 (&v)[4]) {
    const u32x4 w0 = *(const u32x4*)(p + 16 * lane), w1 = *(const u32x4*)(p + 16 * lane + 8);
    v[0] = (f32x4){bf_lo(w0.x), bf_hi(w0.x), bf_lo(w0.y), bf_hi(w0.y)}; v[1] = (f32x4){bf_lo(w0.z), bf_hi(w0.z), bf_lo(w0.w), bf_hi(w0.w)};
    v[2] = (f32x4){bf_lo(w1.x), bf_hi(w1.x), bf_lo(w1.y), bf_hi(w1.y)}; v[3] = (f32x4){bf_lo(w1.z), bf_hi(w1.z), bf_lo(w1.w), bf_hi(w1.w)};
}
__device__ __forceinline__ int permB(int c) { return 4 * (c >> 4) + 256 * ((c >> 2) & 3) + (c & 3); }
__device__ __forceinline__ void st_rowB_fp8(unsigned char* p, int lane, const f32x4 (&v)[4]) {
    *(u32x4*)(p + 16 * lane) = (u32x4){pack_fp8x4(v[0][0], v[0][1], v[0][2], v[0][3]), pack_fp8x4(v[1][0], v[1][1], v[1][2], v[1][3]), pack_fp8x4(v[2][0], v[2][1], v[2][2], v[2][3]), pack_fp8x4(v[3][0], v[3][1], v[3][2], v[3][3])};
}
__device__ __forceinline__ void st_rowB_bf16(bf16_t* p, int lane, const f32x4 (&v)[4]) {
    *(u32x4*)(p + 16 * lane) = (u32x4){cvt_pk_bf16(v[0][0], v[0][1]), cvt_pk_bf16(v[0][2], v[0][3]), cvt_pk_bf16(v[1][0], v[1][1]), cvt_pk_bf16(v[1][2], v[1][3])};
    *(u32x4*)(p + 16 * lane + 8) = (u32x4){cvt_pk_bf16(v[2][0], v[2][1]), cvt_pk_bf16(v[2][2], v[2][3]), cvt_pk_bf16(v[3][0], v[3][1]), cvt_pk_bf16(v[3][2], v[3][3])};
}
__device__ __forceinline__ const float* xrow_in(const Frame& F, int layer, int row) {
    if (layer == 0) return row < T_LAT ? F.in[F.zi + I_X] + (size_t)row * D : F.in[F.zi + I_CTX] + (size_t)(row - T_LAT) * D;
    return WSP(const float, WS_X) + (size_t)row * D;
}
__device__ __forceinline__ int cond_of(int row) { return row < T_LAT ? (row >> 12) : 8; }

__device__ __forceinline__ void transpose_family(const Frame& F, const float* src, int nmat, int K, int N, bf16_t* dst, LAS float* scr) {
    const int lane = hidden_tid(F.wave) & 63; const int gw = F.vcu * NWAVES + F.wave, NGW = F.G * NWAVES;
    const int nkb = K / 64, nnb = N / 64, per = nkb * nnb; const long items = (long)nmat * per;
    for (long it = gw; it < items; it += NGW) {
        const int mat = (int)(it / per), r = (int)(it % per), kb = r / nnb, nb = r % nnb, k0 = kb * 64, n0 = nb * 64;
        const float* W = src + (size_t)mat * K * N; bf16_t* WT = dst + (size_t)mat * K * N;
        f32x4 v[16];
#pragma unroll
        for (int i = 0; i < 16; ++i) v[i] = *(const f32x4*)(W + (size_t)(k0 + 4 * i + (lane >> 4)) * N + n0 + 4 * (lane & 15));
#pragma unroll
        for (int i = 0; i < 16; ++i) { LAS float* s = scr + (4 * i + (lane >> 4)) * 65 + 4 * (lane & 15); s[0] = v[i][0]; s[1] = v[i][1]; s[2] = v[i][2]; s[3] = v[i][3]; }
        LDS_WAIT(); asm volatile("" ::: "memory");
        const int kc = lane & 7;
#pragma unroll
        for (int jj = 0; jj < 8; ++jj) { const int n = (lane >> 3) + 8 * jj; const LAS float* s = scr + (8 * kc) * 65 + n;
            u32x4 o; o.x = cvt_pk_bf16(s[0], s[65]); o.y = cvt_pk_bf16(s[2 * 65], s[3 * 65]); o.z = cvt_pk_bf16(s[4 * 65], s[5 * 65]); o.w = cvt_pk_bf16(s[6 * 65], s[7 * 65]);
            *(u32x4*)(WT + (size_t)(n0 + n) * K + k0 + 8 * kc) = o; }
        LDS_WAIT(); asm volatile("" ::: "memory");
    }
}
template <bool FP8> __device__ __forceinline__ void quant_w(Frame& F, const float* src, int nmat, int N, unsigned char* dst, float* scales, int rot = 0) {
    const int tid = hidden_tid(F.wave), lane = tid & 63, wave = __builtin_amdgcn_readfirstlane(tid >> 6);
    LAS float* scr = (LAS float*)(F.lds + wave * 16640);
    LAS float* cmaxp = (LAS float*)(F.lds + 133120);
    LAS float* finv = (LAS float*)(F.lds + 133120 + 2048);
    const int strips = N / 64;
    for (int it = (F.vcu + F.G - rot % F.G) % F.G; it < nmat * strips; it += F.G) {
        const int mat = it / strips, n0 = (it % strips) * 64;
        const float* W = src + (size_t)mat * 1024 * N + n0 + 4 * (lane & 15);
        f32x4 v[32];
#pragma unroll
        for (int i = 0; i < 32; ++i) v[i] = *(const f32x4*)(W + (size_t)(wave * 128 + 4 * i + (lane >> 4)) * N);
        float mx0 = 0.f, mx1 = 0.f, mx2 = 0.f, mx3 = 0.f;
#pragma unroll
        for (int i = 0; i < 32; ++i) { mx0 = fmaxf(mx0, fabsf(v[i][0])); mx1 = fmaxf(mx1, fabsf(v[i][1])); mx2 = fmaxf(mx2, fabsf(v[i][2])); mx3 = fmaxf(mx3, fabsf(v[i][3])); }
        mx0 = fmaxf(mx0, sx<16>(mx0)); mx1 = fmaxf(mx1, sx<16>(mx1)); mx2 = fmaxf(mx2, sx<16>(mx2)); mx3 = fmaxf(mx3, sx<16>(mx3));
        { auto r0 = __builtin_amdgcn_permlane32_swap(__float_as_uint(mx0), __float_as_uint(mx0), false, false); mx0 = fmaxf(__uint_as_float(r0[0]), __uint_as_float(r0[1]));
          auto r1 = __builtin_amdgcn_permlane32_swap(__float_as_uint(mx1), __float_as_uint(mx1), false, false); mx1 = fmaxf(__uint_as_float(r1[0]), __uint_as_float(r1[1]));
          auto r2 = __builtin_amdgcn_permlane32_swap(__float_as_uint(mx2), __float_as_uint(mx2), false, false); mx2 = fmaxf(__uint_as_float(r2[0]), __uint_as_float(r2[1]));
          auto r3 = __builtin_amdgcn_permlane32_swap(__float_as_uint(mx3), __float_as_uint(mx3), false, false); mx3 = fmaxf(__uint_as_float(r3[0]), __uint_as_float(r3[1])); }
        if (lane < 16) *(LAS f32x4*)(cmaxp + wave * 64 + 4 * lane) = (f32x4){mx0, mx1, mx2, mx3};
        __syncthreads();
        if (tid < 64) { float m = cmaxp[tid];
#pragma unroll
            for (int w = 1; w < 8; ++w) m = fmaxf(m, cmaxp[w * 64 + tid]);
            const float sc = m > 0.f ? m * (1.0f / (FP8 ? FP8_TOP : 127.0f)) : 1.0f; scales[(size_t)mat * N + n0 + tid] = sc; finv[tid] = 1.0f / sc; }
        __syncthreads();
        unsigned char* Wq = dst + (size_t)mat * N * 1024;
#pragma unroll
        for (int kb2 = 0; kb2 < 2; ++kb2) { const int k0 = wave * 128 + kb2 * 64;
#pragma unroll
            for (int i = 0; i < 16; ++i) { LAS float* sp = scr + (4 * i + (lane >> 4)) * 65 + 4 * (lane & 15); sp[0] = v[16 * kb2 + i][0]; sp[1] = v[16 * kb2 + i][1]; sp[2] = v[16 * kb2 + i][2]; sp[3] = v[16 * kb2 + i][3]; }
            LDS_WAIT(); asm volatile("" ::: "memory");
            const int kc = lane & 3;
#pragma unroll
            for (int jj = 0; jj < 4; ++jj) { const int n = (lane >> 2) + 16 * jj; const LAS float* sp = scr + (16 * kc) * 65 + n; const float fi = finv[n];
                u32x4 o;
                if (FP8) { o.x = pack_fp8x4(sp[0] * fi, sp[65] * fi, sp[2 * 65] * fi, sp[3 * 65] * fi); o.y = pack_fp8x4(sp[4 * 65] * fi, sp[5 * 65] * fi, sp[6 * 65] * fi, sp[7 * 65] * fi);
                    o.z = pack_fp8x4(sp[8 * 65] * fi, sp[9 * 65] * fi, sp[10 * 65] * fi, sp[11 * 65] * fi); o.w = pack_fp8x4(sp[12 * 65] * fi, sp[13 * 65] * fi, sp[14 * 65] * fi, sp[15 * 65] * fi); }
                else { o.x = pack_i8x4(sp[0] * fi, sp[65] * fi, sp[2 * 65] * fi, sp[3 * 65] * fi); o.y = pack_i8x4(sp[4 * 65] * fi, sp[5 * 65] * fi, sp[6 * 65] * fi, sp[7 * 65] * fi);
                    o.z = pack_i8x4(sp[8 * 65] * fi, sp[9 * 65] * fi, sp[10 * 65] * fi, sp[11 * 65] * fi); o.w = pack_i8x4(sp[12 * 65] * fi, sp[13 * 65] * fi, sp[14 * 65] * fi, sp[15 * 65] * fi); }
                *(u32x4*)(Wq + (size_t)(n0 + n) * 1024 + k0 + 16 * kc) = o; }
            LDS_WAIT(); asm volatile("" ::: "memory");
        }
        __syncthreads();
    }
}
__device__ __forceinline__ void p0_prologue(Frame& F) {
    const int tid = hidden_tid(F.wave), lane = tid & 63, wave = __builtin_amdgcn_readfirstlane(tid >> 6);
    LAS float* sc = (LAS float*)F.lds;
    LAS float* red = (LAS float*)(F.lds + 40960);
    for (int i = tid; i < 9 * 1024; i += NTHR) { const float cv = i < 8192 ? F.in[F.zi + I_C][i] : F.in[F.zi + I_CCTX][i - 8192]; sc[i] = cv * fast_sigmoid(cv); }
    __syncthreads();
    for (int it = F.vcu; it < 4 * 96; it += F.G) {
        const int layer = it / 96, n = (it % 96) * 64 + lane;
        const float* W = F.in[F.zi + I_WMOD] + (size_t)layer * 1024 * 6144 + n;
        float a[9];
#pragma unroll
        for (int r = 0; r < 9; ++r) a[r] = 0.f;
#pragma unroll 8
        for (int k = wave * 128; k < wave * 128 + 128; ++k) { const float w = W[(size_t)k * 6144];
#pragma unroll
            for (int r = 0; r < 9; ++r) a[r] += sc[r * 1024 + k] * w; }
#pragma unroll
        for (int r = 0; r < 9; ++r) red[(wave * 9 + r) * 64 + lane] = a[r];
        __syncthreads();
        for (int r = wave; r < 9; r += NWAVES) { float s = F.in[F.zi + I_BMOD][layer * 6144 + n];
#pragma unroll
            for (int w = 0; w < 8; ++w) s += red[(w * 9 + r) * 64 + lane];
            WSP(float, WS_MOD)[((size_t)layer * 9 + r) * 6144 + n] = s; }
        __syncthreads();
    }
    const int gt = F.vcu * NTHR + tid, NGT = F.G * NTHR;
    for (int i = gt; i < 64 * 16; i += NGT) { const int pos = i >> 4, f = i & 15; const float inv = __powf(10000.0f, -(float)f / 16.0f); float s, c; sincosf((float)pos * inv, &s, &c);
        WSP(float, WS_ROPE)[2 * i] = c; WSP(float, WS_ROPE)[2 * i + 1] = s; }
    for (int i = gt; i < 2 * 256 * 256; i += NGT) { const int cs = i >> 16, r = (i >> 8) & 255, k = i & 255; float v = 0.f;
        if ((r >> 7) == (k >> 7)) { const int m = ((r & 127) * (k & 127)) & 127; v = (cs ? sinpif((float)m / 64.0f) : cospif((float)m / 64.0f)) * 0.08838834764831845f; }
        WSP(bf16_t, WS_ACS)[i] = (bf16_t)(cvt_pk_bf16(v, 0.f) & 0xffffu); }
    for (int i = gt; i < 256 * 512; i += NGT) { const int k = i >> 9, j = i & 511, n = j & 255; const int m = (k * n) & 255;
        const float v = (j < 256 ? cospif((float)m / 128.0f) : -sinpif((float)m / 128.0f)) * (0.0625f * DFT_PRESCALE);
        WSP(unsigned char, WS_DFTN)[(size_t)(4096 + k) * 8192 + j] = (unsigned char)(pack_fp8x4(v, 0.f, 0.f, 0.f) & 0xffu); }
    LAS float* tab = (LAS float*)(F.lds + 81920);
    for (int m = tid; m < 4096; m += NTHR) tab[m] = cospif((float)m / 2048.0f) * (0.015625f * DFT_PRESCALE);
    __syncthreads();
    for (int i = gt; i < 4096 * 1024; i += NGT) {
        const int k = i >> 10, j0 = (i & 1023) * 8; unsigned w[2];
#pragma unroll
        for (int q = 0; q < 2; ++q) { float v[4];
#pragma unroll
            for (int e = 0; e < 4; ++e) { const int j = j0 + 4 * q + e, n = j & 4095; const int m = (k * n) & 4095;
                v[e] = j < 4096 ? tab[m] : -tab[(m - 1024) & 4095]; }
            w[q] = pack_fp8x4(v[0], v[1], v[2], v[3]); }
        *(u32x2*)(WSP(unsigned char, WS_DFTN) + (size_t)k * 8192 + j0) = (u32x2){w[0], w[1]}; }
    __syncthreads();
    LAS float* scr = (LAS float*)(F.lds + wave * 16640);
    (void)scr;
    __syncthreads();
    quant_w<true>(F, F.in[F.zi + I_AQKV], 2, 3072, WSP(unsigned char, WS_WQKV), WSP(float, WS_WQKVS));
    quant_w<true>(F, F.in[F.zi + I_CPW1], 1, 2048, WSP(unsigned char, WS_PW1), WSP(float, WS_PW1S), 96);
    quant_w<true>(F, F.in[F.zi + I_AWO], 2, 1024, WSP(unsigned char, WS_WO), WSP(float, WS_WZS), 128);
    quant_w<true>(F, F.in[F.zi + I_FW], 1, 1024, WSP(unsigned char, WS_WF), WSP(float, WS_WZS) + 2048, 160);
    quant_w<true>(F, F.in[F.zi + I_CPW2], 1, 1024, WSP(unsigned char, WS_PW2), WSP(float, WS_WZS) + 3072, 176);
    quant_w<false>(F, F.in[F.zi + I_MW1], 128, 2048, WSP(unsigned char, WS_W1), WSP(float, WS_W1S));
    quant_w<true>(F, F.in[F.zi + I_MW2], 128, 1024, WSP(unsigned char, WS_W2), WSP(float, WS_W2S));
}
__device__ __forceinline__ void p1_modulate(Frame& F) {
    const int lane = hidden_tid(F.wave) & 63; const int gw = F.vcu * NWAVES + F.wave, NGW = F.G * NWAVES;
    const int per = (T_ALL + NGW - 1) / NGW, r0 = gw * per, r1 = min(T_ALL, r0 + per);
    int cic = -1; f32x4 psh[4], psc[4];
    for (int row = r0; row < r1; ++row) { const int ci = cond_of(row);
        if (ci != cic) { ld_rowB_f32(MODP(0, ci, 0), lane, psh); ld_rowB_f32(MODP(0, ci, 1), lane, psc); cic = ci; }
        f32x4 v[4]; ld_rowB_f32(xrow_in(F, 0, row), lane, v);
        st_rowB_bf16(WSP(bf16_t, WS_X) + (size_t)row * D, lane, v);
#pragma unroll
        for (int j = 0; j < 4; ++j) v[j] = v[j] * (1.0f + psc[j]) + psh[j];
        st_rowB_fp8(WSP(unsigned char, WS_U) + (size_t)row * D, lane, v); }
}
struct LRaw { u32x4 x0, x1, y0, y1; };
__device__ __forceinline__ void ln1_load(Frame& F, int row, int lane, LRaw& r) {
    const bf16_t* xp = WSP(const bf16_t, WS_X) + (size_t)row * D + 16 * lane; const bf16_t* yp = WSP(const bf16_t, WS_Y) + (size_t)row * D + 16 * lane;
    r.x0 = *(const u32x4*)xp; r.x1 = *(const u32x4*)(xp + 8); r.y0 = *(const u32x4*)yp; r.y1 = *(const u32x4*)(yp + 8);
}
__device__ __forceinline__ void unpack_bf16x16(const u32x4 w0, const u32x4 w1, f32x4 (&v)[4]) {
    v[0] = (f32x4){bf_lo(w0.x), bf_hi(w0.x), bf_lo(w0.y), bf_hi(w0.y)}; v[1] = (f32x4){bf_lo(w0.z), bf_hi(w0.z), bf_lo(w0.w), bf_hi(w0.w)};
    v[2] = (f32x4){bf_lo(w1.x), bf_hi(w1.x), bf_lo(w1.y), bf_hi(w1.y)}; v[3] = (f32x4){bf_lo(w1.z), bf_hi(w1.z), bf_lo(w1.w), bf_hi(w1.w)};
}
__device__ __forceinline__ void ln1_row(Frame& F, int layer, int row, int lane, const LRaw& raw, const LAS float* lgl, const f32x4 (&g1)[4], const f32x4 (&sc2)[4], const f32x4 (&sh2)[4], f32x4 (&v)[4]) {
    f32x4 y[4];
    unpack_bf16x16(raw.x0, raw.x1, v); unpack_bf16x16(raw.y0, raw.y1, y);
#pragma unroll
    for (int j = 0; j < 4; ++j) v[j] = DN_ALPHA * v[j] + g1[j] * y[j];
    { f32x4 lg[4], lb[4];
#pragma unroll
      for (int j = 0; j < 4; ++j) { lg[j] = *(const LAS f32x4*)(lgl + 4 * lane + 256 * j); lb[j] = *(const LAS f32x4*)(lgl + 1024 + 4 * lane + 256 * j); }
      layer_norm_row_r(v, lg, lb); }
    st_rowB_bf16(WSP(bf16_t, WS_X1) + (size_t)row * D, lane, v);
    float am = 0.f;
#pragma unroll
    for (int j = 0; j < 4; ++j) { v[j] = v[j] * (1.0f + sc2[j]) + sh2[j]; am = fmaxf(am, fmaxf(fmaxf(fabsf(v[j][0]), fabsf(v[j][1])), fmaxf(fabsf(v[j][2]), fabsf(v[j][3])))); }
    am = wave_max(am); const float qs = am > 0.f ? am * (1.0f / 127.0f) : 1.0f, qi = 1.0f / qs;
    *(u32x4*)(WSP(unsigned char, WS_V2) + (size_t)row * D + 16 * lane) = (u32x4){pack_i8x4(v[0][0] * qi, v[0][1] * qi, v[0][2] * qi, v[0][3] * qi), pack_i8x4(v[1][0] * qi, v[1][1] * qi, v[1][2] * qi, v[1][3] * qi),
        pack_i8x4(v[2][0] * qi, v[2][1] * qi, v[2][2] * qi, v[2][3] * qi), pack_i8x4(v[3][0] * qi, v[3][1] * qi, v[3][2] * qi, v[3][3] * qi)};
    if (lane == 0) WSP(float, WS_V2S)[row] = qs;
}
__device__ __forceinline__ float reduce_scatter32(float (&p)[32], int lane) {
    float q16[16], q8[8], q4[4], q2[2];
    { const bool up = (lane & 32) != 0;
#pragma unroll
      for (int i = 0; i < 16; ++i) { const float keep = up ? p[16 + i] : p[i], send = up ? p[i] : p[16 + i];
          auto rr = __builtin_amdgcn_permlane32_swap(__float_as_uint(send), __float_as_uint(send), false, false); q16[i] = keep + (up ? __uint_as_float(rr[0]) : __uint_as_float(rr[1])); } }
    { const bool up = (lane & 16) != 0;
#pragma unroll
      for (int i = 0; i < 8; ++i) { const float keep = up ? q16[8 + i] : q16[i], send = up ? q16[i] : q16[8 + i]; q8[i] = keep + sx<16>(send); } }
    { const bool up = (lane & 8) != 0;
#pragma unroll
      for (int i = 0; i < 4; ++i) { const float keep = up ? q8[4 + i] : q8[i], send = up ? q8[i] : q8[4 + i]; q4[i] = keep + sx<8>(send); } }
    { const bool up = (lane & 4) != 0;
#pragma unroll
      for (int i = 0; i < 2; ++i) { const float keep = up ? q4[2 + i] : q4[i], send = up ? q4[i] : q4[2 + i]; q2[i] = keep + sx<4>(send); } }
    float r; { const bool up = (lane & 2) != 0; const float keep = up ? q2[1] : q2[0], send = up ? q2[0] : q2[1]; r = keep + sx<2>(send); }
    return r + sx<1>(r);
}
__device__ __forceinline__ void route_token(Frame& F, int row, int lane, float lg, LAS float* ws, volatile LAS int* hist) {
    const int e = (lane >> 1) & 31;
    if ((lane & 1) == 0) ws[e] = lg;
    LDS_WAIT();
    int rank = 0;
#pragma unroll
    for (int q = 0; q < 8; ++q) { const f32x4 o = *(const LAS f32x4*)(ws + 4 * q);
#pragma unroll
        for (int j = 0; j < 4; ++j) { const int e2 = 4 * q + j; rank += (o[j] > lg || (o[j] == lg && e2 < e)) ? 1 : 0; } }
    if (rank < 4 && (lane & 1) == 0) ws[32 + rank] = lg;
    LDS_WAIT();
    const f32x4 tv = *(const LAS f32x4*)(ws + 32);
    const float e1 = __expf(tv[1] - tv[0]), e2 = __expf(tv[2] - tv[0]), e3 = __expf(tv[3] - tv[0]); const float inv = 1.0f / (1.0f + e1 + e2 + e3);
    if (rank < 4 && (lane & 1) == 0) {
        WSP(int, WS_TOPK)[(size_t)row * 4 + rank] = e; WSP(float, WS_GATE)[(size_t)row * 4 + rank] = __expf(lg - tv[0]) * inv;
        int one_ = 1; asm volatile("" : "+v"(one_)); __hip_atomic_fetch_add((LAS int*)(hist + e), one_, __ATOMIC_RELAXED, __HIP_MEMORY_SCOPE_WORKGROUP); }
}
__device__ __forceinline__ void phase_ln1_router(Frame& F, int layer, int nrows, bool count) {
    const int tid = hidden_tid(F.wave), lane = tid & 63;
    LAS float* wt = (LAS float*)F.lds;
    LAS float* wsc = (LAS float*)(F.lds + 131072) + F.wave * 128;
    volatile LAS int* hist = (volatile LAS int*)(F.lds + MISC_OFF + 64);
    const float* Wr = F.in[F.zi + I_RW] + (size_t)layer * 1024 * 32;
    for (int i = tid; i < 32768; i += NTHR) wt[(i & 31) * 1024 + permB(i >> 5)] = Wr[i];
    if (tid < 32) hist[tid] = 0;
    { u32x4* rt = WSP(u32x4, WS_ROWTOK); int gstep = F.G * NTHR; asm volatile("" : "+s"(gstep));
      unsigned zz = 0u; asm volatile("" : "+v"(zz));
#pragma clang loop vectorize(disable) unroll(disable)
      for (int p = F.vcu * NTHR + tid; p < P_MAX / 4; p += gstep) rt[p] = (u32x4){zz, zz, zz, zz}; }
    LAS float* lgl = (LAS float*)(F.lds + 131072 + 4096);
    for (int i = tid; i < 2048; i += NTHR) lgl[(i & 1024) + permB(i & 1023)] = i < 1024 ? F.in[F.zi + I_LN1G][layer * D + i] : F.in[F.zi + I_LN1B][layer * D + i - 1024];
    __syncthreads();
    f32x4 pg1[4], psc[4], psh[4];
    const float rbias = F.in[F.zi + I_RB][layer * 32 + ((lane >> 1) & 31)];
    const int gw = F.vcu * NWAVES + F.wave, NGW = F.G * NWAVES;
    const int npairs = nrows / 2, per = (npairs + NGW - 1) / NGW, p0 = gw * per, p1 = min(npairs, p0 + per);
    int cic = -1;
    LRaw ra, rb;
    if (p0 < p1) { ln1_load(F, 2 * p0, lane, ra); ln1_load(F, 2 * p0 + 1, lane, rb); }
    for (int pr = p0; pr < p1; ++pr) {
        const int ci = cond_of(2 * pr);
        if (ci != cic) { ld_rowB_f32(MODP(layer, ci, 2), lane, pg1); ld_rowB_f32(MODP(layer, ci, 4), lane, psc); ld_rowB_f32(MODP(layer, ci, 3), lane, psh); cic = ci; }
        f32x4 va[4], vb[4];
        ln1_row(F, layer, 2 * pr, lane, ra, lgl, pg1, psc, psh, va); ln1_row(F, layer, 2 * pr + 1, lane, rb, lgl, pg1, psc, psh, vb);
        { const int pn = pr + 1 < p1 ? pr + 1 : pr; ln1_load(F, 2 * pn, lane, ra); ln1_load(F, 2 * pn + 1, lane, rb); }
        float pa[32], pb[32];
#pragma unroll
        for (int e = 0; e < 32; ++e) { f32x2 sa = (f32x2){0.f, 0.f}, sb = sa;
#pragma unroll
            for (int j = 0; j < 4; ++j) { const f32x4 w = *(const LAS f32x4*)(wt + e * 1024 + 4 * lane + 256 * j);
                const f32x2 wl = __builtin_shufflevector(w, w, 0, 1), wh = __builtin_shufflevector(w, w, 2, 3);
                sa = __builtin_elementwise_fma(__builtin_shufflevector(va[j], va[j], 0, 1), wl, sa); sa = __builtin_elementwise_fma(__builtin_shufflevector(va[j], va[j], 2, 3), wh, sa);
                sb = __builtin_elementwise_fma(__builtin_shufflevector(vb[j], vb[j], 0, 1), wl, sb); sb = __builtin_elementwise_fma(__builtin_shufflevector(vb[j], vb[j], 2, 3), wh, sb); }
            pa[e] = sa.x + sa.y; pb[e] = sb.x + sb.y; }
        const float la = reduce_scatter32(pa, lane) + rbias, lbv = reduce_scatter32(pb, lane) + rbias;
        route_token(F, 2 * pr, lane, la, wsc, hist); route_token(F, 2 * pr + 1, lane, lbv, wsc + 64, hist);
    }
    __syncthreads();
    if (tid < 32 && count) { const int hv = hist[tid]; if (hv) __hip_atomic_fetch_add(F.ctl + CW_CNT + layer * 32 + tid, (unsigned)hv, RLX_AGENT); }
}
__device__ __forceinline__ volatile LAS int* moe_tables(Frame& F, int layer) {
    volatile LAS int* ts = (volatile LAS int*)(F.lds + MISC_OFF + 256);
    if (hidden_tid(F.wave) == 0) { int acc = 0; for (int e = 0; e < 32; ++e) { ts[e] = acc; acc += ((int)__hip_atomic_load(F.ctl + CW_CNT + layer * 32 + e, RLX_AGENT) + 255) >> 8; } ts[32] = acc; }
    __syncthreads();
    return ts;
}
__device__ __forceinline__ void phase_assign(Frame& F, int layer, int nrows) {
    const int tid = hidden_tid(F.wave);
    volatile LAS int* ts = moe_tables(F, layer);
    volatile LAS int* lcnt = (volatile LAS int*)(F.lds + MISC_OFF + 512);
    volatile LAS int* lbase = (volatile LAS int*)(F.lds + MISC_OFF + 640);
    if (tid < 32) lcnt[tid] = 0;
    __syncthreads();
    const int chunk = (nrows + F.G - 1) / F.G, r0 = F.vcu * chunk, r1 = min(nrows, r0 + chunk);
    const int* tk = WSP(const int, WS_TOPK);
    int one_ = 1; asm volatile("" : "+v"(one_));
    for (int i = r0 * 4 + tid; i < r1 * 4; i += NTHR) __hip_atomic_fetch_add((LAS int*)(lcnt + tk[i]), one_, __ATOMIC_RELAXED, __HIP_MEMORY_SCOPE_WORKGROUP);
    __syncthreads();
    if (tid < 32) { const int n = lcnt[tid]; int base = ts[tid] * 256; if (n) base += (int)__hip_atomic_fetch_add(F.ctl + CW_CUR + layer * 32 + tid, (unsigned)n, RLX_AGENT); lbase[tid] = base; lcnt[tid] = 0; }
    __syncthreads();
    int* rt = WSP(int, WS_ROWTOK); int* pos = WSP(int, WS_POS); float* sap = WSP(float, WS_SAP); const float* sa = WSP(const float, WS_V2S);
    for (int i = r0 * 4 + tid; i < r1 * 4; i += NTHR) { const int e = tk[i]; const int p = lbase[e] + __hip_atomic_fetch_add((LAS int*)(lcnt + e), one_, __ATOMIC_RELAXED, __HIP_MEMORY_SCOPE_WORKGROUP); rt[p] = i >> 2; pos[i] = p; sap[p] = sa[i >> 2]; }
}
__device__ __forceinline__ void combine_row(Frame& F, int layer, int row, int lane, bool last, bool fp8u, const int4 ps, const f32x4 gt, const f32x4 (&lg)[4], const f32x4 (&lb)[4], const f32x4 (&pg2)[4], const f32x4 (&psc)[4], const f32x4 (&psh)[4]) {
    const int pk[4] = {ps.x, ps.y, ps.z, ps.w};
    f32x4 y[4][4], v[4];
    ld_rowB_bf16(WSP(const bf16_t, WS_X1) + (size_t)row * D, lane, v);
#pragma unroll
    for (int k = 0; k < 4; ++k) ld_rowB_fp8(WSP(const unsigned char, WS_Y2) + (size_t)pk[k] * D, lane, y[k]);
    f32x4 a[4];
#pragma unroll
    for (int j = 0; j < 4; ++j) { a[j] = (gt[0] * y[0][j] + gt[1] * y[1][j]) + (gt[2] * y[2][j] + gt[3] * y[3][j]); v[j] = DN_ALPHA * v[j] + (pg2[j] * (1.0f / Y2_PRESCALE)) * a[j]; }
    layer_norm_row_r(v, lg, lb);
    if (last) { st_rowB_f32(F.out + (size_t)row * D, lane, v); }
    else { st_rowB_bf16(WSP(bf16_t, WS_X) + (size_t)row * D, lane, v);
#pragma unroll
        for (int j = 0; j < 4; ++j) v[j] = v[j] * (1.0f + psc[j]) + psh[j];
        if (fp8u) st_rowB_fp8(WSP(unsigned char, WS_U) + (size_t)row * D, lane, v);
        else st_rowB_bf16(WSP(bf16_t, WS_U) + (size_t)row * D, lane, v); }
}
__device__ __forceinline__ void phase_combine_ln2(Frame& F, int layer, int nrows) {
    const int lane = hidden_tid(F.wave) & 63; const bool last = layer == DEPTH - 1; const bool fp8u = (layer + 1) % 3 != 1;
    f32x4 lg[4], lb[4], pg2[4], psc[4], psh[4]; ld_rowB_f32(F.in[F.zi + I_LN2G] + layer * D, lane, lg); ld_rowB_f32(F.in[F.zi + I_LN2B] + layer * D, lane, lb);
    const int gw = F.vcu * NWAVES + F.wave, NGW = F.G * NWAVES;
    const int npairs = nrows / 2, per = (npairs + NGW - 1) / NGW, p0 = gw * per, p1 = min(npairs, p0 + per);
    const int4* posp = WSP(const int4, WS_POS); const f32x4* gatp = WSP(const f32x4, WS_GATE);
    int cic = -1;
    int4 psa, psb; f32x4 gta, gtb;
    if (p0 < p1) { psa = posp[2 * p0]; psb = posp[2 * p0 + 1]; gta = gatp[2 * p0]; gtb = gatp[2 * p0 + 1]; }
    for (int pr = p0; pr < p1; ++pr) {
        const int ci = cond_of(2 * pr);
        if (ci != cic) { ld_rowB_f32(MODP(layer, ci, 5), lane, pg2); if (!last) { ld_rowB_f32(MODP(layer + 1, ci, 1), lane, psc); ld_rowB_f32(MODP(layer + 1, ci, 0), lane, psh); } cic = ci; }
        const int4 ca = psa, cb = psb; const f32x4 ga = gta, gb = gtb;
        const int pn = pr + 1 < p1 ? pr + 1 : pr;
        psa = posp[2 * pn]; psb = posp[2 * pn + 1]; gta = gatp[2 * pn]; gtb = gatp[2 * pn + 1];
        combine_row(F, layer, 2 * pr, lane, last, fp8u, ca, ga, lg, lb, pg2, psc, psh);
        combine_row(F, layer, 2 * pr + 1, lane, last, fp8u, cb, gb, lg, lb, pg2, psc, psh);
    }
}
__device__ __forceinline__ void phase_dwconv(Frame& F) {
    const int tid = hidden_tid(F.wave), lane = tid & 63, wave = __builtin_amdgcn_readfirstlane(tid >> 6);
    LAS unsigned* tile = (LAS unsigned*)F.lds;
    LAS float* red = (LAS float*)(F.lds + 126976);
    const float* wdw = F.in[F.zi + I_CWDW]; f32x2 wv[31];
#pragma unroll
    for (int j = 0; j < 31; ++j) { unsigned bo = (unsigned)(j * D + 2 * tid) * 4u; asm volatile("" : "+v"(bo));
        wv[j] = *(const f32x2*)((const char*)wdw + bo); }
    const f32x2 bdw = *(const f32x2*)(F.in[F.zi + I_CBDW] + 2 * tid), lng = *(const f32x2*)(F.in[F.zi + I_CLNG] + 2 * tid), lnb = *(const f32x2*)(F.in[F.zi + I_CLNB] + 2 * tid);
    const bf16_t* Gin = WSP(const bf16_t, WS_G); unsigned char* outp = WSP(unsigned char, WS_MIX);
    for (int un = F.vcu; un < 1024 + 64; un += F.G) {
        int seq0, slen, t0;
        if (un < 1024) { seq0 = (un >> 7) * SEQ; slen = SEQ; t0 = (un & 127) * 32; } else { const int q = un - 1024; seq0 = T_LAT + (q >> 3) * CTXL; slen = CTXL; t0 = (q & 7) * 32; }
        __syncthreads();
#pragma unroll 1
        for (int i = tid; i < 62 * 128; i += NTHR) { const int r = i >> 7, ch = i & 127, t = t0 - 15 + r; u32x4 v = (u32x4){0u, 0u, 0u, 0u};
            if (t >= 0 && t < slen) v = *(const u32x4*)(Gin + (size_t)(seq0 + t) * D + ch * 8);
            *(LAS u32x4*)(tile + r * 512 + ch * 4) = v; }
        __syncthreads();
        for (int hf = 0; hf < 2; ++hf) {
            f32x2 ov[16];
#pragma unroll
            for (int t = 0; t < 16; ++t) ov[t] = bdw;
            const LAS unsigned* tp = tile + hf * 16 * 512 + tid;
#pragma unroll
            for (int r = 0; r < 46; ++r) { const unsigned w = tp[r * 512]; const f32x2 xv = (f32x2){bf_lo(w), bf_hi(w)};
#pragma unroll
                for (int t = 0; t < 16; ++t) { const int j = r - t; if (j >= 0 && j < 31) ov[t] = __builtin_elementwise_fma(wv[j], xv, ov[t]); }
                if ((r & 7) == 7) __builtin_amdgcn_sched_barrier(0); }
            float o0[16], o1[16];
#pragma unroll
            for (int t = 0; t < 16; ++t) { o0[t] = ov[t].x; o1[t] = ov[t].y; }
#pragma unroll
            for (int t = 0; t < 16; ++t) { float s = o0[t] + o1[t], q = o0[t] * o0[t] + o1[t] * o1[t]; s = wave_sum(s); q = wave_sum(q);
                if (lane == 0) { red[(wave * 16 + t) * 2] = s; red[(wave * 16 + t) * 2 + 1] = q; } }
            __syncthreads();
#pragma unroll
            for (int t = 0; t < 16; t += 2) { unsigned pk2[2];
#pragma unroll
                for (int u = 0; u < 2; ++u) { float s = 0.f, q = 0.f;
#pragma unroll
                    for (int w = 0; w < 8; ++w) { s += red[(w * 16 + t + u) * 2]; q += red[(w * 16 + t + u) * 2 + 1]; }
                    const float mean = s * (1.0f / D), var = fmaxf(q * (1.0f / D) - mean * mean, 0.f), rstd = rsqrtf(var + ln_eps());
                    const float a0 = (o0[t + u] - mean) * rstd * lng.x + lnb.x, a1 = (o1[t + u] - mean) * rstd * lng.y + lnb.y;
                    pk2[u] = pack_fp8x4(a0 * fast_sigmoid(a0) * MIX_PRESCALE, a1 * fast_sigmoid(a1) * MIX_PRESCALE, 0.f, 0.f) & 0xffffu; }
                const bool odd = (tid & 1) != 0;
                const unsigned got = __float_as_uint(sx<1>(__uint_as_float(odd ? pk2[0] : pk2[1])));
                const unsigned word = odd ? (got | (pk2[1] << 16)) : (pk2[0] | (got << 16));
                *(unsigned*)(outp + (size_t)(seq0 + t0 + hf * 16 + t + (odd ? 1 : 0)) * D + 2 * (tid & ~1)) = word; }
            __syncthreads();
        }
    }
}
constexpr int NPHASE = 2 + 8 * DEPTH;
__global__ void __launch_bounds__(NTHR, 2) fwd(Args args) {
    extern __shared__ __attribute__((aligned(16))) unsigned char lds_raw[];
    Frame F;
    F.lds = (LAS unsigned char*)lds_raw; F.MISC = (volatile LAS unsigned*)(F.lds + MISC_OFF);
    F.tid = threadIdx.x; F.lane = F.tid & 63; F.wave = __builtin_amdgcn_readfirstlane(F.tid >> 6);
    F.G = gridDim.x; { const int bx = blockIdx.x; F.vcu = (F.G % 8 == 0) ? (bx % 8) * (F.G / 8) + bx / 8 : bx; }
    F.ws = args.ws; F.ctl = (unsigned*)(args.ws + WS_CTL); F.in = args.in; F.out = args.out; F.zi = 0;
    for (int u = F.tid; u < 512; u += NTHR) ((LAS unsigned*)(F.lds + MISC_OFF))[u] = 0u;
    __syncthreads();

    const int lo = args.ph_lo, hi = args.ph_hi;
    XcdBarrier bar; bar.bar = F.ctl + CW_BAR; bar.x = 0; bar.st = nullptr;
    if (hi - lo > 1) bar = xcd_barrier_post(F.ctl + CW_BAR, F.MISC);
#define IN(k) (lo <= (k) && (k) < hi)
#define SEAM(k) do { if (IN(k) && IN((k) + 1)) xcd_barrier(bar, F.wave); } while (0)
    int bx = (int)blockIdx.x; const int vcu0 = F.vcu, wave0 = F.wave; const unsigned xcc0 = bar.x;

    if (EN(0) && IN(0)) { for (int rep = 0; rep < NREP(0); ++rep) { __syncthreads(); p0_prologue(F); } } SEAM(0);
    if (EN(1) && IN(1)) { for (int rep = 0; rep < NREP(1); ++rep) { __syncthreads(); p1_modulate(F); } } SEAM(1);

    for (int layer = 0; layer < DEPTH; ++layer) {
        {
            const int z_ = __builtin_amdgcn_readfirstlane((int)F.MISC[2]);
            F.zi = z_; F.ws = args.ws + z_; F.out = args.out + z_; F.ctl = (unsigned*)(F.ws + WS_CTL); bar.bar = F.ctl + CW_BAR;
            F.G = (int)gridDim.x + z_; F.vcu = vcu0 + z_; bx = (int)blockIdx.x + z_; F.lds = (LAS unsigned char*)lds_raw + z_; F.MISC = (volatile LAS unsigned*)(F.lds + MISC_OFF); bar.st = F.MISC; bar.x = xcc0 + (unsigned)z_; F.wave = wave0 + z_; }
        const int pb = 2 + 8 * layer, kind = layer % 3, jj = layer / 3; const bool last = layer == DEPTH - 1;
        const int nrows = last ? T_LAT : T_ALL;
        if (IN(pb + 0)) for (int rep = 0; rep < NREP(kind == 0 ? 2 : (kind == 1 ? 3 : 4)); ++rep) {
            if (EN(2) && kind == 0) {
                const unsigned char* W8 = WSP(const unsigned char, WS_WQKV) + (size_t)jj * 3072 * 1024; const float* sw = WSP(const float, WS_WQKVS) + jj * 3072;
                { DenseSched S; S.init8(WSP(const unsigned char, WS_U), W8, T_ALL, 2048, 1024, 1024, F.G, bx);
                  EpiQK8 E{WSP(unsigned char, WS_Q), WSP(const float, WS_ROPE), sw};
                  g8::gemm_phase(F.lds, S, E, F.wave); }
                { VtSched S; S.init(W8 + (size_t)2048 * 1024, WSP(const unsigned char, WS_U), F.G, bx);
                  EpiVt8 E{WSP(unsigned char, WS_V), sw + 2048};
                  g8::gemm_phase(F.lds, S, E, F.wave); }
            } else if (EN(3) && kind == 1) {
                F1Sched S; S.init(WSP(const bf16_t, WS_ACS), WSP(const bf16_t, WS_U), F.G, bx);
                EpiFp8T<0> E{WSP(unsigned char, WS_YT), 8192, 1.0f};
                g8::gemm_phase(F.lds, S, E, F.wave);
            } else if (EN(4) && kind == 2) {
                GatedSched S; S.init8(WSP(const unsigned char, WS_U), WSP(const unsigned char, WS_PW1), T_ALL, 1024, 1024, 1024, F.G, bx);
                EpiGlu8 E{WSP(bf16_t, WS_G), 1024, F.in[F.zi + I_CBPW1], WSP(const float, WS_PW1S), 1024};
                g8::gemm_phase(F.lds, S, E, F.wave);
            }
        }
        SEAM(pb + 0);
        if (IN(pb + 1)) for (int rep = 0; rep < NREP(kind == 0 ? 5 : (kind == 1 ? 6 : 7)); ++rep) {
            if (EN(5) && kind == 0) {
                const float li = 0.8f - 0.6f * __expf(-0.3f * (float)layer);
                const int ln_ = hidden_tid(F.wave) & 63; const float d1 = wave_sum(F.in[F.zi + I_LQ1][jj * 64 + ln_] * F.in[F.zi + I_LK1][jj * 64 + ln_]), d2 = wave_sum(F.in[F.zi + I_LQ2][jj * 64 + ln_] * F.in[F.zi + I_LK2][jj * 64 + ln_]);
                att::Params P{WSP(const unsigned char, WS_Q), WSP(const unsigned char, WS_K), WSP(const unsigned char, WS_V), WSP(unsigned char, WS_MIX), WSP(float, WS_ASCR), F.in[F.zi + I_SUBLN] + jj * 128, __expf(d1) - __expf(d2) + li, (1.0f - li) * MIX_PRESCALE, F.wave};
                const int nun = last ? 1024 : 1024 + 64;
#if ATT_PROBE
                for (int un = F.vcu; un < nun; un += F.G) {
                    int b, h, q0, tb;
                    if (un < 1024) { b = un >> 7; h = (un >> 4) & 7; q0 = b * SEQ + (un & 15) * 256; tb = 0; } else { const int q = un - 1024; b = q >> 3; h = q & 7; q0 = T_LAT + b * CTXL; tb = 64; }
                    for (int c = 0; c < 2; ++c) att::unit<8, ATT_PROBE>(P, b, h, c, q0, tb, 68, F.lds);
                }
                __syncthreads();
#endif
                for (int un = F.vcu; un < nun; un += F.G) {
                    int b, h, q0, tb;
                    if (un < 1024) { b = un >> 7; h = (un >> 4) & 7; q0 = b * SEQ + (un & 15) * 256; tb = 0; } else { const int q = un - 1024; b = q >> 3; h = q & 7; q0 = T_LAT + b * CTXL; tb = 64; }
                    for (int c = 0; c < 2; ++c) att::unit<8>(P, b, h, c, q0, tb, 68, F.lds);
                }
            } else if (EN(6) && kind == 1) {
                F2Sched S; S.init(WSP(const unsigned char, WS_DFTN), WSP(const unsigned char, WS_YT), F.G, bx); EpiFp8T<2> E{WSP(unsigned char, WS_MIX), 1024, MIX_PRESCALE / DFT_PRESCALE}; g8::gemm_phase(F.lds, S, E, F.wave);
            } else if (EN(7) && kind == 2) {
                __syncthreads(); phase_dwconv(F);
            }
        }
        SEAM(pb + 1);
        if (EN(8) && IN(pb + 2)) for (int rep = 0; rep < NREP(8); ++rep) {
            const unsigned char* Bt = WSP(const unsigned char, 0) + (kind == 0 ? WS_WO + (size_t)jj * 1024 * 1024 : (kind == 1 ? WS_WF : WS_PW2));
            const float* wsc = WSP(const float, WS_WZS) + (kind == 0 ? jj : kind + 1) * 1024;
            const float* bias = kind == 0 ? (const float*)(F.ws + WS_CTL + 524288) : (kind == 1 ? F.in[F.zi + I_FB] : F.in[F.zi + I_CBPW2]);
            DenseSched S; S.init8(WSP(const unsigned char, WS_MIX), Bt, nrows, 1024, 1024, 1024, F.G, bx);
            EpiBf16T<2> E{WSP(bf16_t, WS_Y), 1024, bias, 0, wsc, 1.0f / MIX_PRESCALE};
            g8::gemm_phase(F.lds, S, E, F.wave);
        }
        SEAM(pb + 2);
        if (EN(9) && IN(pb + 3)) { for (int rep = 0; rep < NREP(9); ++rep) { __syncthreads(); phase_ln1_router(F, layer, nrows, rep == 0); } } SEAM(pb + 3);
        if (EN(10) && IN(pb + 4)) { phase_assign(F, layer, nrows); } SEAM(pb + 4);
        if (EN(11) && IN(pb + 5)) for (int rep = 0; rep < NREP(11); ++rep) {
            volatile LAS int* ts = MK_MULTI ? moe_tables(F, layer) : (volatile LAS int*)(F.lds + MISC_OFF + 256);
            MoeSched<true> S; S.init(WSP(const char, WS_V2), WSP(const char, WS_W1) + (size_t)layer * 32 * 2048 * 1024, WSP(const int, WS_ROWTOK), ts, F.G, bx, F.wave);
            EpiGatedI8 E{WSP(unsigned char, WS_H), F.in[F.zi + I_MB1] + (size_t)layer * 32 * 2048, WSP(const float, WS_W1S) + (size_t)layer * 32 * 2048, WSP(const float, WS_SAP)};
#if MOE_PROBE
            { EpiGatedI8T<(MOE_PROBE >> 4)> EP{E.O, E.bias, E.sw, E.sap};
              g8::gemm_phase<EpiGatedI8T<(MOE_PROBE >> 4)>, MoeSched<true>, (MOE_PROBE & 15)>(F.lds, S, EP, F.wave); __syncthreads(); }
#endif
            g8::gemm_phase(F.lds, S, E, F.wave);
        }
        SEAM(pb + 5);
        if (EN(12) && IN(pb + 6)) for (int rep = 0; rep < NREP(12); ++rep) {
            volatile LAS int* ts = MK_MULTI ? moe_tables(F, layer) : (volatile LAS int*)(F.lds + MISC_OFF + 256);
            MoeSched<false> S; S.init(WSP(const char, WS_H), WSP(const char, WS_W2) + (size_t)layer * 32 * 1024 * 1024, nullptr, ts, F.G, bx, F.wave);
            EpiY2 E{WSP(unsigned char, WS_Y2), F.in[F.zi + I_MB2] + (size_t)layer * 32 * 1024, WSP(const float, WS_W2S) + (size_t)layer * 32 * 1024};
            g8::gemm_phase(F.lds, S, E, F.wave);
        }
        SEAM(pb + 6);
        if (EN(13) && IN(pb + 7)) { for (int rep = 0; rep < NREP(13); ++rep) { __syncthreads(); phase_combine_ln2(F, layer, nrows); } } SEAM(pb + 7);
    }
#undef IN
#undef SEAM
}

extern "C" void kernel_launch(void* const* d_in, const int* in_sizes, int n_in, void* d_out, int out_size, void* d_ws, size_t ws_size, hipStream_t stream) {
    static int grid = 0;
    if (grid == 0) {
        if (n_in != 33 || out_size != T_LAT * D || ws_size < WS_END) { fprintf(stderr, "kernel_launch: unexpected shapes (n_in %d, out %d, ws %zu < %zu); nothing launched\n", n_in, out_size, ws_size, (size_t)WS_END); grid = -1; return; }
        int dev = 0, cus = 0, per_cu = 0;
        if (hipGetDevice(&dev) != hipSuccess || hipDeviceGetAttribute(&cus, hipDeviceAttributeMultiprocessorCount, dev) != hipSuccess) { grid = -1; return; }
        if (hipFuncSetAttribute((const void*)fwd, hipFuncAttributeMaxDynamicSharedMemorySize, LDS_BYTES) != hipSuccess) { fprintf(stderr, "kernel_launch: hipFuncSetAttribute failed\n"); grid = -1; return; }
        if (hipOccupancyMaxActiveBlocksPerMultiprocessor(&per_cu, (const void*)fwd, NTHR, LDS_BYTES) != hipSuccess || per_cu < 1) fprintf(stderr, "kernel_launch: occupancy query says %d blocks per CU\n", per_cu);
        (void)hipGetLastError();
        grid = cus < 256 ? cus : 256;
    }
    if (grid < 0) return;
    if (hipMemsetAsync((char*)d_ws + WS_CTL, 0, CTL_ZERO_BYTES, stream) != hipSuccess) return;
    Args a{};
    for (int i = 0; i < 33; ++i) a.in[i] = (const float*)d_in[i];
    a.out = (float*)d_out; a.ws = (unsigned char*)d_ws;
#if MK_MULTI
    for (int p = 0; p < NPHASE; ++p) { a.ph_lo = p; a.ph_hi = p + 1; hipLaunchKernelGGL(fwd, dim3(grid), dim3(NTHR), LDS_BYTES, stream, a); }
#else
    a.ph_lo = 0; a.ph_hi = NPHASE;
    hipLaunchKernelGGL(fwd, dim3(grid), dim3(NTHR), LDS_BYTES, stream, a);
#endif
    const hipError_t le = hipPeekAtLastError();
    if (le != hipSuccess) fprintf(stderr, "kernel_launch: launch failed: %s\n", hipGetErrorName(le));
}
```

```cpp
#include <hip/hip_runtime.h>
#include <cstdio>
#include <cstdint>

#ifndef MK_MULTI
#define MK_MULTI 0
#endif
#ifndef PH_MASK
#define PH_MASK 0xffffffffu
#endif
#define EN(k) (((PH_MASK) >> (k)) & 1u)
#ifndef REP_MASK
#define REP_MASK 0u
#endif
#ifndef MOE_PROBE
#define MOE_PROBE 0
#endif
#ifndef ATT_GSH
#define ATT_GSH 0
#endif
#ifndef ATT_PROBE
#define ATT_PROBE 0
#endif
#define NREP(k) ((((REP_MASK) >> (k)) & 1u) ? 2 : 1)

#define LAS __attribute__((address_space(3)))
#define GAS __attribute__((address_space(1)))
typedef unsigned short bf16_t;
typedef short bf16x8 __attribute__((ext_vector_type(8)));
typedef short s16x4 __attribute__((ext_vector_type(4)));
typedef float f32x2 __attribute__((ext_vector_type(2)));
typedef float f32x4 __attribute__((ext_vector_type(4)));
typedef float f32x16 __attribute__((ext_vector_type(16)));
typedef unsigned u32x2 __attribute__((ext_vector_type(2)));
typedef unsigned u32x4 __attribute__((ext_vector_type(4)));
typedef int i32x4 __attribute__((ext_vector_type(4)));
typedef int i32x8 __attribute__((ext_vector_type(8)));

constexpr int D = 1024, NB = 8, SEQ = 4096, CTXL = 256, DEPTH = 4;
constexpr int T_LAT = NB * SEQ, T_CTX = NB * CTXL, T_ALL = T_LAT + T_CTX;
constexpr int NE = 32, TOPK = 4, P_MAX = 147456;
constexpr float LN_EPS = 1e-5f;
constexpr float DN_ALPHA = 1.6817928305074290f;
constexpr float ATT_C2 = 0.125f * 1.4426950408889634f;
constexpr int NWAVES = 8, NTHR = 512;
constexpr float H_PRESCALE = 7.5f, FP8_TOP = 440.0f, Q_PRESCALE = 16.0f;
constexpr float MIX_PRESCALE = 1.0f;
constexpr float Y2_PRESCALE = 16.0f;
constexpr float DFT_PRESCALE = 64.0f;
constexpr int VT_PITCH = 4352;

constexpr size_t MiB = 1u << 20;
constexpr size_t WS_CTL = 0, CTL_ZERO_BYTES = 1 * MiB;
constexpr size_t WS_MOD = 1 * MiB;
constexpr size_t WS_ROPE = 2 * MiB;
constexpr size_t WS_ACS = 2 * MiB + 65536;
constexpr size_t WS_DFTN = 4 * MiB;
constexpr size_t WS_WQKV = 72 * MiB;
constexpr size_t WS_WO = 84 * MiB;
constexpr size_t WS_WF = 88 * MiB;
constexpr size_t WS_PW1 = 90 * MiB;
constexpr size_t WS_PW2 = 94 * MiB;
constexpr size_t WS_W1 = 96 * MiB;
constexpr size_t WS_W2 = 608 * MiB;
constexpr size_t WS_X = 864 * MiB;
constexpr size_t WS_X1 = 1000 * MiB;
constexpr size_t WS_U = 1136 * MiB;
constexpr size_t WS_Q = 1204 * MiB, WS_K = 1272 * MiB, WS_V = 1340 * MiB;
constexpr size_t WS_MIX = 1408 * MiB;
constexpr size_t WS_Y = 1476 * MiB;
constexpr size_t WS_V2 = 1544 * MiB;
constexpr size_t WS_G = 1612 * MiB;
constexpr size_t WS_YT = 1680 * MiB;
constexpr size_t WS_YTC = 1808 * MiB;
constexpr size_t WS_H = 1936 * MiB;
constexpr size_t WS_Y2 = 2224 * MiB;
constexpr size_t WS_TOPK = 2512 * MiB;
constexpr size_t WS_GATE = 2513 * MiB;
constexpr size_t WS_POS = 2514 * MiB;
constexpr size_t WS_ROWTOK = 2515 * MiB;
constexpr size_t WS_ASCR = 2516 * MiB;
constexpr size_t WS_W1S = 2548 * MiB;
constexpr size_t WS_V2S = 2549 * MiB;
constexpr size_t WS_W2S = 2550 * MiB;
constexpr size_t WS_WQKVS = 2551 * MiB;
constexpr size_t WS_PW1S = 2551 * MiB + 65536;
constexpr size_t WS_WZS = 2551 * MiB + 131072;
constexpr size_t WS_SAP = 2552 * MiB;
constexpr size_t WS_END = 2553 * MiB;
constexpr int CW_TMO = 0, CW_BAR = 4096, CW_CNT = 16384, CW_CUR = 16384 + 1024;

constexpr int LDS_BYTES = 147456;
constexpr int RING_BYTES = 131072;
constexpr int MISC_OFF = LDS_BYTES - 2048;

#define RLX_AGENT __ATOMIC_RELAXED, __HIP_MEMORY_SCOPE_AGENT
#define LDS_WAIT() asm volatile("s_waitcnt lgkmcnt(0)" ::: "memory")
#define VM_WAIT() asm volatile("s_waitcnt vmcnt(0)" ::: "memory")
__device__ __forceinline__ unsigned cvt_pk_bf16(float lo, float hi) { unsigned r; asm volatile("v_cvt_pk_bf16_f32 %0, %1, %2" : "=v"(r) : "v"(lo), "v"(hi)); return r; }
__device__ __forceinline__ float bf_lo(unsigned w) { return __uint_as_float(w << 16); }
__device__ __forceinline__ float bf_hi(unsigned w) { return __uint_as_float(w & 0xffff0000u); }
template <int M> __device__ __forceinline__ float sx(float v) { return __int_as_float(__builtin_amdgcn_ds_swizzle(__float_as_int(v), 0x1f | (M << 10))); }
__device__ __forceinline__ float sum32x(float v) { auto rr = __builtin_amdgcn_permlane32_swap(__float_as_uint(v), __float_as_uint(v), false, false); return __uint_as_float(rr[0]) + __uint_as_float(rr[1]); }
__device__ __forceinline__ float wave_max(float v) { v = fmaxf(v, sx<1>(v)); v = fmaxf(v, sx<2>(v)); v = fmaxf(v, sx<4>(v)); v = fmaxf(v, sx<8>(v)); v = fmaxf(v, sx<16>(v));
    auto rr = __builtin_amdgcn_permlane32_swap(__float_as_uint(v), __float_as_uint(v), false, false); return fmaxf(__uint_as_float(rr[0]), __uint_as_float(rr[1])); }
__device__ __forceinline__ unsigned pack_i8x4(float a, float b, float c, float d) {
    int hi_ = 127, lo_ = -127; asm volatile("" : "+s"(hi_), "+s"(lo_));
    const int ia = max(lo_, min(hi_, __float2int_rn(a))), ib = max(lo_, min(hi_, __float2int_rn(b))), ic = max(lo_, min(hi_, __float2int_rn(c))), id = max(lo_, min(hi_, __float2int_rn(d)));
    return (unsigned)(ia & 255) | ((unsigned)(ib & 255) << 8) | ((unsigned)(ic & 255) << 16) | ((unsigned)id << 24); }
__device__ __forceinline__ unsigned pack_i8x4_fast(float a, float b, float c, float d, float q) {
    float mg = 12582912.0f; asm volatile("" : "+s"(mg));
    const unsigned ta = __float_as_uint(__builtin_fmaf(a, q, mg)), tb = __float_as_uint(__builtin_fmaf(b, q, mg)), tc = __float_as_uint(__builtin_fmaf(c, q, mg)), td = __float_as_uint(__builtin_fmaf(d, q, mg));
    return __builtin_amdgcn_perm(tb, ta, 0x0c0c0400u) | __builtin_amdgcn_perm(td, tc, 0x04000c0cu);
}
__device__ __forceinline__ unsigned pack_fp8x4(float a, float b, float c, float d) { int w = 0; w = __builtin_amdgcn_cvt_pk_fp8_f32(a, b, w, false); w = __builtin_amdgcn_cvt_pk_fp8_f32(c, d, w, true); return (unsigned)w; }
__device__ __forceinline__ float wave_sum(float v) { v += sx<1>(v); v += sx<2>(v); v += sx<4>(v); v += sx<8>(v); v += sx<16>(v); return sum32x(v); }
__device__ __forceinline__ float ln_eps() { float e = LN_EPS; asm volatile("" : "+s"(e)); return e; }
__device__ __forceinline__ int hidden_tid(int wave) { int l; asm volatile("v_mbcnt_lo_u32_b32 %0, -1, 0\n\tv_mbcnt_hi_u32_b32 %0, -1, %0" : "=v"(l)); return wave * 64 + l; }
__device__ __forceinline__ float fast_sigmoid(float x) { return __builtin_amdgcn_rcpf(1.0f + __builtin_amdgcn_exp2f(-1.4426950408889634f * x)); }

#define XB_TMO      128
#define XB_XCNT(j)  (256  + 64 * (j))
#define XB_XSUB(j)  (1280 + 64 * (j))
#define XB_XGEN(j)  (2304 + 64 * (j))
#define XB_TOP      3328
#define XB_TOPGEN   3392
#define XCD_BAR_WORDS 3456
#define XB_SPIN_CAP (1u << 18)
__device__ __forceinline__ unsigned xb_ld(unsigned* p)              { return __hip_atomic_load(p, __ATOMIC_RELAXED, __HIP_MEMORY_SCOPE_AGENT); }
__device__ __forceinline__ unsigned xb_add(unsigned* p, unsigned v) { return __hip_atomic_fetch_add(p, v, __ATOMIC_RELAXED, __HIP_MEMORY_SCOPE_AGENT); }
__device__ __forceinline__ unsigned xb_xcc_id() { return (unsigned)__builtin_amdgcn_s_getreg((3 << 11) | 20) & 0xFu; }
#define XB_SPIN(cond, bar) do { unsigned _sp = 0; while (cond) { __builtin_amdgcn_s_sleep(1); \
    if ((++_sp & 255u) == 0u) { if (xb_ld(&(bar)[XB_TMO])) break; if (_sp > XB_SPIN_CAP) { atomicAdd(&(bar)[XB_TMO], 1u); break; } } } } while (0)
struct XcdBarrier { unsigned* bar; unsigned x; volatile LAS unsigned* st; };
__device__ __forceinline__ XcdBarrier xcd_barrier_post(unsigned* bar, volatile LAS unsigned* st) {
    XcdBarrier b; b.bar = bar; b.x = xb_xcc_id(); b.st = st;
    if (threadIdx.x == 0) (void)xb_add(&bar[XB_XCNT(b.x)], 1u);
    return b;
}
__device__ __forceinline__ void xcd_barrier_complete(unsigned* bar, unsigned x, unsigned& nloc, unsigned& nx) {
    const unsigned G = gridDim.x * gridDim.y * gridDim.z;
    unsigned sum, cnt, mine, sp = 0u;
    for (;;) {
        sum = 0u; cnt = 0u; mine = 0u;
#pragma unroll
        for (unsigned j = 0; j < 16; ++j) { const unsigned c = xb_ld(&bar[XB_XCNT(j)]); sum += c; cnt += (c > 0u) ? 1u : 0u; mine = (j == x) ? c : mine; }
        if (sum == G) break;
        __builtin_amdgcn_s_sleep(1);
        if ((++sp & 255u) == 0u) { if (xb_ld(&bar[XB_TMO])) break; if (sp > XB_SPIN_CAP) { atomicAdd(&bar[XB_TMO], 1u); break; } }
    }
    nloc = mine > 0u ? mine : 1u; nx = cnt > 0u ? cnt : 1u;
}
__device__ __forceinline__ void xcd_barrier(const XcdBarrier& b, int wave_) {
    asm volatile("s_waitcnt vmcnt(0)" ::: "memory");
    __syncthreads();
    if (hidden_tid(wave_) == 0) {
        unsigned* bar = b.bar;
        __builtin_amdgcn_s_waitcnt(0);
        unsigned nloc = b.st[0], nx = b.st[1];
        if (nloc == 0u) { xcd_barrier_complete(bar, b.x, nloc, nx); b.st[0] = nloc; b.st[1] = nx; }
        const unsigned old = xb_add(&bar[XB_XSUB(b.x)], 1u);
        const unsigned gen = old / nloc;
        if (old + 1u == (gen + 1u) * nloc) {
            __builtin_amdgcn_fence(__ATOMIC_RELEASE, "agent");
            asm volatile("s_waitcnt vmcnt(0)" ::: "memory");
            const unsigned og = xb_add(&bar[XB_TOP], 1u);
            const unsigned tg = og / nx;
            if (og + 1u == (tg + 1u) * nx) xb_add(&bar[XB_TOPGEN], 1u);
            else XB_SPIN(xb_ld(&bar[XB_TOPGEN]) == tg, bar);
            __builtin_amdgcn_fence(__ATOMIC_ACQUIRE, "agent");
            xb_add(&bar[XB_XGEN(b.x)], 1u);
            asm volatile("s_waitcnt vmcnt(0)" ::: "memory");
        } else {
            XB_SPIN(xb_ld(&bar[XB_XGEN(b.x)]) == gen, bar);
            __builtin_amdgcn_fence(__ATOMIC_ACQUIRE, "agent");
            asm volatile("s_waitcnt vmcnt(0)" ::: "memory");
        }
    }
    __syncthreads();
}

namespace g8 {
constexpr int BM = 256, BK = 64, HALF = 128, HTB = HALF * BK * 2, NXCD = 8, WGM = 8, PF_OFF = 8 * HTB, PF_BLK = 3072;
__host__ __device__ __forceinline__ int lds_byte(int r, int c) { const int st = (r >> 4) * 2 + (c >> 5), rr = r & 15, cc = c & 31, ob = rr * 64 + cc * 2; return st * 1024 + (ob ^ (((ob >> 9) & 1) << 5)); }
__host__ __device__ __forceinline__ void stage_rc(int b, int& R, int& C) { const int st = b / 1024, sb = b % 1024, swz = sb ^ (((sb >> 9) & 1) << 5); R = (st >> 1) * 16 + swz / 64; C = (st & 1) * 32 + (swz % 64) / 2; }
__host__ __device__ __forceinline__ int perm32(int rho) { const int n = rho >> 4, i = rho & 15; return 8 * (i >> 2) + 4 * n + (i & 3); }

struct GU { unsigned a, b, ooff; int row0, col0, aux; };

struct DenseOrder {
    int nM, nN, nwg, G, c;
    __device__ __forceinline__ void init(int M, int N, int G_, int c_) { nM = M / BM; nN = N / BM; nwg = nM * nN; G = G_; c = c_; }
    __device__ __forceinline__ bool tile(int i, int& pm, int& pn) const {
        const long L = (long)i * G + c; if (L >= nwg) return false;
        int wgid = (int)L; { const int q = nwg / NXCD, r = nwg % NXCD, xcd = wgid % NXCD, off = wgid / NXCD; wgid = (xcd < r ? xcd * (q + 1) : r * (q + 1) + (xcd - r) * q) + off; }
        const int nig = WGM * nN, gid = wgid / nig, fm = gid * WGM, gsz = (nM - fm) < WGM ? (nM - fm) : WGM;
        pm = fm + ((wgid % nig) % gsz); pn = (wgid % nig) / gsz; return true;
    }
};

template <int MODE> struct Mma;
template <> struct Mma<0> { typedef f32x4 acc_t; static __device__ __forceinline__ f32x4 run(const bf16x8 (&a)[2], const bf16x8 (&b)[2], f32x4 c, int) {
    c = __builtin_amdgcn_mfma_f32_16x16x32_bf16(a[0], b[0], c, 0, 0, 0); return __builtin_amdgcn_mfma_f32_16x16x32_bf16(a[1], b[1], c, 0, 0, 0); } };
template <> struct Mma<1> { typedef i32x4 acc_t; static __device__ __forceinline__ i32x4 run(const bf16x8 (&a)[2], const bf16x8 (&b)[2], i32x4 c, int) {
    c = __builtin_amdgcn_mfma_i32_16x16x64_i8(__builtin_bit_cast(i32x4, a[0]), __builtin_bit_cast(i32x4, b[0]), c, 0, 0, 0); return __builtin_amdgcn_mfma_i32_16x16x64_i8(__builtin_bit_cast(i32x4, a[1]), __builtin_bit_cast(i32x4, b[1]), c, 0, 0, 0); } };
template <> struct Mma<2> { typedef f32x4 acc_t; static __device__ __forceinline__ f32x4 run(const bf16x8 (&a)[2], const bf16x8 (&b)[2], f32x4 c, int sc1) {
    const i32x4 a0 = __builtin_bit_cast(i32x4, a[0]), a1 = __builtin_bit_cast(i32x4, a[1]), b0 = __builtin_bit_cast(i32x4, b[0]), b1 = __builtin_bit_cast(i32x4, b[1]);
    const i32x8 av = (i32x8){a0[0], a0[1], a0[2], a0[3], a1[0], a1[1], a1[2], a1[3]}, bv = (i32x8){b0[0], b0[1], b0[2], b0[3], b1[0], b1[1], b1[2], b1[3]};
    return __builtin_amdgcn_mfma_scale_f32_16x16x128_f8f6f4(av, bv, c, 0, 0, 0, sc1, 0, sc1); } };
template <class Epi, class Sched, int PROBE = 0>
__device__ __forceinline__ void gemm_phase(LAS unsigned char* lds, const Sched& S, const Epi& E, int wave_) {
    typedef typename Mma<Epi::MODE>::acc_t acc_t;
    int mxs = 0x7f7f7f7f; asm volatile("" : "+v"(mxs));
    constexpr bool GATHER = Sched::GATHER;
    const int tid = hidden_tid(wave_), wid = wave_, lane = tid & 63, wr = wid >> 2, wc = wid & 3, fr = lane & 15, fq = lane >> 4;
    unsigned voffA[2], voffB[2]; int RA[2];
#pragma unroll
    for (int i = 0; i < 2; ++i) { int R, C; stage_rc(tid * 16 + i * 8192, R, C); const int Rb = Epi::PERM ? ((R & ~31) + perm32(R & 31)) : R;
        voffA[i] = (GATHER ? 0u : (unsigned)R * S.lda) + (unsigned)C * 2u; voffB[i] = (unsigned)Rb * S.ldb + (unsigned)C * 2u; RA[i] = R; }
    constexpr unsigned kstep = (unsigned)(BK * 2);
    const unsigned hsA = GATHER ? 0u : S.hstepA, hsB = S.hstepB;
    const unsigned ldsw = (unsigned)wid * 1024u;
    const unsigned ldsb = (unsigned)(unsigned long)lds + ldsw;
    const int aoff = lds_byte(wr * 64 + fr, fq * 8), boff = lds_byte(wc * 32 + fr, fq * 8);
    const char* const Ab = S.A; const char* const Bb = S.Bt;
#define G8_SA(b, h) (((b) * 2 + (h)) * HTB)
#define G8_SB(b, h) ((4 + (b) * 2 + (h)) * HTB)
#define G8_STAGE(bufoff, gbase, soff, voff) do { const char* gp_ = (gbase) + (size_t)(soff); _Pragma("unroll") for (int _i = 0; _i < 2; ++_i) { unsigned keep_ = 0; \
        asm volatile("s_mov_b32 m0, %2\n\ts_nop 4\n\tglobal_load_lds_dwordx4 %0, %1" :: "v"((voff)[_i]), "s"(gp_), "s"(ldsb + (unsigned)((bufoff) + _i * 8192)) : "memory"); (void)keep_; } } while (0)
#define G8_LDA(dst, b, h) do { _Pragma("unroll") for (int m = 0; m < 4; ++m) _Pragma("unroll") for (int k = 0; k < 2; ++k) dst[m][k] = *(const LAS bf16x8*)(lds + G8_SA(b, h) + aoff + m * 2048 + k * 1024); } while (0)
#define G8_LDB(dst, b, h) do { _Pragma("unroll") for (int n = 0; n < 2; ++n) _Pragma("unroll") for (int k = 0; k < 2; ++k) dst[n][k] = *(const LAS bf16x8*)(lds + G8_SB(b, h) + boff + n * 2048 + k * 1024); } while (0)
#define G8_MMA(ai, bj, At, Bt) do { __builtin_amdgcn_s_setprio(1); _Pragma("unroll") for (int m = 0; m < 4; ++m) _Pragma("unroll") for (int n = 0; n < 2; ++n) { \
        if (PROBE & 2) { asm volatile("" :: "v"(Bt[n][0]), "v"(Bt[n][1]), "v"(At[m][0]), "v"(At[m][1])); } else acc[ai][bj][m][n] = Mma<Epi::MODE>::run(Bt[n], At[m], acc[ai][bj][m][n], mxs); } __builtin_amdgcn_s_setprio(0); } while (0)
#define G8_WAIT_V(n) asm volatile("s_waitcnt vmcnt(" #n ")" ::: "memory")
#define G8_WAIT_L(n) asm volatile("s_waitcnt lgkmcnt(" #n ")" ::: "memory")
#define G8_BAR __builtin_amdgcn_s_barrier()
#define G8_SCHED __builtin_amdgcn_sched_barrier(0)
    GU cur, nxt; int ui = 0;
    if (!S.next(0, cur)) return;
    acc_t acc[2][2][4][2];
#pragma unroll
    for (int a = 0; a < 2; ++a)
#pragma unroll
        for (int b = 0; b < 2; ++b)
#pragma unroll
            for (int m = 0; m < 4; ++m)
#pragma unroll
                for (int n = 0; n < 2; ++n) {
                    if constexpr (Epi::MODE == 0) acc[a][b][m][n] = (acc_t){0, 0, 0, 0};
                    else {
#pragma unroll
                        for (int j = 0; j < 4; ++j) { decltype(acc[a][b][m][n][j] + acc[a][b][m][n][j]) zv; asm volatile("v_mov_b32 %0, 0" : "=v"(zv)); acc[a][b][m][n][j] = zv; } } }
    bf16x8 At[4][2], B0[2][2], B1[2][2];
    unsigned cA = cur.a, cB = cur.b;
    unsigned c0[2], c1[2], n0[2], n1[2];
    if constexpr (GATHER) {
#pragma unroll
        for (int i = 0; i < 2; ++i) { const int r0 = S.rowtok[cur.row0 + RA[i]], r1 = S.rowtok[cur.row0 + HALF + RA[i]];
            c0[i] = (unsigned)r0 * S.lda + voffA[i]; c1[i] = (unsigned)r1 * S.lda + voffA[i]; n0[i] = c0[i]; n1[i] = c1[i]; }
    } else {
#pragma unroll
        for (int i = 0; i < 2; ++i) { c0[i] = voffA[i]; c1[i] = voffA[i]; n0[i] = voffA[i]; n1[i] = voffA[i]; }
    }
    G8_STAGE(G8_SB(0, 0), Bb, cB, voffB); G8_STAGE(G8_SB(0, 1), Bb, cB + hsB, voffB); G8_STAGE(G8_SA(0, 0), Ab, cA, c0); G8_STAGE(G8_SA(0, 1), Ab, cA + hsA, c1);
    if (wr == 1) G8_BAR;
    G8_WAIT_V(2); G8_BAR;
    G8_STAGE(G8_SB(1, 0), Bb, cB + kstep, voffB); G8_STAGE(G8_SA(1, 0), Ab, cA + kstep, c0); G8_STAGE(G8_SB(1, 1), Bb, cB + hsB + kstep, voffB);
    G8_WAIT_V(6); G8_BAR;
    for (;;) {
        const bool has_next = S.next(ui + 1, nxt);
        const unsigned nA = has_next ? nxt.a : cA, nB = has_next ? nxt.b : cB;
        const int nt = Sched::VAR_NT ? cur.aux : S.nt;
        if constexpr (Epi::PF) E.prefetch(cur, wave_, (unsigned)(unsigned long)lds + (unsigned)(PF_OFF + (ui & 1) * PF_BLK));
        for (int t = 0; t < nt; t += 2) {
            const bool last = (t == nt - 2);
            const unsigned a1 = cA + (unsigned)(t + 1) * kstep;
            const unsigned a2 = last ? nA : cA + (unsigned)(t + 2) * kstep, b2 = last ? nB : cB + (unsigned)(t + 2) * kstep;
            const unsigned a3 = a2 + kstep, b3 = b2 + kstep;
            unsigned s0[2], s1[2];
            if constexpr (GATHER) {
                if (last && has_next) {
#pragma unroll
                    for (int i = 0; i < 2; ++i) { const int r0 = S.rowtok[nxt.row0 + RA[i]], r1 = S.rowtok[nxt.row0 + HALF + RA[i]];
                        n0[i] = (unsigned)r0 * S.lda + voffA[i]; n1[i] = (unsigned)r1 * S.lda + voffA[i]; }
                }
#pragma unroll
                for (int i = 0; i < 2; ++i) { s0[i] = last ? n0[i] : c0[i]; s1[i] = last ? n1[i] : c1[i]; }
            } else {
#pragma unroll
                for (int i = 0; i < 2; ++i) { s0[i] = voffA[i]; s1[i] = voffA[i]; }
            }
            G8_LDB(B0, 0, 0); G8_LDB(B1, 0, 1); G8_SCHED; G8_LDA(At, 0, 0);
            G8_STAGE(G8_SA(1, 1), Ab, a1 + hsA, c1);
            G8_WAIT_V(8); G8_WAIT_L(0); G8_BAR; G8_MMA(0, 0, At, B0); G8_MMA(0, 1, At, B1); G8_BAR; G8_SCHED;
            G8_LDA(At, 0, 1); G8_STAGE(G8_SB(0, 0), Bb, b2, voffB); G8_STAGE(G8_SB(0, 1), Bb, b2 + hsB, voffB); G8_STAGE(G8_SA(0, 0), Ab, a2, s0);
            G8_WAIT_V(8); G8_WAIT_L(0); G8_BAR; G8_MMA(1, 0, At, B0); G8_MMA(1, 1, At, B1); G8_BAR; G8_SCHED;
            G8_LDB(B0, 1, 0); G8_LDB(B1, 1, 1); G8_SCHED; G8_LDA(At, 1, 0); G8_STAGE(G8_SA(0, 1), Ab, a2 + hsA, s1);
            G8_WAIT_V(8); G8_WAIT_L(0); G8_BAR; G8_MMA(0, 0, At, B0); G8_MMA(0, 1, At, B1); G8_BAR; G8_SCHED;
            G8_LDA(At, 1, 1); G8_STAGE(G8_SB(1, 0), Bb, b3, voffB); G8_STAGE(G8_SB(1, 1), Bb, b3 + hsB, voffB); G8_STAGE(G8_SA(1, 0), Ab, a3, s0);
            G8_WAIT_V(8); G8_WAIT_L(0); G8_BAR; G8_MMA(1, 0, At, B0); G8_MMA(1, 1, At, B1); G8_BAR; G8_SCHED;
        }
        if (wr == 0) G8_BAR;
        if (!(PROBE & 1)) E(acc, cur, wave_, lds + (Epi::PF ? (ui & 1) * PF_BLK : 0));
        if (!has_next) break;
#pragma unroll
        for (int a = 0; a < 2; ++a)
#pragma unroll
            for (int b = 0; b < 2; ++b)
#pragma unroll
                for (int m = 0; m < 4; ++m)
#pragma unroll
                    for (int n = 0; n < 2; ++n) {
                        if constexpr (Epi::MODE == 0) acc[a][b][m][n] = (acc_t){0, 0, 0, 0};
                        else {
#pragma unroll
                            for (int j = 0; j < 4; ++j) { decltype(acc[a][b][m][n][j] + acc[a][b][m][n][j]) zv; asm volatile("v_mov_b32 %0, 0" : "=v"(zv)); acc[a][b][m][n][j] = zv; } } }
        cur = nxt; cA = nA; cB = nB; ++ui;
        if constexpr (GATHER) {
#pragma unroll
            for (int i = 0; i < 2; ++i) { c0[i] = n0[i]; c1[i] = n1[i]; }
        }
        if (wr == 1) G8_BAR;
    }
    G8_WAIT_V(0);
    G8_BAR;
#undef G8_SA
#undef G8_SB
#undef G8_STAGE
#undef G8_LDA
#undef G8_LDB
#undef G8_MMA
#undef G8_WAIT_V
#undef G8_WAIT_L
#undef G8_BAR
#undef G8_SCHED
}
}

using g8::GU;
#define EPI_LANE_IDS() const int tz_ = hidden_tid(wave_); const int wid_ = wave_, lane_ = tz_ & 63, wr = wid_ >> 2, wc = wid_ & 3, fr = lane_ & 15, fq = lane_ >> 4
template <int MODE_ = 0> struct EpiBf16T {          static constexpr int MODE = MODE_; static constexpr bool PF = false;
    static constexpr bool PERM = true;
    bf16_t* O; int ldc; const float* bias; int bstride; const float* scale; float smul;
    __device__ __forceinline__ void operator()(const f32x4 (&acc)[2][2][4][2], const GU& u, int wave_, LAS unsigned char* lds_) const {
        EPI_LANE_IDS();
        const int cl = wc * 32 + 8 * fq;
        bf16_t* Ob = O + u.ooff;
#pragma unroll
        for (int bj = 0; bj < 2; ++bj) {
            f32x4 bv[2], sv[2];
#pragma unroll
            for (int n = 0; n < 2; ++n) { bv[n] = bias ? *(const f32x4*)(bias + (size_t)u.aux * bstride + u.col0 + cl + bj * 128 + 4 * n) : (f32x4){0.f, 0.f, 0.f, 0.f};
                sv[n] = scale ? *(const f32x4*)(scale + (size_t)u.aux * bstride + u.col0 + cl + bj * 128 + 4 * n) * smul : (f32x4){smul, smul, smul, smul}; }
#pragma unroll
            for (int ai = 0; ai < 2; ++ai)
#pragma unroll
                for (int m = 0; m < 4; ++m) { bf16_t* rowp = Ob + (unsigned)((ai * 128 + wr * 64 + m * 16 + fr) * ldc + cl) + bj * 128;
                    const f32x4 v0 = acc[ai][bj][m][0] * sv[0] + bv[0], v1 = acc[ai][bj][m][1] * sv[1] + bv[1];
                    u32x4 w; w.x = cvt_pk_bf16(v0[0], v0[1]); w.y = cvt_pk_bf16(v0[2], v0[3]); w.z = cvt_pk_bf16(v1[0], v1[1]); w.w = cvt_pk_bf16(v1[2], v1[3]);
                    *(u32x4*)rowp = w; }
        }
    }
};
typedef EpiBf16T<0> EpiBf16;
struct EpiGlu8 { static constexpr bool PF = false;
    static constexpr bool PERM = true; static constexpr int MODE = 2;
    bf16_t* O; int ldc; const float* bias; const float* sw; int half;
    __device__ __forceinline__ void operator()(const f32x4 (&acc)[2][2][4][2], const GU& u, int wave_, LAS unsigned char* lds_) const {
        EPI_LANE_IDS();
        const int cl = wc * 32 + 8 * fq;
        f32x4 bv[2][2], sv[2][2];
#pragma unroll
        for (int bj = 0; bj < 2; ++bj)
#pragma unroll
            for (int n = 0; n < 2; ++n) { bv[bj][n] = *(const f32x4*)(bias + u.col0 + cl + bj * half + 4 * n); sv[bj][n] = *(const f32x4*)(sw + u.col0 + cl + bj * half + 4 * n); }
        bf16_t* Ob = O + u.ooff;
#pragma unroll
        for (int ai = 0; ai < 2; ++ai)
#pragma unroll
            for (int m = 0; m < 4; ++m) { bf16_t* rowp = Ob + (unsigned)((ai * 128 + wr * 64 + m * 16 + fr) * ldc + cl);
                float o[8];
#pragma unroll
                for (int n = 0; n < 2; ++n) { const f32x4 a = acc[ai][0][m][n] * sv[0][n] + bv[0][n], g = acc[ai][1][m][n] * sv[1][n] + bv[1][n];
#pragma unroll
                    for (int j = 0; j < 4; ++j) o[4 * n + j] = a[j] * fast_sigmoid(g[j]); }
                u32x4 w; w.x = cvt_pk_bf16(o[0], o[1]); w.y = cvt_pk_bf16(o[2], o[3]); w.z = cvt_pk_bf16(o[4], o[5]); w.w = cvt_pk_bf16(o[6], o[7]);
                *(u32x4*)rowp = w; }
    }
};
#define EPI_DMA16(gptr, ldsaddr) asm volatile("s_mov_b32 m0, %1\n\ts_nop 4\n\tglobal_load_lds_dwordx4 %0, off" :: "v"(gptr), "s"(ldsaddr) : "memory")
struct EpiY2 { static constexpr bool PF = true;
    static constexpr bool PERM = true; static constexpr int MODE = 2;
    unsigned char* O; const float* bias; const float* scale;
    __device__ __forceinline__ void prefetch(const GU& u, int wave_, unsigned ldsaddr) const {
        const int l_ = hidden_tid(wave_) & 63;
        if (wave_ == 0) { const float* p = bias + (size_t)u.aux * 1024 + u.col0 + 4 * l_; EPI_DMA16(p, ldsaddr); }
        else if (wave_ == 1) { const float* p = scale + (size_t)u.aux * 1024 + u.col0 + 4 * l_; EPI_DMA16(p, ldsaddr + 1024u); }
    }
    __device__ __forceinline__ void operator()(const f32x4 (&acc)[2][2][4][2], const GU& u, int wave_, LAS unsigned char* lds_) const {
        EPI_LANE_IDS();
        const int cl = wc * 32 + 8 * fq;
        unsigned char* Ob = O + u.ooff; const LAS float* pf = (const LAS float*)(lds_ + g8::PF_OFF);
#pragma unroll
        for (int bj = 0; bj < 2; ++bj) {
            f32x4 bv[2], sv[2];
#pragma unroll
            for (int n = 0; n < 2; ++n) { bv[n] = *(const LAS f32x4*)(pf + cl + bj * 128 + 4 * n) * Y2_PRESCALE;
                sv[n] = *(const LAS f32x4*)(pf + 256 + cl + bj * 128 + 4 * n) * (Y2_PRESCALE / H_PRESCALE); }
#pragma unroll
            for (int ai = 0; ai < 2; ++ai)
#pragma unroll
                for (int m = 0; m < 4; m += 2) {
                    const f32x4 a0 = acc[ai][bj][m][0] * sv[0] + bv[0], a1 = acc[ai][bj][m][1] * sv[1] + bv[1], b0 = acc[ai][bj][m + 1][0] * sv[0] + bv[0], b1 = acc[ai][bj][m + 1][1] * sv[1] + bv[1];
                    const unsigned pa0 = pack_fp8x4(a0[0], a0[1], a0[2], a0[3]), pa1 = pack_fp8x4(a1[0], a1[1], a1[2], a1[3]), pb0 = pack_fp8x4(b0[0], b0[1], b0[2], b0[3]), pb1 = pack_fp8x4(b1[0], b1[1], b1[2], b1[3]);
                    const bool odd = (fq & 1) != 0;
                    const unsigned k0 = odd ? pb0 : pa0, k1 = odd ? pb1 : pa1, s0 = odd ? pa0 : pb0, s1 = odd ? pa1 : pb1;
                    const unsigned r0 = __float_as_uint(sx<16>(__uint_as_float(s0))), r1 = __float_as_uint(sx<16>(__uint_as_float(s1)));
                    const u32x4 w = odd ? (u32x4){r0, r1, k0, k1} : (u32x4){k0, k1, r0, r1};
                    unsigned char* rowp = Ob + (unsigned)((ai * 128 + wr * 64 + (m + (odd ? 1 : 0)) * 16 + fr) * 1024 + (cl - (odd ? 8 : 0))) + bj * 128;
                    *(u32x4*)rowp = w; }
        }
    }
};
template <int MODE_ = 0> struct EpiFp8T { static constexpr bool PF = false;
    static constexpr bool PERM = true; static constexpr int MODE = MODE_;
    unsigned char* O; int ldc; float smul;
    __device__ __forceinline__ void operator()(const f32x4 (&acc)[2][2][4][2], const GU& u, int wave_, LAS unsigned char* lds_) const {
        EPI_LANE_IDS();
        const int cl = wc * 32 + 8 * fq;
        unsigned char* Ob = O + u.ooff;
#pragma unroll
        for (int ai = 0; ai < 2; ++ai)
#pragma unroll
            for (int m = 0; m < 4; ++m) { unsigned char* rowp = Ob + (unsigned)((ai * 128 + wr * 64 + m * 16 + fr) * ldc + cl);
#pragma unroll
                for (int bj = 0; bj < 2; ++bj) { const f32x4 v0 = acc[ai][bj][m][0] * smul, v1 = acc[ai][bj][m][1] * smul;
                    *(u32x2*)(rowp + bj * 128) = (u32x2){pack_fp8x4(v0[0], v0[1], v0[2], v0[3]), pack_fp8x4(v1[0], v1[1], v1[2], v1[3])}; } }
    }
};
template <int PV = 0> struct EpiGatedI8T { static constexpr bool PF = true;
    static constexpr bool PERM = true; static constexpr int MODE = 1;
    unsigned char* O; const float* bias; const float* sw; const float* sap;
    __device__ __forceinline__ void prefetch(const GU& u, int wave_, unsigned ldsaddr) const {
        const int l_ = hidden_tid(wave_) & 63;
        if (wave_ == 0) { const float* p = bias + (size_t)u.aux * 2048 + u.col0 + (l_ >> 5) * 1024 + 4 * (l_ & 31); EPI_DMA16(p, ldsaddr); }
        else if (wave_ == 1) { const float* p = sw + (size_t)u.aux * 2048 + u.col0 + (l_ >> 5) * 1024 + 4 * (l_ & 31); EPI_DMA16(p, ldsaddr + 1024u); }
        else if (wave_ == 2) { const float* p = sap + u.row0 + 4 * l_; EPI_DMA16(p, ldsaddr + 2048u); }
    }
    __device__ __forceinline__ void operator()(const i32x4 (&acc)[2][2][4][2], const GU& u, int wave_, LAS unsigned char* lds_) const {
        EPI_LANE_IDS();
        const int cl = wc * 32 + 8 * fq; const LAS float* pf = (const LAS float*)(lds_ + g8::PF_OFF);
        f32x4 bv[2][2], sv[2][2]; float sr[2][4];
#pragma unroll
        for (int bj = 0; bj < 2; ++bj)
#pragma unroll
            for (int n = 0; n < 2; ++n) { if (PV & 1) { bv[bj][n] = (f32x4){0.f, 0.f, 0.f, 0.f}; sv[bj][n] = (f32x4){1.f, 1.f, 1.f, 1.f}; } else { bv[bj][n] = *(const LAS f32x4*)(pf + bj * 128 + cl + 4 * n); sv[bj][n] = *(const LAS f32x4*)(pf + 256 + bj * 128 + cl + 4 * n); } }
#pragma unroll
        for (int ai = 0; ai < 2; ++ai)
#pragma unroll
            for (int m = 0; m < 4; ++m) sr[ai][m] = (PV & 1) ? 1.0f : pf[512 + ai * 128 + wr * 64 + m * 16 + fr];
        unsigned char* Ob = O + u.ooff;
        float C_SIG = -1.702f * 1.4426950408889634f, K2 = H_PRESCALE / (-1.702f * 1.4426950408889634f), c7s = 7.0f * (-1.702f * 1.4426950408889634f), glo = -6.0f * (H_PRESCALE / (-1.702f * 1.4426950408889634f)), ghi = 8.0f * (H_PRESCALE / (-1.702f * 1.4426950408889634f));
        asm volatile("" : "+s"(C_SIG), "+s"(K2), "+s"(c7s), "+s"(glo), "+s"(ghi));
        if (!(PV & 1)) {
#pragma unroll
            for (int n = 0; n < 2; ++n) { sv[0][n] = sv[0][n] * C_SIG; bv[0][n] = bv[0][n] * C_SIG; sv[1][n] = sv[1][n] * K2; bv[1][n] = bv[1][n] * K2 + K2; } }
#pragma unroll
        for (int ai = 0; ai < 2; ++ai)
#pragma unroll
            for (int m = 0; m < 4; ++m) { const int rl = ai * 128 + wr * 64 + m * 16 + fr; const float srow = sr[ai][m];
                unsigned char* rowp = Ob + (unsigned)(rl * 1024 + cl);
                float o[8];
#pragma unroll
                for (int n = 0; n < 2; ++n) {
#pragma unroll
                    for (int j = 0; j < 4; ++j) { const float a = ((float)acc[ai][0][m][n][j] * sv[0][n][j]) * srow + bv[0][n][j], g = ((float)acc[ai][1][m][n][j] * sv[1][n][j]) * srow + bv[1][n][j];
                        if (PV & 4) { o[4 * n + j] = a + g; } else {
                        const float gl = fmaxf(a, c7s), li = __builtin_amdgcn_fmed3f(g, glo, ghi);
                        const float sg = __builtin_amdgcn_rcpf(1.0f + __builtin_amdgcn_exp2f(gl));
                        o[4 * n + j] = (gl * sg) * li; } } }
                int w0 = 0, w1 = 0; w0 = __builtin_amdgcn_cvt_pk_fp8_f32(o[0], o[1], w0, false); w0 = __builtin_amdgcn_cvt_pk_fp8_f32(o[2], o[3], w0, true);
                w1 = __builtin_amdgcn_cvt_pk_fp8_f32(o[4], o[5], w1, false); w1 = __builtin_amdgcn_cvt_pk_fp8_f32(o[6], o[7], w1, true);
                if (PV & 2) { asm volatile("" :: "v"(w0), "v"(w1)); } else *(u32x2*)rowp = (u32x2){(unsigned)w0, (unsigned)w1}; }
    }
};
typedef EpiGatedI8T<0> EpiGatedI8;
struct EpiQK8 { static constexpr bool PF = false;
    static constexpr bool PERM = false; static constexpr int MODE = 2;
    unsigned char* Q; const float* rope; const float* sw;
    __device__ __forceinline__ void operator()(const f32x4 (&acc)[2][2][4][2], const GU& u, int wave_, LAS unsigned char* lds_) const {
        EPI_LANE_IDS();
        const int which = u.col0 >> 10, colw = u.col0 & 1023;
        unsigned char* base = Q + (size_t)which * (WS_K - WS_Q);
        const bool dorope = u.row0 < T_LAT;
        const float sc = which == 0 ? ATT_C2 * Q_PRESCALE : 1.0f;
#pragma unroll
        for (int bj = 0; bj < 2; ++bj) {
            const f32x4 s1 = *(const f32x4*)(sw + u.col0 + bj * 128 + wc * 32 + 4 * fq) * sc, s2 = *(const f32x4*)(sw + u.col0 + bj * 128 + wc * 32 + 16 + 4 * fq) * sc;
#pragma unroll
            for (int ai = 0; ai < 2; ++ai)
#pragma unroll
                for (int m = 0; m < 4; ++m) { const int row = u.row0 + ai * 128 + wr * 64 + m * 16 + fr;
                    float one_ = 1.0f; asm volatile("" : "+s"(one_));
                    f32x4 cs0 = (f32x4){one_, 0.f, one_, 0.f}, cs1 = cs0;
                    if (dorope) { const int t = row & (SEQ - 1); const int pos = (wc & 1) ? (t & 63) : (t >> 6); const float* rp = rope + (pos * 16 + 4 * fq) * 2; cs0 = *(const f32x4*)rp; cs1 = *(const f32x4*)(rp + 4); }
                    const float cj[4] = {cs0[0], cs0[2], cs1[0], cs1[2]}, sj[4] = {cs0[1], cs0[3], cs1[1], cs1[3]};
                    const f32x4 x1 = acc[ai][bj][m][0] * s1, x2 = acc[ai][bj][m][1] * s2; float o1[4], o2[4];
#pragma unroll
                    for (int j = 0; j < 4; ++j) { o1[j] = x1[j] * cj[j] - x2[j] * sj[j]; o2[j] = x2[j] * cj[j] + x1[j] * sj[j]; }
                    unsigned char* rowp = base + (size_t)row * D + colw + bj * 128 + wc * 32 + 4 * fq;
                    *(unsigned*)rowp = pack_fp8x4(o1[0], o1[1], o1[2], o1[3]); *(unsigned*)(rowp + 16) = pack_fp8x4(o2[0], o2[1], o2[2], o2[3]);
                    if (m & 1) __builtin_amdgcn_sched_barrier(0); }
        }
    }
};
struct EpiVt8 { static constexpr bool PF = false;
    static constexpr bool PERM = true; static constexpr int MODE = 2;
    unsigned char* Vt; const float* sw;
    __device__ __forceinline__ void operator()(const f32x4 (&acc)[2][2][4][2], const GU& u, int wave_, LAS unsigned char* lds_) const {
        EPI_LANE_IDS();
        unsigned char* Ob = Vt + u.ooff; const float* swp = sw + u.row0;
        const int k0 = wc * 32 + 8 * fq, kk = k0 & 63;
        const unsigned pcol = (unsigned)((k0 & ~63) + 16 * (kk >> 5) + 4 * ((kk >> 3) & 3));
#pragma unroll
        for (int ai = 0; ai < 2; ++ai)
#pragma unroll
            for (int m = 0; m < 4; ++m) { const int r = ai * 128 + wr * 64 + m * 16 + fr; const float sr = swp[r];
                const unsigned ro = (unsigned)r * (unsigned)VT_PITCH + pcol;
#pragma unroll
                for (int bj = 0; bj < 2; ++bj) { const f32x4 v0 = acc[ai][bj][m][0] * sr, v1 = acc[ai][bj][m][1] * sr;
                    *(unsigned*)(Ob + ro + bj * 128) = pack_fp8x4(v0[0], v0[1], v0[2], v0[3]); *(unsigned*)(Ob + ro + bj * 128 + 32) = pack_fp8x4(v1[0], v1[1], v1[2], v1[3]); }
                __builtin_amdgcn_sched_barrier(0); }
    }
};

struct DenseSched {
    static constexpr bool GATHER = false, VAR_NT = false;
    const char* A; const char* Bt; unsigned lda, ldb, hstepA, hstepB; int nt, ldc; const int* rowtok; g8::DenseOrder ord;
    __device__ __forceinline__ void init(const void* A_, const void* Bt_, int M, int N, int K, int ldc_, int G, int c) {
        A = (const char*)A_; Bt = (const char*)Bt_; lda = (unsigned)K * 2u; ldb = lda; hstepA = 128u * lda; hstepB = hstepA; nt = K / 64; ldc = ldc_; rowtok = nullptr; ord.init(M, N, G, c); }
    __device__ __forceinline__ void init8(const void* A_, const void* Bt_, int M, int N, int Kbytes, int ldc_, int G, int c) {
        A = (const char*)A_; Bt = (const char*)Bt_; lda = (unsigned)Kbytes; ldb = lda; hstepA = 128u * lda; hstepB = hstepA; nt = Kbytes / 128; ldc = ldc_; rowtok = nullptr; ord.init(M, N, G, c); }
    __device__ __forceinline__ bool next(int i, GU& u) const { int pm, pn; if (!ord.tile(i, pm, pn)) return false;
        u.a = (unsigned)pm * 2u * hstepA; u.b = (unsigned)pn * 2u * hstepB; u.row0 = pm * 256; u.col0 = pn * 256; u.ooff = (unsigned)(pm * 256) * (unsigned)ldc + (unsigned)(pn * 256); u.aux = 0; return true; }
};
__device__ __forceinline__ bool xcd_local(int i, int G, int c, int total, int& Li) {
    if ((G & 7) == 0 && (total & 7) == 0) { const int per = total >> 3, off = i * (G >> 3) + (c >> 3); if (off >= per) return false; Li = (c & 7) * per + off; return true; }
    const long L = (long)i * G + c; if (L >= total) return false; Li = (int)L; return true;
}
struct VtSched {
    static constexpr bool GATHER = false, VAR_NT = false;
    const char* A; const char* Bt; unsigned lda, ldb, hstepA, hstepB; int nt, ldc; const int* rowtok; int G, c;
    __device__ __forceinline__ void init(const void* Wv, const void* U, int G_, int c_) { A = (const char*)Wv; Bt = (const char*)U; lda = 1024u; ldb = 1024u; hstepA = 128u * 1024u; hstepB = hstepA; nt = 8; ldc = VT_PITCH; rowtok = nullptr; G = G_; c = c_; }
    __device__ __forceinline__ bool next(int i, GU& u) const {
        const long L = (long)i * G + c; if (L >= 4 * 136) return false; const int Li = (int)L, pm = Li & 3, pn = Li >> 2;
        const int b = pn < 128 ? (pn >> 4) : pn - 128, n0 = pn < 128 ? (pn & 15) * 256 : SEQ;
        u.a = (unsigned)pm * 256u * 1024u; u.b = (unsigned)pn * 256u * 1024u; u.row0 = pm * 256; u.col0 = 0; u.aux = 0;
        u.ooff = (unsigned)(b * 1024 + pm * 256) * (unsigned)VT_PITCH + (unsigned)n0; return true; }
};
struct GatedSched {
    static constexpr bool GATHER = false, VAR_NT = false;
    const char* A; const char* Bt; unsigned lda, ldb, hstepA, hstepB; int nt, ldc; const int* rowtok; g8::DenseOrder ord;
    __device__ __forceinline__ void init(const void* A_, const void* Bt_, int M, int N2, int K, int ldc_, int G, int c) {
        A = (const char*)A_; Bt = (const char*)Bt_; lda = (unsigned)K * 2u; ldb = lda; hstepA = 128u * lda; hstepB = (unsigned)N2 * ldb; nt = K / 64; ldc = ldc_; rowtok = nullptr; ord.init(M, 2 * N2, G, c); }
    __device__ __forceinline__ void init8(const void* A_, const void* Bt_, int M, int N2, int Kbytes, int ldc_, int G, int c) {
        A = (const char*)A_; Bt = (const char*)Bt_; lda = (unsigned)Kbytes; ldb = lda; hstepA = 128u * lda; hstepB = (unsigned)N2 * ldb; nt = Kbytes / 128; ldc = ldc_; rowtok = nullptr; ord.init(M, 2 * N2, G, c); }
    __device__ __forceinline__ bool next(int i, GU& u) const { int pm, pn; if (!ord.tile(i, pm, pn)) return false;
        u.a = (unsigned)pm * 2u * hstepA; u.b = (unsigned)pn * 128u * ldb; u.row0 = pm * 256; u.col0 = pn * 128; u.ooff = (unsigned)(pm * 256) * (unsigned)ldc + (unsigned)(pn * 128); u.aux = 0; return true; }
};
template <bool G1> struct MoeSched {
    static constexpr bool GATHER = G1, VAR_NT = false;
    const char* A; const char* Bt; unsigned lda, ldb, hstepA, hstepB; int nt, ldc; const int* rowtok;
    int G, c, NCT, wv; const volatile LAS int* tsp;
    __device__ __forceinline__ void init(const void* A_, const void* Bt_, const int* rowtok_, const volatile LAS int* tstart, int G_, int c_, int wave_) {
        A = (const char*)A_; Bt = (const char*)Bt_; lda = 1024u; ldb = lda; hstepA = 128u * lda; hstepB = G1 ? 1024u * ldb : 128u * ldb; nt = 8; ldc = 1024; rowtok = rowtok_;
        G = G_; c = c_; NCT = G1 ? 8 : 4; wv = wave_; tsp = tstart; }
    __device__ __forceinline__ bool next(int i, GU& u) const {
        const int l = hidden_tid(wv) & 63; const int vts = l <= 32 ? tsp[l] : 0x7fffffff;
        const int total = __builtin_amdgcn_readlane(vts, 32) * NCT; int Li;
        if ((G & 7) == 0) {
            const int x = c & 7, j = c >> 3, q = total >> 3, r = total & 7; const int len = q + (x < r ? 1 : 0), start = x * q + (x < r ? x : r), off = i * (G >> 3) + j;
            if (off >= len) return false; Li = start + off; }
        else { const long L = (long)i * G + c; if (L >= total) return false; Li = (int)L; }
        const unsigned long long mk = __ballot(l < 32 && vts * NCT <= Li);
        const int e = __popcll(mk) - 1; const int t0 = __builtin_amdgcn_readlane(vts, e);
        const int loc = Li - t0 * NCT, rt = loc / NCT, ct = loc - rt * NCT;
        const int prow = (t0 + rt) * 256;
        u.row0 = prow; u.aux = e;
        if (G1) { u.a = 0u; u.b = ((unsigned)e * 2048u + (unsigned)ct * 128u) * 1024u; u.col0 = ct * 128; u.ooff = (unsigned)prow * 1024u + (unsigned)ct * 128u; }
        else { u.a = (unsigned)prow * 1024u; u.b = ((unsigned)e * 1024u + (unsigned)ct * 256u) * 1024u; u.col0 = ct * 256; u.ooff = (unsigned)prow * 1024u + (unsigned)ct * 256u; }
        return true; }
};
struct F1Sched {
    static constexpr bool GATHER = false, VAR_NT = false;
    const char* A; const char* Bt; unsigned lda, ldb, hstepA, hstepB; int nt, ldc; const int* rowtok; int G, c;
    __device__ __forceinline__ void init(const void* acs, const void* U, int G_, int c_) { A = (const char*)acs; Bt = (const char*)U; lda = 512u; ldb = 2048u; hstepA = 128u * 512u; hstepB = 128u * 2048u; nt = 4; ldc = 8192; rowtok = nullptr; G = G_; c = c_; }
    __device__ __forceinline__ bool next(int i, GU& u) const {
        int Li; if (!xcd_local(i, G, c, 1024 + 64, Li)) return false;
        if (Li < 1024) { const int sub = Li & 7, tt = (Li >> 3) & 15, b = Li >> 7, cs = sub >> 2, mt = sub & 3;
            u.a = (unsigned)cs * 131072u; u.b = (unsigned)(b * SEQ + tt * 256) * 2048u + (unsigned)mt * 512u; u.row0 = mt * 256; u.col0 = 0; u.aux = 0;
            u.ooff = (unsigned)(b * 1024 + mt * 256) * 8192u + (unsigned)(cs * 4096 + tt * 256); }
        else { Li -= 1024; const int sub = Li & 7, b = Li >> 3, cs = sub >> 2, mt = sub & 3;
            u.a = (unsigned)cs * 131072u; u.b = (unsigned)(T_LAT + b * CTXL) * 2048u + (unsigned)mt * 512u; u.row0 = mt * 256; u.col0 = 0; u.aux = 0;
            u.ooff = 8u * 1024u * 8192u + (unsigned)(b * 1024 + mt * 256) * 8192u + (unsigned)(cs * 256); }
        return true; }
};
static_assert(WS_K - WS_Q == WS_V - WS_K, "Q, K, V equally spaced");
static_assert(WS_YTC >= WS_YT + (size_t)2 * 8 * 1024 * 8192, "ctx Yt follows lat Yt (8 MiB x 8 after it)");
struct F2Sched {
    static constexpr bool GATHER = false, VAR_NT = true;
    const char* A; const char* Bt; unsigned lda, ldb, hstepA, hstepB; int nt, ldc; const int* rowtok; int G, c;
    __device__ __forceinline__ void init(const void* dft, const void* Yt, int G_, int c_) { A = (const char*)dft; Bt = (const char*)Yt;
        lda = 8192u; ldb = 8192u; hstepA = 128u * 8192u; hstepB = hstepA; nt = 0; ldc = 1024; rowtok = nullptr; G = G_; c = c_; }
    __device__ __forceinline__ bool next(int i, GU& u) const {
        int Li;
        if ((G & 7) == 0) { const int off = i * (G >> 3) + (c >> 3); if (off >= 68) return false; Li = off < 64 ? (c & 7) * 64 + off : 512 + (c & 7) * 4 + (off - 64); }
        else { const long L = (long)i * G + c; if (L >= 512 + 32) return false; Li = (int)L; }
        if (Li < 512) { const int ct = Li & 3, kt = (Li >> 2) & 15, b = Li >> 6;
            u.a = (unsigned)kt * 256u * 8192u; u.b = (unsigned)(b * 1024 + ct * 256) * 8192u; u.row0 = b * SEQ + kt * 256; u.col0 = ct * 256; u.aux = 64; }
        else { Li -= 512; const int ct = Li & 3, b = Li >> 2;
            u.a = 4096u * 8192u; u.b = (unsigned)(8 * 1024 + b * 1024 + ct * 256) * 8192u; u.row0 = T_LAT + b * CTXL; u.col0 = ct * 256; u.aux = 4; }
        u.ooff = (unsigned)u.row0 * 1024u + (unsigned)u.col0; return true; }
};
namespace att {
constexpr int SLOTK = 4096, SLOTV = 8192, NSLOT = 4, PFD = NSLOT - 1;
constexpr int LDS_K = 0, LDS_V = NSLOT * SLOTK, LDS_WS = LDS_V + NSLOT * SLOTV, LDS_OST = LDS_WS + NWAVES * 256, LDS_END = LDS_OST + NWAVES * 8192;
static_assert(LDS_END <= MISC_OFF, "attention LDS map");
__device__ __forceinline__ int crow(int r, int hi) { return (r & 3) + 8 * (r >> 2) + 4 * hi; }
struct Params { const unsigned char* Q; const unsigned char* K; const unsigned char* Vt; unsigned char* O; float* scr; const float* subln_g; float lam, outscale; int wave; };
__device__ __forceinline__ float max3f(float a, float b, float c) { float r; asm("v_max3_f32 %0, %1, %2, %3" : "=v"(r) : "v"(a), "v"(b), "v"(c)); return r; }
__device__ __forceinline__ i32x8 cat8(i32x4 a, i32x4 b) { return (i32x8){a[0], a[1], a[2], a[3], b[0], b[1], b[2], b[3]}; }

template <int THRL, int VAR = 0>
__device__ __forceinline__ void unit(const Params& P, int b, int h, int c, int qrow0, int t_begin, int t_end, LAS unsigned char* lds) {
    const int tid = hidden_tid(P.wave), lane = tid & 63, r32 = lane & 31, hi = lane >> 5; const int wid = P.wave; const int grp = (wid >> ATT_GSH) & 1; const bool dk = wid < 4;
    LAS float* wsf = (LAS float*)(lds + LDS_WS) + wid * 64;
    const int drow = lane >> 2, dsw = (lane & 3) ^ ((lane >> 4) & 3);
    const unsigned koff = (unsigned)(16 * (wid & 3) + drow) * 1024u + (unsigned)(h * 128 + c * 64 + 16 * dsw);
    const unsigned voff = (unsigned)((b * 1024 + h * 128 + 16 * wid + drow) * VT_PITCH + 16 * dsw);
    const char* Kb = (const char*)P.K; const char* Vb = (const char*)P.Vt; const unsigned lds0 = (unsigned)(unsigned long)lds;
#define ATT_KROW0(t) ((t) < 64 ? b * SEQ + 64 * (t) : T_LAT + b * CTXL + 64 * ((t) - 64))
#define ATT_GLDS(sbase, vo, ldsaddr) do { unsigned keep_ = 0; asm volatile("s_mov_b32 m0, %2\n\ts_nop 4\n\tglobal_load_lds_dwordx4 %0, %1" :: "v"(vo), "s"(sbase), "s"(ldsaddr) : "memory"); (void)keep_; } while (0)
#define ATT_DMA_K(t, slot) do { if (dk) { const char* kp_ = Kb + (size_t)(ATT_KROW0(t)) * 1024; ATT_GLDS(kp_, koff, lds0 + (unsigned)(LDS_K + (slot) * SLOTK + wid * 1024)); } } while (0)
#define ATT_DMA_V(t, slot) do { const char* vp_ = Vb + (size_t)(t) * 64; ATT_GLDS(vp_, voff, lds0 + (unsigned)(LDS_V + (slot) * SLOTV + wid * 1024)); } while (0)
#define ATT_BAR() asm volatile("s_waitcnt lgkmcnt(0)\n\ts_barrier" ::: "memory")
#define ATT_VM(N) asm volatile("s_waitcnt vmcnt(" #N ")" ::: "memory")
#define ATT_VMN(N) asm volatile("s_waitcnt vmcnt(%0)" :: "n"(N) : "memory")
    const int T = t_end - t_begin;
#pragma unroll
    for (int j = 0; j < PFD; ++j) { if (j < T) ATT_DMA_K(t_begin + j, j); if (j < PFD - 1 && j < T) ATT_DMA_V(t_begin + j, j); }
    i32x8 qf;
    { const unsigned char* Qw = P.Q + (size_t)(qrow0 + wid * 32 + r32) * D + h * 128 + c * 64 + hi * 32; qf = cat8(*(const i32x4*)Qw, *(const i32x4*)(Qw + 16)); }
    f32x16 o[4], negm;
#pragma unroll
    for (int r = 0; r < 16; ++r) { negm[r] = 0.f;
#pragma unroll
        for (int d0 = 0; d0 < 4; ++d0) o[d0][r] = 0.f; }
    float mhat = 0.f;
    f32x16 lacc;
#pragma unroll
    for (int r = 0; r < 16; ++r) lacc[r] = 0.f;
    i32x8 ones; { int o1_ = 0x38383838; asm volatile("" : "+v"(o1_)); ones = (i32x8){o1_, o1_, o1_, o1_, o1_, o1_, o1_, o1_}; }
    const int fsw = (r32 >> 2) & 3;
    const int foff0 = r32 * 64 + ((2 * hi) ^ fsw) * 16, foff1 = r32 * 64 + ((2 * hi + 1) ^ fsw) * 16;
    int sc_s = 0x7d7d7d7d, sc_1 = 0x7f7f7f7f; asm volatile("" : "+v"(sc_s), "+v"(sc_1));
    f32x16 p0, p1; i32x8 pa;
#pragma unroll
    for (int r = 0; r < 16; ++r) { p0[r] = 0.f; p1[r] = 0.f; }
#pragma unroll
    for (int k = 0; k < 8; ++k) pa[k] = 0;
#define ATT_SOFTMAX(FIRST) do { \
        float rm, rm1 = max3f(p0[3], p0[4], p0[5]), rm2 = max3f(p0[6], p0[7], p0[8]), rm3 = max3f(p0[9], p0[10], p0[11]);     \
        rm = max3f(p0[0], p0[1], p0[2]); rm = max3f(rm, p0[12], p0[13]); rm1 = max3f(rm1, p0[14], p0[15]); rm2 = max3f(rm2, p1[0], p1[1]); rm3 = max3f(rm3, p1[2], p1[3]); \
        rm = max3f(rm, p1[4], p1[5]); rm1 = max3f(rm1, p1[6], p1[7]); rm2 = max3f(rm2, p1[8], p1[9]); rm3 = max3f(rm3, p1[10], p1[11]); \
        rm = max3f(rm, p1[12], p1[13]); rm1 = max3f(rm1, p1[14], p1[15]); rm = max3f(rm, rm1, rm2); rm = max3f(rm, rm3, rm3); \
        { auto rr = __builtin_amdgcn_permlane32_swap(__float_as_uint(rm), __float_as_uint(rm), false, false); rm = max3f(__uint_as_float(rr[0]), __uint_as_float(rr[1]), __uint_as_float(rr[1])); } \
        if ((FIRST) || __any(rm > (float)THRL)) { \
            const float dl = (FIRST) ? rm : fmaxf(rm, 0.f), f = (FIRST) ? 1.0f : __builtin_amdgcn_exp2f(-dl);     \
            mhat += dl; \
            _Pragma("unroll") for (int r = 0; r < 16; ++r) { p0[r] -= dl; p1[r] -= dl; negm[r] = -mhat; } \
            if (hi == 0) wsf[r32] = f; \
            LDS_WAIT(); \
            _Pragma("unroll") for (int r = 0; r < 16; ++r) { const float fr_ = wsf[crow(r, hi)]; \
                lacc[r] *= fr_; \
                _Pragma("unroll") for (int d0 = 0; d0 < 4; ++d0) o[d0][r] *= fr_; } \
        } \
        _Pragma("unroll") for (int r = 0; r < 16; ++r) { p0[r] = __builtin_amdgcn_exp2f(p0[r]); p1[r] = __builtin_amdgcn_exp2f(p1[r]); } \
        _Pragma("unroll") for (int q = 0; q < 4; ++q) { pa[q] = (int)pack_fp8x4(p0[4 * q], p0[4 * q + 1], p0[4 * q + 2], p0[4 * q + 3]); pa[4 + q] = (int)pack_fp8x4(p1[4 * q], p1[4 * q + 1], p1[4 * q + 2], p1[4 * q + 3]); } \
    } while (0)
    ATT_VM(0); ATT_BAR();
    int sk = 0, sv = NSLOT - 1;
    for (int s = 0; s <= T; ++s) {
#define ATT_ISSUE() do { const int k2 = sk == 0 ? NSLOT - 1 : sk - 1, v1 = k2 == 0 ? NSLOT - 1 : k2 - 1;     \
          if (VAR != 3) { if (s + PFD < T) ATT_DMA_K(t_begin + s + PFD, k2); \
          if (s + PFD - 1 < T) ATT_DMA_V(t_begin + s + PFD - 1, v1); } } while (0)
        if (VAR != 1 && VAR != 5) { if (grp == 1 && s > 0) ATT_SOFTMAX(s == 1); }
        if (grp == 1) ATT_ISSUE();
        i32x8 kf0, kf1;
        if (VAR != 2 && VAR != 5 && s < T) { const LAS unsigned char* Ks = lds + LDS_K + sk * SLOTK;
            kf0 = cat8(*(const LAS i32x4*)(Ks + foff0), *(const LAS i32x4*)(Ks + foff1)); kf1 = cat8(*(const LAS i32x4*)(Ks + 2048 + foff0), *(const LAS i32x4*)(Ks + 2048 + foff1)); }
        if (VAR != 2 && VAR != 5 && s < T) {
            __builtin_amdgcn_s_setprio(1);
            p0 = __builtin_amdgcn_mfma_scale_f32_32x32x64_f8f6f4(kf0, qf, negm, 0, 0, 0, sc_s, 0, sc_s);
            p1 = __builtin_amdgcn_mfma_scale_f32_32x32x64_f8f6f4(kf1, qf, negm, 0, 0, 0, sc_s, 0, sc_s);
            __builtin_amdgcn_s_setprio(0);
        }
        if (VAR != 2 && VAR != 5 && s > 0) {
            const LAS unsigned char* Vs = lds + LDS_V + sv * SLOTV;
            i32x8 vf[4];
#pragma unroll
            for (int d0 = 0; d0 < 4; ++d0) vf[d0] = cat8(*(const LAS i32x4*)(Vs + d0 * 2048 + foff0), *(const LAS i32x4*)(Vs + d0 * 2048 + foff1));
            __builtin_amdgcn_s_setprio(1);
#pragma unroll
            for (int d0 = 0; d0 < 4; ++d0) o[d0] = __builtin_amdgcn_mfma_scale_f32_32x32x64_f8f6f4(pa, vf[d0], o[d0], 0, 0, 0, sc_1, 0, sc_1);
            lacc = __builtin_amdgcn_mfma_scale_f32_32x32x64_f8f6f4(pa, ones, lacc, 0, 0, 0, sc_1, 0, sc_1);
            __builtin_amdgcn_s_setprio(0);
        }
        if (VAR != 2 && VAR != 5 && s < T) asm volatile("s_nop 15\n\ts_nop 15" : "+v"(p0), "+v"(p1));
        if (grp == 0) ATT_ISSUE();
        if (VAR != 1 && VAR != 5) { if (grp == 0 && s < T) ATT_SOFTMAX(s == 0); }
        if (s + PFD < T) { if (dk) { ATT_VMN(2 * (PFD - 1)); } else { ATT_VMN(PFD - 1); } } else { ATT_VM(0); }
        if (VAR != 4) ATT_BAR();
        sv = sk; sk = sk == NSLOT - 1 ? 0 : sk + 1;
    }
#undef ATT_SOFTMAX
#undef ATT_ISSUE
    f32x4* scr4 = (f32x4*)(P.scr + (size_t)blockIdx.x * 32768) + tid;
    if (c == 0) {
        float rl[16];
#pragma unroll
        for (int r = 0; r < 16; ++r) rl[r] = __builtin_amdgcn_rcpf(lacc[r]);
#pragma unroll
        for (int d0 = 0; d0 < 4; ++d0)
#pragma unroll
            for (int rq = 0; rq < 4; ++rq) scr4[(d0 * 4 + rq) * 512] = (f32x4){o[d0][4 * rq] * rl[4 * rq], o[d0][4 * rq + 1] * rl[4 * rq + 1], o[d0][4 * rq + 2] * rl[4 * rq + 2], o[d0][4 * rq + 3] * rl[4 * rq + 3]};
    } else {
        f32x4 o0v[16];
#pragma unroll
        for (int q = 0; q < 16; ++q) o0v[q] = scr4[q * 512];
        const float g0 = P.subln_g[r32], g1 = P.subln_g[32 + r32], g2 = P.subln_g[64 + r32], g3 = P.subln_g[96 + r32];
        LAS unsigned char* stg = lds + LDS_OST + wid * 4096;
#pragma unroll
        for (int r = 0; r < 16; ++r) { const float rl = __builtin_amdgcn_rcpf(lacc[r]) * P.lam; float dv[4]; float ss = 0.f;
#pragma unroll
            for (int d0 = 0; d0 < 4; ++d0) { const float o0 = o0v[d0 * 4 + (r >> 2)][r & 3]; dv[d0] = o0 - o[d0][r] * rl; ss += dv[d0] * dv[d0]; }
            ss += sx<1>(ss); ss += sx<2>(ss); ss += sx<4>(ss); ss += sx<8>(ss); ss += sx<16>(ss);
            const float sc = rsqrtf(ss * (1.0f / 128.0f) + ln_eps()) * P.outscale; const int orow = crow(r, hi);
            { const unsigned pk_ = pack_fp8x4(dv[0] * sc * g0, dv[1] * sc * g1, dv[2] * sc * g2, dv[3] * sc * g3);
              stg[orow * 128 + r32] = (unsigned char)(pk_ & 0xffu); stg[orow * 128 + 32 + r32] = (unsigned char)((pk_ >> 8) & 0xffu);
              stg[orow * 128 + 64 + r32] = (unsigned char)((pk_ >> 16) & 0xffu); stg[orow * 128 + 96 + r32] = (unsigned char)(pk_ >> 24); }
            if ((r & 3) == 3) __builtin_amdgcn_sched_barrier(0); }
        LDS_WAIT();
        unsigned char* Ow = P.O + (size_t)(qrow0 + wid * 32) * D + h * 128;
#pragma unroll
        for (int i = 0; i < 4; ++i) { const int id = i * 64 + lane, row = id >> 3, ch = id & 7; const u32x4 v = *(const LAS u32x4*)(stg + row * 128 + ch * 16); *(u32x4*)(Ow + (size_t)row * D + ch * 16) = v; }
    }
    asm volatile("s_waitcnt vmcnt(0) lgkmcnt(0)\n\ts_barrier" ::: "memory");
#undef ATT_DMA_K
#undef ATT_GLDS
#undef ATT_DMA_V
#undef ATT_KROW0
#undef ATT_BAR
#undef ATT_VM
#undef ATT_VMN
}
}

struct Args { const float* in[33]; float* out; unsigned char* ws; int ph_lo, ph_hi; };
enum { I_X = 0, I_C, I_CTX, I_CCTX, I_WMOD, I_BMOD, I_LN1G, I_LN1B, I_LN2G, I_LN2B, I_AQKV, I_AWO, I_LQ1, I_LK1, I_LQ2, I_LK2, I_SUBLN, I_FW, I_FB,
       I_CPW1, I_CBPW1, I_CWDW, I_CBDW, I_CLNG, I_CLNB, I_CPW2, I_CBPW2, I_RW, I_RB, I_MW1, I_MB1, I_MW2, I_MB2 };
struct Frame {
    LAS unsigned char* lds; volatile LAS unsigned* MISC; unsigned* ctl; unsigned char* ws;
    int tid, lane, wave, vcu, G, zi;
    const float* const* in; float* out;
};
#define WSP(T, off) ((T*)(F.ws + (off)))
#define MODP(layer, ci, chunk) (WSP(const float, WS_MOD) + ((size_t)(layer) * 9 + (ci)) * 6144 + (chunk) * 1024)

__device__ __forceinline__ void ld_row_f32(const float* p, int lane, f32x4 (&v)[4]) {
#pragma unroll
    for (int j = 0; j < 4; ++j) v[j] = *(const f32x4*)(p + 4 * lane + 256 * j);
}
__device__ __forceinline__ void ld_row_bf16(const bf16_t* p, int lane, f32x4 (&v)[4]) {
#pragma unroll
    for (int j = 0; j < 4; ++j) { const u32x2 w = *(const u32x2*)(p + 4 * lane + 256 * j); v[j] = (f32x4){bf_lo(w.x), bf_hi(w.x), bf_lo(w.y), bf_hi(w.y)}; }
}
__device__ __forceinline__ void ld_row_fp8(const unsigned char* p, int lane, f32x4 (&v)[4]) {
#pragma unroll
    for (int j = 0; j < 4; ++j) { const int w = *(const int*)(p + 4 * lane + 256 * j); const f32x2 lo = __builtin_amdgcn_cvt_pk_f32_fp8(w, false), hi = __builtin_amdgcn_cvt_pk_f32_fp8(w, true); v[j] = (f32x4){lo.x, lo.y, hi.x, hi.y}; }
}
__device__ __forceinline__ void st_row_f32(float* p, int lane, const f32x4 (&v)[4]) {
#pragma unroll
    for (int j = 0; j < 4; ++j) *(f32x4*)(p + 4 * lane + 256 * j) = v[j];
}
__device__ __forceinline__ void st_row_bf16(bf16_t* p, int lane, const f32x4 (&v)[4]) {
#pragma unroll
    for (int j = 0; j < 4; ++j) { u32x2 w; w.x = cvt_pk_bf16(v[j][0], v[j][1]); w.y = cvt_pk_bf16(v[j][2], v[j][3]); *(u32x2*)(p + 4 * lane + 256 * j) = w; }
}
__device__ __forceinline__ void st_row_fp8(unsigned char* p, int lane, const f32x4 (&v)[4]) {
#pragma unroll
    for (int j = 0; j < 4; ++j) *(unsigned*)(p + 4 * lane + 256 * j) = pack_fp8x4(v[j][0], v[j][1], v[j][2], v[j][3]);
}
__device__ __forceinline__ void layer_norm_row(f32x4 (&v)[4], const float* g, const float* b, int lane) {
    float s = 0.f;
#pragma unroll
    for (int j = 0; j < 4; ++j) s += (v[j][0] + v[j][1]) + (v[j][2] + v[j][3]);
    const float mean = wave_sum(s) * (1.0f / D); float q = 0.f;
#pragma unroll
    for (int j = 0; j < 4; ++j) { v[j] = v[j] - mean; q += (v[j][0] * v[j][0] + v[j][1] * v[j][1]) + (v[j][2] * v[j][2] + v[j][3] * v[j][3]); }
    const float rstd = rsqrtf(wave_sum(q) * (1.0f / D) + ln_eps());
#pragma unroll
    for (int j = 0; j < 4; ++j) { const f32x4 gg = *(const f32x4*)(g + 4 * lane + 256 * j), bb = *(const f32x4*)(b + 4 * lane + 256 * j); v[j] = v[j] * rstd * gg + bb; }
}
__device__ __forceinline__ void ld_vec(const float* p, int lane, f32x4 (&v)[4]) {
#pragma unroll
    for (int j = 0; j < 4; ++j) v[j] = *(const f32x4*)(p + 4 * lane + 256 * j);
}
__device__ __forceinline__ void layer_norm_row_r(f32x4 (&v)[4], const f32x4 (&g)[4], const f32x4 (&b)[4]) {
    float s = 0.f;
#pragma unroll
    for (int j = 0; j < 4; ++j) s += (v[j][0] + v[j][1]) + (v[j][2] + v[j][3]);
    const float mean = wave_sum(s) * (1.0f / D); float q = 0.f;
#pragma unroll
    for (int j = 0; j < 4; ++j) { v[j] = v[j] - mean; q += (v[j][0] * v[j][0] + v[j][1] * v[j][1]) + (v[j][2] * v[j][2] + v[j][3] * v[j][3]); }
    const float rstd = rsqrtf(wave_sum(q) * (1.0f / D) + ln_eps());
#pragma unroll
    for (int j = 0; j < 4; ++j) v[j] = v[j] * rstd * g[j] + b[j];
}
__device__ __forceinline__ void ld_rowB_f32(const float* p, int lane, f32x4 (&v)[4]) {
#pragma unroll
    for (int i = 0; i < 4; ++i) v[i] = *(const f32x4*)(p + 16 * lane + 4 * i);
}
__device__ __forceinline__ void st_rowB_f32(float* p, int lane, const f32x4 (&v)[4]) {
#pragma unroll
    for (int i = 0; i < 4; ++i) *(f32x4*)(p + 16 * lane + 4 * i) = v[i];
}
__device__ __forceinline__ void ld_rowB_fp8(const unsigned char* p, int lane, f32x4 (&v)[4]) {
    const u32x4 w = *(const u32x4*)(p + 16 * lane);
#pragma unroll
    for (int i = 0; i < 4; ++i) { const f32x2 lo = __builtin_amdgcn_cvt_pk_f32_fp8((int)w[i], false), hi = __builtin_amdgcn_cvt_pk_f32_fp8((int)w[i], true); v[i] = (f32x4){lo.x, lo.y, hi.x, hi.y}; }
}
__device__ __forceinline__ void ld_rowB_bf16(const bf16_t* p, int lane, f32x4 (&v)[4]) {
    const u32x4 w0 = *(const u32x4*)(p + 16 * lane), w1 = *(const u32x4*)(p + 16 * lane + 8);
    v[0] = (f32x4){bf_lo(w0.x), bf_hi(w0.x), bf_lo(w0.y), bf_hi(w0.y)}; v[1] = (f32x4){bf_lo(w0.z), bf_hi(w0.z), bf_lo(w0.w), bf_hi(w0.w)};
    v[2] = (f32x4){bf_lo(w1.x), bf_hi(w1.x), bf_lo(w1.y), bf_hi(w1.y)}; v[3] = (f32x4){bf_lo(w1.z), bf_hi(w1.z), bf_lo(w1.w), bf_hi(w1.w)};
}
__device__ __forceinline__ int permB(int c) { return 4 * (c >> 4) + 256 * ((c >> 2) & 3) + (c & 3); }
__device__ __forceinline__ void st_rowB_fp8(unsigned char* p, int lane, const f32x4 (&v)[4]) {
    *(u32x4*)(p + 16 * lane) = (u32x4){pack_fp8x4(v[0][0], v[0][1], v[0][2], v[0][3]), pack_fp8x4(v[1][0], v[1][1], v[1][2], v[1][3]), pack_fp8x4(v[2][0], v[2][1], v[2][2], v[2][3]), pack_fp8x4(v[3][0], v[3][1], v[3][2], v[3][3])};
}
__device__ __forceinline__ void st_rowB_bf16(bf16_t* p, int lane, const f32x4 (&v)[4]) {
    *(u32x4*)(p + 16 * lane) = (u32x4){cvt_pk_bf16(v[0][0], v[0][1]), cvt_pk_bf16(v[0][2], v[0][3]), cvt_pk_bf16(v[1][0], v[1][1]), cvt_pk_bf16(v[1][2], v[1][3])};
    *(u32x4*)(p + 16 * lane + 8) = (u32x4){cvt_pk_bf16(v[2][0], v[2][1]), cvt_pk_bf16(v[2][2], v[2][3]), cvt_pk_bf16(v[3][0], v[3][1]), cvt_pk_bf16(v[3][2], v[3][3])};
}
__device__ __forceinline__ const float* xrow_in(const Frame& F, int layer, int row) {
    if (layer == 0) return row < T_LAT ? F.in[F.zi + I_X] + (size_t)row * D : F.in[F.zi + I_CTX] + (size_t)(row - T_LAT) * D;
    return WSP(const float, WS_X) + (size_t)row * D;
}
__device__ __forceinline__ int cond_of(int row) { return row < T_LAT ? (row >> 12) : 8; }

__device__ __forceinline__ void transpose_family(const Frame& F, const float* src, int nmat, int K, int N, bf16_t* dst, LAS float* scr) {
    const int lane = hidden_tid(F.wave) & 63; const int gw = F.vcu * NWAVES + F.wave, NGW = F.G * NWAVES;
    const int nkb = K / 64, nnb = N / 64, per = nkb * nnb; const long items = (long)nmat * per;
    for (long it = gw; it < items; it += NGW) {
        const int mat = (int)(it / per), r = (int)(it % per), kb = r / nnb, nb = r % nnb, k0 = kb * 64, n0 = nb * 64;
        const float* W = src + (size_t)mat * K * N; bf16_t* WT = dst + (size_t)mat * K * N;
        f32x4 v[16];
#pragma unroll
        for (int i = 0; i < 16; ++i) v[i] = *(const f32x4*)(W + (size_t)(k0 + 4 * i + (lane >> 4)) * N + n0 + 4 * (lane & 15));
#pragma unroll
        for (int i = 0; i < 16; ++i) { LAS float* s = scr + (4 * i + (lane >> 4)) * 65 + 4 * (lane & 15); s[0] = v[i][0]; s[1] = v[i][1]; s[2] = v[i][2]; s[3] = v[i][3]; }
        LDS_WAIT(); asm volatile("" ::: "memory");
        const int kc = lane & 7;
#pragma unroll
        for (int jj = 0; jj < 8; ++jj) { const int n = (lane >> 3) + 8 * jj; const LAS float* s = scr + (8 * kc) * 65 + n;
            u32x4 o; o.x = cvt_pk_bf16(s[0], s[65]); o.y = cvt_pk_bf16(s[2 * 65], s[3 * 65]); o.z = cvt_pk_bf16(s[4 * 65], s[5 * 65]); o.w = cvt_pk_bf16(s[6 * 65], s[7 * 65]);
            *(u32x4*)(WT + (size_t)(n0 + n) * K + k0 + 8 * kc) = o; }
        LDS_WAIT(); asm volatile("" ::: "memory");
    }
}
template <bool FP8> __device__ __forceinline__ void quant_w(Frame& F, const float* src, int nmat, int N, unsigned char* dst, float* scales, int rot = 0) {
    const int tid = hidden_tid(F.wave), lane = tid & 63, wave = __builtin_amdgcn_readfirstlane(tid >> 6);
    LAS float* scr = (LAS float*)(F.lds + wave * 16640);
    LAS float* cmaxp = (LAS float*)(F.lds + 133120);
    LAS float* finv = (LAS float*)(F.lds + 133120 + 2048);
    const int strips = N / 64;
    for (int it = (F.vcu + F.G - rot % F.G) % F.G; it < nmat * strips; it += F.G) {
        const int mat = it / strips, n0 = (it % strips) * 64;
        const float* W = src + (size_t)mat * 1024 * N + n0 + 4 * (lane & 15);
        f32x4 v[32];
#pragma unroll
        for (int i = 0; i < 32; ++i) v[i] = *(const f32x4*)(W + (size_t)(wave * 128 + 4 * i + (lane >> 4)) * N);
        float mx0 = 0.f, mx1 = 0.f, mx2 = 0.f, mx3 = 0.f;
#pragma unroll
        for (int i = 0; i < 32; ++i) { mx0 = fmaxf(mx0, fabsf(v[i][0])); mx1 = fmaxf(mx1, fabsf(v[i][1])); mx2 = fmaxf(mx2, fabsf(v[i][2])); mx3 = fmaxf(mx3, fabsf(v[i][3])); }
        mx0 = fmaxf(mx0, sx<16>(mx0)); mx1 = fmaxf(mx1, sx<16>(mx1)); mx2 = fmaxf(mx2, sx<16>(mx2)); mx3 = fmaxf(mx3, sx<16>(mx3));
        { auto r0 = __builtin_amdgcn_permlane32_swap(__float_as_uint(mx0), __float_as_uint(mx0), false, false); mx0 = fmaxf(__uint_as_float(r0[0]), __uint_as_float(r0[1]));
          auto r1 = __builtin_amdgcn_permlane32_swap(__float_as_uint(mx1), __float_as_uint(mx1), false, false); mx1 = fmaxf(__uint_as_float(r1[0]), __uint_as_float(r1[1]));
          auto r2 = __builtin_amdgcn_permlane32_swap(__float_as_uint(mx2), __float_as_uint(mx2), false, false); mx2 = fmaxf(__uint_as_float(r2[0]), __uint_as_float(r2[1]));
          auto r3 = __builtin_amdgcn_permlane32_swap(__float_as_uint(mx3), __float_as_uint(mx3), false, false); mx3 = fmaxf(__uint_as_float(r3[0]), __uint_as_float(r3[1])); }
        if (lane < 16) *(LAS f32x4*)(cmaxp + wave * 64 + 4 * lane) = (f32x4){mx0, mx1, mx2, mx3};
        __syncthreads();
        if (tid < 64) { float m = cmaxp[tid];
#pragma unroll
            for (int w = 1; w < 8; ++w) m = fmaxf(m, cmaxp[w * 64 + tid]);
            const float sc = m > 0.f ? m * (1.0f / (FP8 ? FP8_TOP : 127.0f)) : 1.0f; scales[(size_t)mat * N + n0 + tid] = sc; finv[tid] = 1.0f / sc; }
        __syncthreads();
        unsigned char* Wq = dst + (size_t)mat * N * 1024;
#pragma unroll
        for (int kb2 = 0; kb2 < 2; ++kb2) { const int k0 = wave * 128 + kb2 * 64;
#pragma unroll
            for (int i = 0; i < 16; ++i) { LAS float* sp = scr + (4 * i + (lane >> 4)) * 65 + 4 * (lane & 15); sp[0] = v[16 * kb2 + i][0]; sp[1] = v[16 * kb2 + i][1]; sp[2] = v[16 * kb2 + i][2]; sp[3] = v[16 * kb2 + i][3]; }
            LDS_WAIT(); asm volatile("" ::: "memory");
            const int kc = lane & 3;
#pragma unroll
            for (int jj = 0; jj < 4; ++jj) { const int n = (lane >> 2) + 16 * jj; const LAS float* sp = scr + (16 * kc) * 65 + n; const float fi = finv[n];
                u32x4 o;
                if (FP8) { o.x = pack_fp8x4(sp[0] * fi, sp[65] * fi, sp[2 * 65] * fi, sp[3 * 65] * fi); o.y = pack_fp8x4(sp[4 * 65] * fi, sp[5 * 65] * fi, sp[6 * 65] * fi, sp[7 * 65] * fi);
                    o.z = pack_fp8x4(sp[8 * 65] * fi, sp[9 * 65] * fi, sp[10 * 65] * fi, sp[11 * 65] * fi); o.w = pack_fp8x4(sp[12 * 65] * fi, sp[13 * 65] * fi, sp[14 * 65] * fi, sp[15 * 65] * fi); }
                else { o.x = pack_i8x4(sp[0] * fi, sp[65] * fi, sp[2 * 65] * fi, sp[3 * 65] * fi); o.y = pack_i8x4(sp[4 * 65] * fi, sp[5 * 65] * fi, sp[6 * 65] * fi, sp[7 * 65] * fi);
                    o.z = pack_i8x4(sp[8 * 65] * fi, sp[9 * 65] * fi, sp[10 * 65] * fi, sp[11 * 65] * fi); o.w = pack_i8x4(sp[12 * 65] * fi, sp[13 * 65] * fi, sp[14 * 65] * fi, sp[15 * 65] * fi); }
                *(u32x4*)(Wq + (size_t)(n0 + n) * 1024 + k0 + 16 * kc) = o; }
            LDS_WAIT(); asm volatile("" ::: "memory");
        }
        __syncthreads();
    }
}
__device__ __forceinline__ void p0_prologue(Frame& F) {
    const int tid = hidden_tid(F.wave), lane = tid & 63, wave = __builtin_amdgcn_readfirstlane(tid >> 6);
    LAS float* sc = (LAS float*)F.lds;
    LAS float* red = (LAS float*)(F.lds + 40960);
    for (int i = tid; i < 9 * 1024; i += NTHR) { const float cv = i < 8192 ? F.in[F.zi + I_C][i] : F.in[F.zi + I_CCTX][i - 8192]; sc[i] = cv * fast_sigmoid(cv); }
    __syncthreads();
    for (int it = F.vcu; it < 4 * 96; it += F.G) {
        const int layer = it / 96, n = (it % 96) * 64 + lane;
        const float* W = F.in[F.zi + I_WMOD] + (size_t)layer * 1024 * 6144 + n;
        float a[9];
#pragma unroll
        for (int r = 0; r < 9; ++r) a[r] = 0.f;
#pragma unroll 8
        for (int k = wave * 128; k < wave * 128 + 128; ++k) { const float w = W[(size_t)k * 6144];
#pragma unroll
            for (int r = 0; r < 9; ++r) a[r] += sc[r * 1024 + k] * w; }
#pragma unroll
        for (int r = 0; r < 9; ++r) red[(wave * 9 + r) * 64 + lane] = a[r];
        __syncthreads();
        for (int r = wave; r < 9; r += NWAVES) { float s = F.in[F.zi + I_BMOD][layer * 6144 + n];
#pragma unroll
            for (int w = 0; w < 8; ++w) s += red[(w * 9 + r) * 64 + lane];
            WSP(float, WS_MOD)[((size_t)layer * 9 + r) * 6144 + n] = s; }
        __syncthreads();
    }
    const int gt = F.vcu * NTHR + tid, NGT = F.G * NTHR;
    for (int i = gt; i < 64 * 16; i += NGT) { const int pos = i >> 4, f = i & 15; const float inv = __powf(10000.0f, -(float)f / 16.0f); float s, c; sincosf((float)pos * inv, &s, &c);
        WSP(float, WS_ROPE)[2 * i] = c; WSP(float, WS_ROPE)[2 * i + 1] = s; }
    for (int i = gt; i < 2 * 256 * 256; i += NGT) { const int cs = i >> 16, r = (i >> 8) & 255, k = i & 255; float v = 0.f;
        if ((r >> 7) == (k >> 7)) { const int m = ((r & 127) * (k & 127)) & 127; v = (cs ? sinpif((float)m / 64.0f) : cospif((float)m / 64.0f)) * 0.08838834764831845f; }
        WSP(bf16_t, WS_ACS)[i] = (bf16_t)(cvt_pk_bf16(v, 0.f) & 0xffffu); }
    for (int i = gt; i < 256 * 512; i += NGT) { const int k = i >> 9, j = i & 511, n = j & 255; const int m = (k * n) & 255;
        const float v = (j < 256 ? cospif((float)m / 128.0f) : -sinpif((float)m / 128.0f)) * (0.0625f * DFT_PRESCALE);
        WSP(unsigned char, WS_DFTN)[(size_t)(4096 + k) * 8192 + j] = (unsigned char)(pack_fp8x4(v, 0.f, 0.f, 0.f) & 0xffu); }
    LAS float* tab = (LAS float*)(F.lds + 81920);
    for (int m = tid; m < 4096; m += NTHR) tab[m] = cospif((float)m / 2048.0f) * (0.015625f * DFT_PRESCALE);
    __syncthreads();
    for (int i = gt; i < 4096 * 1024; i += NGT) {
        const int k = i >> 10, j0 = (i & 1023) * 8; unsigned w[2];
#pragma unroll
        for (int q = 0; q < 2; ++q) { float v[4];
#pragma unroll
            for (int e = 0; e < 4; ++e) { const int j = j0 + 4 * q + e, n = j & 4095; const int m = (k * n) & 4095;
                v[e] = j < 4096 ? tab[m] : -tab[(m - 1024) & 4095]; }
            w[q] = pack_fp8x4(v[0], v[1], v[2], v[3]); }
        *(u32x2*)(WSP(unsigned char, WS_DFTN) + (size_t)k * 8192 + j0) = (u32x2){w[0], w[1]}; }
    __syncthreads();
    LAS float* scr = (LAS float*)(F.lds + wave * 16640);
    (void)scr;
    __syncthreads();
    quant_w<true>(F, F.in[F.zi + I_AQKV], 2, 3072, WSP(unsigned char, WS_WQKV), WSP(float, WS_WQKVS));
    quant_w<true>(F, F.in[F.zi + I_CPW1], 1, 2048, WSP(unsigned char, WS_PW1), WSP(float, WS_PW1S), 96);
    quant_w<true>(F, F.in[F.zi + I_AWO], 2, 1024, WSP(unsigned char, WS_WO), WSP(float, WS_WZS), 128);
    quant_w<true>(F, F.in[F.zi + I_FW], 1, 1024, WSP(unsigned char, WS_WF), WSP(float, WS_WZS) + 2048, 160);
    quant_w<true>(F, F.in[F.zi + I_CPW2], 1, 1024, WSP(unsigned char, WS_PW2), WSP(float, WS_WZS) + 3072, 176);
    quant_w<false>(F, F.in[F.zi + I_MW1], 128, 2048, WSP(unsigned char, WS_W1), WSP(float, WS_W1S));
    quant_w<true>(F, F.in[F.zi + I_MW2], 128, 1024, WSP(unsigned char, WS_W2), WSP(float, WS_W2S));
}
__device__ __forceinline__ void p1_modulate(Frame& F) {
    const int lane = hidden_tid(F.wave) & 63; const int gw = F.vcu * NWAVES + F.wave, NGW = F.G * NWAVES;
    const int per = (T_ALL + NGW - 1) / NGW, r0 = gw * per, r1 = min(T_ALL, r0 + per);
    int cic = -1; f32x4 psh[4], psc[4];
    for (int row = r0; row < r1; ++row) { const int ci = cond_of(row);
        if (ci != cic) { ld_rowB_f32(MODP(0, ci, 0), lane, psh); ld_rowB_f32(MODP(0, ci, 1), lane, psc); cic = ci; }
        f32x4 v[4]; ld_rowB_f32(xrow_in(F, 0, row), lane, v);
        st_rowB_bf16(WSP(bf16_t, WS_X) + (size_t)row * D, lane, v);
#pragma unroll
        for (int j = 0; j < 4; ++j) v[j] = v[j] * (1.0f + psc[j]) + psh[j];
        st_rowB_fp8(WSP(unsigned char, WS_U) + (size_t)row * D, lane, v); }
}
struct LRaw { u32x4 x0, x1, y0, y1; };
__device__ __forceinline__ void ln1_load(Frame& F, int row, int lane, LRaw& r) {
    const bf16_t* xp = WSP(const bf16_t, WS_X) + (size_t)row * D + 16 * lane; const bf16_t* yp = WSP(const bf16_t, WS_Y) + (size_t)row * D + 16 * lane;
    r.x0 = *(const u32x4*)xp; r.x1 = *(const u32x4*)(xp + 8); r.y0 = *(const u32x4*)yp; r.y1 = *(const u32x4*)(yp + 8);
}
__device__ __forceinline__ void unpack_bf16x16(const u32x4 w0, const u32x4 w1, f32x4 (&v)[4]) {
    v[0] = (f32x4){bf_lo(w0.x), bf_hi(w0.x), bf_lo(w0.y), bf_hi(w0.y)}; v[1] = (f32x4){bf_lo(w0.z), bf_hi(w0.z), bf_lo(w0.w), bf_hi(w0.w)};
    v[2] = (f32x4){bf_lo(w1.x), bf_hi(w1.x), bf_lo(w1.y), bf_hi(w1.y)}; v[3] = (f32x4){bf_lo(w1.z), bf_hi(w1.z), bf_lo(w1.w), bf_hi(w1.w)};
}
__device__ __forceinline__ void ln1_row(Frame& F, int layer, int row, int lane, const LRaw& raw, const LAS float* lgl, const f32x4 (&g1)[4], const f32x4 (&sc2)[4], const f32x4 (&sh2)[4], f32x4 (&v)[4]) {
    f32x4 y[4];
    unpack_bf16x16(raw.x0, raw.x1, v); unpack_bf16x16(raw.y0, raw.y1, y);
#pragma unroll
    for (int j = 0; j < 4; ++j) v[j] = DN_ALPHA * v[j] + g1[j] * y[j];
    { f32x4 lg[4], lb[4];
#pragma unroll
      for (int j = 0; j < 4; ++j) { lg[j] = *(const LAS f32x4*)(lgl + 4 * lane + 256 * j); lb[j] = *(const LAS f32x4*)(lgl + 1024 + 4 * lane + 256 * j); }
      layer_norm_row_r(v, lg, lb); }
    st_rowB_bf16(WSP(bf16_t, WS_X1) + (size_t)row * D, lane, v);
    float am = 0.f;
#pragma unroll
    for (int j = 0; j < 4; ++j) { v[j] = v[j] * sc2[j] + sh2[j]; am = fmaxf(am, fmaxf(fmaxf(fabsf(v[j][0]), fabsf(v[j][1])), fmaxf(fabsf(v[j][2]), fabsf(v[j][3])))); }
    am = wave_max(am); const float qs = am > 0.f ? am * (1.0f / 127.0f) : 1.0f, qi = 1.0f / qs;
    *(u32x4*)(WSP(unsigned char, WS_V2) + (size_t)row * D + 16 * lane) = (u32x4){pack_i8x4_fast(v[0][0], v[0][1], v[0][2], v[0][3], qi), pack_i8x4_fast(v[1][0], v[1][1], v[1][2], v[1][3], qi),
        pack_i8x4_fast(v[2][0], v[2][1], v[2][2], v[2][3], qi), pack_i8x4_fast(v[3][0], v[3][1], v[3][2], v[3][3], qi)};
    if (lane == 0) WSP(float, WS_V2S)[row] = qs;
}
__device__ __forceinline__ float reduce_scatter32(float (&p)[32], int lane) {
    float q16[16], q8[8], q4[4], q2[2];
    { const bool up = (lane & 32) != 0;
#pragma unroll
      for (int i = 0; i < 16; ++i) { const float keep = up ? p[16 + i] : p[i], send = up ? p[i] : p[16 + i];
          auto rr = __builtin_amdgcn_permlane32_swap(__float_as_uint(send), __float_as_uint(send), false, false); q16[i] = keep + (up ? __uint_as_float(rr[0]) : __uint_as_float(rr[1])); } }
    { const bool up = (lane & 16) != 0;
#pragma unroll
      for (int i = 0; i < 8; ++i) { const float keep = up ? q16[8 + i] : q16[i], send = up ? q16[i] : q16[8 + i]; q8[i] = keep + sx<16>(send); } }
    { const bool up = (lane & 8) != 0;
#pragma unroll
      for (int i = 0; i < 4; ++i) { const float keep = up ? q8[4 + i] : q8[i], send = up ? q8[i] : q8[4 + i]; q4[i] = keep + sx<8>(send); } }
    { const bool up = (lane & 4) != 0;
#pragma unroll
      for (int i = 0; i < 2; ++i) { const float keep = up ? q4[2 + i] : q4[i], send = up ? q4[i] : q4[2 + i]; q2[i] = keep + sx<4>(send); } }
    float r; { const bool up = (lane & 2) != 0; const float keep = up ? q2[1] : q2[0], send = up ? q2[0] : q2[1]; r = keep + sx<2>(send); }
    return r + sx<1>(r);
}
__device__ __forceinline__ void route_token(Frame& F, int row, int lane, float lg, LAS float* ws, volatile LAS int* hist) {
    const int e = (lane >> 1) & 31;
    if ((lane & 1) == 0) ws[e] = lg;
    LDS_WAIT();
    int rank = 0;
#pragma unroll
    for (int q = 0; q < 8; ++q) { const f32x4 o = *(const LAS f32x4*)(ws + 4 * q);
#pragma unroll
        for (int j = 0; j < 4; ++j) { const int e2 = 4 * q + j; rank += (o[j] > lg || (o[j] == lg && e2 < e)) ? 1 : 0; } }
    if (rank < 4 && (lane & 1) == 0) ws[32 + rank] = lg;
    LDS_WAIT();
    const f32x4 tv = *(const LAS f32x4*)(ws + 32);
    const float e1 = __expf(tv[1] - tv[0]), e2 = __expf(tv[2] - tv[0]), e3 = __expf(tv[3] - tv[0]); const float inv = 1.0f / (1.0f + e1 + e2 + e3);
    if (rank < 4 && (lane & 1) == 0) {
        WSP(int, WS_TOPK)[(size_t)row * 4 + rank] = e; WSP(float, WS_GATE)[(size_t)row * 4 + rank] = __expf(lg - tv[0]) * inv;
        int one_ = 1; asm volatile("" : "+v"(one_)); __hip_atomic_fetch_add((LAS int*)(hist + e), one_, __ATOMIC_RELAXED, __HIP_MEMORY_SCOPE_WORKGROUP); }
}
__device__ __forceinline__ void phase_ln1_router(Frame& F, int layer, int nrows, bool count) {
    const int tid = hidden_tid(F.wave), lane = tid & 63;
    LAS float* wt = (LAS float*)F.lds;
    LAS float* wsc = (LAS float*)(F.lds + 131072) + F.wave * 128;
    volatile LAS int* hist = (volatile LAS int*)(F.lds + MISC_OFF + 64);
    const float* Wr = F.in[F.zi + I_RW] + (size_t)layer * 1024 * 32;
    for (int i = tid; i < 32768; i += NTHR) wt[(i & 31) * 1024 + permB(i >> 5)] = Wr[i];
    if (tid < 32) hist[tid] = 0;
    { u32x4* rt = WSP(u32x4, WS_ROWTOK); int gstep = F.G * NTHR; asm volatile("" : "+s"(gstep));
      unsigned zz = 0u; asm volatile("" : "+v"(zz));
#pragma clang loop vectorize(disable) unroll(disable)
      for (int p = F.vcu * NTHR + tid; p < P_MAX / 4; p += gstep) rt[p] = (u32x4){zz, zz, zz, zz}; }
    LAS float* lgl = (LAS float*)(F.lds + 131072 + 4096);
    for (int i = tid; i < 2048; i += NTHR) lgl[(i & 1024) + permB(i & 1023)] = i < 1024 ? F.in[F.zi + I_LN1G][layer * D + i] : F.in[F.zi + I_LN1B][layer * D + i - 1024];
    __syncthreads();
    f32x4 pg1[4], psc[4], psh[4];
    const float rbias = F.in[F.zi + I_RB][layer * 32 + ((lane >> 1) & 31)];
    const int gw = F.vcu * NWAVES + F.wave, NGW = F.G * NWAVES;
    const int npairs = nrows / 2, per = (npairs + NGW - 1) / NGW, p0 = gw * per, p1 = min(npairs, p0 + per);
    int cic = -1;
    LRaw ra, rb;
    if (p0 < p1) { ln1_load(F, 2 * p0, lane, ra); ln1_load(F, 2 * p0 + 1, lane, rb); }
    for (int pr = p0; pr < p1; ++pr) {
        const int ci = cond_of(2 * pr);
        if (ci != cic) { ld_rowB_f32(MODP(layer, ci, 2), lane, pg1); ld_rowB_f32(MODP(layer, ci, 4), lane, psc); ld_rowB_f32(MODP(layer, ci, 3), lane, psh); cic = ci;
#pragma unroll
            for (int j = 0; j < 4; ++j) psc[j] = psc[j] + 1.0f; }
        f32x4 va[4], vb[4];
        ln1_row(F, layer, 2 * pr, lane, ra, lgl, pg1, psc, psh, va); ln1_row(F, layer, 2 * pr + 1, lane, rb, lgl, pg1, psc, psh, vb);
        { const int pn = pr + 1 < p1 ? pr + 1 : pr; ln1_load(F, 2 * pn, lane, ra); ln1_load(F, 2 * pn + 1, lane, rb); }
        float pa[32], pb[32];
#pragma unroll
        for (int e = 0; e < 32; ++e) { f32x2 sa = (f32x2){0.f, 0.f}, sb = sa;
#pragma unroll
            for (int j = 0; j < 4; ++j) { const f32x4 w = *(const LAS f32x4*)(wt + e * 1024 + 4 * lane + 256 * j);
                const f32x2 wl = __builtin_shufflevector(w, w, 0, 1), wh = __builtin_shufflevector(w, w, 2, 3);
                sa = __builtin_elementwise_fma(__builtin_shufflevector(va[j], va[j], 0, 1), wl, sa); sa = __builtin_elementwise_fma(__builtin_shufflevector(va[j], va[j], 2, 3), wh, sa);
                sb = __builtin_elementwise_fma(__builtin_shufflevector(vb[j], vb[j], 0, 1), wl, sb); sb = __builtin_elementwise_fma(__builtin_shufflevector(vb[j], vb[j], 2, 3), wh, sb); }
            pa[e] = sa.x + sa.y; pb[e] = sb.x + sb.y; }
        const float la = reduce_scatter32(pa, lane) + rbias, lbv = reduce_scatter32(pb, lane) + rbias;
        route_token(F, 2 * pr, lane, la, wsc, hist); route_token(F, 2 * pr + 1, lane, lbv, wsc + 64, hist);
    }
    __syncthreads();
    if (tid < 32 && count) { const int hv = hist[tid]; if (hv) __hip_atomic_fetch_add(F.ctl + CW_CNT + layer * 32 + tid, (unsigned)hv, RLX_AGENT); }
}
__device__ __forceinline__ volatile LAS int* moe_tables(Frame& F, int layer) {
    volatile LAS int* ts = (volatile LAS int*)(F.lds + MISC_OFF + 256);
    if (hidden_tid(F.wave) == 0) { int acc = 0; for (int e = 0; e < 32; ++e) { ts[e] = acc; acc += ((int)__hip_atomic_load(F.ctl + CW_CNT + layer * 32 + e, RLX_AGENT) + 255) >> 8; } ts[32] = acc; }
    __syncthreads();
    return ts;
}
__device__ __forceinline__ void phase_assign(Frame& F, int layer, int nrows) {
    const int tid = hidden_tid(F.wave);
    volatile LAS int* ts = moe_tables(F, layer);
    volatile LAS int* lcnt = (volatile LAS int*)(F.lds + MISC_OFF + 512);
    volatile LAS int* lbase = (volatile LAS int*)(F.lds + MISC_OFF + 640);
    if (tid < 32) lcnt[tid] = 0;
    __syncthreads();
    const int chunk = (nrows + F.G - 1) / F.G, r0 = F.vcu * chunk, r1 = min(nrows, r0 + chunk);
    const int* tk = WSP(const int, WS_TOPK);
    int one_ = 1; asm volatile("" : "+v"(one_));
    for (int i = r0 * 4 + tid; i < r1 * 4; i += NTHR) __hip_atomic_fetch_add((LAS int*)(lcnt + tk[i]), one_, __ATOMIC_RELAXED, __HIP_MEMORY_SCOPE_WORKGROUP);
    __syncthreads();
    if (tid < 32) { const int n = lcnt[tid]; int base = ts[tid] * 256; if (n) base += (int)__hip_atomic_fetch_add(F.ctl + CW_CUR + layer * 32 + tid, (unsigned)n, RLX_AGENT); lbase[tid] = base; lcnt[tid] = 0; }
    __syncthreads();
    int* rt = WSP(int, WS_ROWTOK); int* pos = WSP(int, WS_POS); float* sap = WSP(float, WS_SAP); const float* sa = WSP(const float, WS_V2S);
    for (int i = r0 * 4 + tid; i < r1 * 4; i += NTHR) { const int e = tk[i]; const int p = lbase[e] + __hip_atomic_fetch_add((LAS int*)(lcnt + e), one_, __ATOMIC_RELAXED, __HIP_MEMORY_SCOPE_WORKGROUP); rt[p] = i >> 2; pos[i] = p; sap[p] = sa[i >> 2]; }
}
__device__ __forceinline__ void combine_row(Frame& F, int layer, int row, int lane, bool last, bool fp8u, const int4 ps, const f32x4 gt, const f32x4 (&lg)[4], const f32x4 (&lb)[4], const f32x4 (&pg2)[4], const f32x4 (&psc)[4], const f32x4 (&psh)[4]) {
    const int pk[4] = {ps.x, ps.y, ps.z, ps.w};
    f32x4 y[4][4], v[4];
    ld_rowB_bf16(WSP(const bf16_t, WS_X1) + (size_t)row * D, lane, v);
#pragma unroll
    for (int k = 0; k < 4; ++k) ld_rowB_fp8(WSP(const unsigned char, WS_Y2) + (size_t)pk[k] * D, lane, y[k]);
    f32x4 a[4];
#pragma unroll
    for (int j = 0; j < 4; ++j) { a[j] = (gt[0] * y[0][j] + gt[1] * y[1][j]) + (gt[2] * y[2][j] + gt[3] * y[3][j]); v[j] = DN_ALPHA * v[j] + (pg2[j] * (1.0f / Y2_PRESCALE)) * a[j]; }
    layer_norm_row_r(v, lg, lb);
    if (last) { st_rowB_f32(F.out + (size_t)row * D, lane, v); }
    else { st_rowB_bf16(WSP(bf16_t, WS_X) + (size_t)row * D, lane, v);
#pragma unroll
        for (int j = 0; j < 4; ++j) v[j] = v[j] * (1.0f + psc[j]) + psh[j];
        if (fp8u) st_rowB_fp8(WSP(unsigned char, WS_U) + (size_t)row * D, lane, v);
        else st_rowB_bf16(WSP(bf16_t, WS_U) + (size_t)row * D, lane, v); }
}
__device__ __forceinline__ void phase_combine_ln2(Frame& F, int layer, int nrows) {
    const int lane = hidden_tid(F.wave) & 63; const bool last = layer == DEPTH - 1; const bool fp8u = (layer + 1) % 3 != 1;
    f32x4 lg[4], lb[4], pg2[4], psc[4], psh[4]; ld_rowB_f32(F.in[F.zi + I_LN2G] + layer * D, lane, lg); ld_rowB_f32(F.in[F.zi + I_LN2B] + layer * D, lane, lb);
    const int gw = F.vcu * NWAVES + F.wave, NGW = F.G * NWAVES;
    const int npairs = nrows / 2, per = (npairs + NGW - 1) / NGW, p0 = gw * per, p1 = min(npairs, p0 + per);
    const int4* posp = WSP(const int4, WS_POS); const f32x4* gatp = WSP(const f32x4, WS_GATE);
    int cic = -1;
    int4 psa, psb; f32x4 gta, gtb;
    if (p0 < p1) { psa = posp[2 * p0]; psb = posp[2 * p0 + 1]; gta = gatp[2 * p0]; gtb = gatp[2 * p0 + 1]; }
    for (int pr = p0; pr < p1; ++pr) {
        const int ci = cond_of(2 * pr);
        if (ci != cic) { ld_rowB_f32(MODP(layer, ci, 5), lane, pg2); if (!last) { ld_rowB_f32(MODP(layer + 1, ci, 1), lane, psc); ld_rowB_f32(MODP(layer + 1, ci, 0), lane, psh); } cic = ci; }
        const int4 ca = psa, cb = psb; const f32x4 ga = gta, gb = gtb;
        const int pn = pr + 1 < p1 ? pr + 1 : pr;
        psa = posp[2 * pn]; psb = posp[2 * pn + 1]; gta = gatp[2 * pn]; gtb = gatp[2 * pn + 1];
        combine_row(F, layer, 2 * pr, lane, last, fp8u, ca, ga, lg, lb, pg2, psc, psh);
        combine_row(F, layer, 2 * pr + 1, lane, last, fp8u, cb, gb, lg, lb, pg2, psc, psh);
    }
}
__device__ __forceinline__ void phase_dwconv(Frame& F) {
    const int tid = hidden_tid(F.wave), lane = tid & 63, wave = __builtin_amdgcn_readfirstlane(tid >> 6);
    LAS unsigned* tile = (LAS unsigned*)F.lds;
    LAS float* red = (LAS float*)(F.lds + 126976);
    const float* wdw = F.in[F.zi + I_CWDW]; f32x2 wv[31];
#pragma unroll
    for (int j = 0; j < 31; ++j) { unsigned bo = (unsigned)(j * D + 2 * tid) * 4u; asm volatile("" : "+v"(bo));
        wv[j] = *(const f32x2*)((const char*)wdw + bo); }
    const f32x2 bdw = *(const f32x2*)(F.in[F.zi + I_CBDW] + 2 * tid), lng = *(const f32x2*)(F.in[F.zi + I_CLNG] + 2 * tid), lnb = *(const f32x2*)(F.in[F.zi + I_CLNB] + 2 * tid);
    const bf16_t* Gin = WSP(const bf16_t, WS_G); unsigned char* outp = WSP(unsigned char, WS_MIX);
    for (int un = F.vcu; un < 1024 + 64; un += F.G) {
        int seq0, slen, t0;
        if (un < 1024) { seq0 = (un >> 7) * SEQ; slen = SEQ; t0 = (un & 127) * 32; } else { const int q = un - 1024; seq0 = T_LAT + (q >> 3) * CTXL; slen = CTXL; t0 = (q & 7) * 32; }
        __syncthreads();
#pragma unroll 1
        for (int i = tid; i < 62 * 128; i += NTHR) { const int r = i >> 7, ch = i & 127, t = t0 - 15 + r; u32x4 v = (u32x4){0u, 0u, 0u, 0u};
            if (t >= 0 && t < slen) v = *(const u32x4*)(Gin + (size_t)(seq0 + t) * D + ch * 8);
            *(LAS u32x4*)(tile + r * 512 + ch * 4) = v; }
        __syncthreads();
        for (int hf = 0; hf < 2; ++hf) {
            f32x2 ov[16];
#pragma unroll
            for (int t = 0; t < 16; ++t) ov[t] = bdw;
            const LAS unsigned* tp = tile + hf * 16 * 512 + tid;
#pragma unroll
            for (int r = 0; r < 46; ++r) { const unsigned w = tp[r * 512]; const f32x2 xv = (f32x2){bf_lo(w), bf_hi(w)};
#pragma unroll
                for (int t = 0; t < 16; ++t) { const int j = r - t; if (j >= 0 && j < 31) ov[t] = __builtin_elementwise_fma(wv[j], xv, ov[t]); }
                if ((r & 7) == 7) __builtin_amdgcn_sched_barrier(0); }
            float o0[16], o1[16];
#pragma unroll
            for (int t = 0; t < 16; ++t) { o0[t] = ov[t].x; o1[t] = ov[t].y; }
#pragma unroll
            for (int t = 0; t < 16; ++t) { float s = o0[t] + o1[t], q = o0[t] * o0[t] + o1[t] * o1[t]; s = wave_sum(s); q = wave_sum(q);
                if (lane == 0) { red[(wave * 16 + t) * 2] = s; red[(wave * 16 + t) * 2 + 1] = q; } }
            __syncthreads();
#pragma unroll
            for (int t = 0; t < 16; t += 2) { unsigned pk2[2];
#pragma unroll
                for (int u = 0; u < 2; ++u) { float s = 0.f, q = 0.f;
#pragma unroll
                    for (int w = 0; w < 8; ++w) { s += red[(w * 16 + t + u) * 2]; q += red[(w * 16 + t + u) * 2 + 1]; }
                    const float mean = s * (1.0f / D), var = fmaxf(q * (1.0f / D) - mean * mean, 0.f), rstd = rsqrtf(var + ln_eps());
                    const float a0 = (o0[t + u] - mean) * rstd * lng.x + lnb.x, a1 = (o1[t + u] - mean) * rstd * lng.y + lnb.y;
                    pk2[u] = pack_fp8x4(a0 * fast_sigmoid(a0) * MIX_PRESCALE, a1 * fast_sigmoid(a1) * MIX_PRESCALE, 0.f, 0.f) & 0xffffu; }
                const bool odd = (tid & 1) != 0;
                const unsigned got = __float_as_uint(sx<1>(__uint_as_float(odd ? pk2[0] : pk2[1])));
                const unsigned word = odd ? (got | (pk2[1] << 16)) : (pk2[0] | (got << 16));
                *(unsigned*)(outp + (size_t)(seq0 + t0 + hf * 16 + t + (odd ? 1 : 0)) * D + 2 * (tid & ~1)) = word; }
            __syncthreads();
        }
    }
}
constexpr int NPHASE = 2 + 8 * DEPTH;
__global__ void __launch_bounds__(NTHR, 2) fwd(Args args) {
    extern __shared__ __attribute__((aligned(16))) unsigned char lds_raw[];
    Frame F;
    F.lds = (LAS unsigned char*)lds_raw; F.MISC = (volatile LAS unsigned*)(F.lds + MISC_OFF);
    F.tid = threadIdx.x; F.lane = F.tid & 63; F.wave = __builtin_amdgcn_readfirstlane(F.tid >> 6);
    F.G = gridDim.x; { const int bx = blockIdx.x; F.vcu = (F.G % 8 == 0) ? (bx % 8) * (F.G / 8) + bx / 8 : bx; }
    F.ws = args.ws; F.ctl = (unsigned*)(args.ws + WS_CTL); F.in = args.in; F.out = args.out; F.zi = 0;
    for (int u = F.tid; u < 512; u += NTHR) ((LAS unsigned*)(F.lds + MISC_OFF))[u] = 0u;
    __syncthreads();

    const int lo = args.ph_lo, hi = args.ph_hi;
    XcdBarrier bar; bar.bar = F.ctl + CW_BAR; bar.x = 0; bar.st = nullptr;
    if (hi - lo > 1) bar = xcd_barrier_post(F.ctl + CW_BAR, F.MISC);
#define IN(k) (lo <= (k) && (k) < hi)
#define SEAM(k) do { if (IN(k) && IN((k) + 1)) xcd_barrier(bar, F.wave); } while (0)
    int bx = (int)blockIdx.x; const int vcu0 = F.vcu, wave0 = F.wave; const unsigned xcc0 = bar.x;

    if (EN(0) && IN(0)) { for (int rep = 0; rep < NREP(0); ++rep) { __syncthreads(); p0_prologue(F); } } SEAM(0);
    if (EN(1) && IN(1)) { for (int rep = 0; rep < NREP(1); ++rep) { __syncthreads(); p1_modulate(F); } } SEAM(1);

    for (int layer = 0; layer < DEPTH; ++layer) {
        {
            const int z_ = __builtin_amdgcn_readfirstlane((int)F.MISC[2]);
            F.zi = z_; F.ws = args.ws + z_; F.out = args.out + z_; F.ctl = (unsigned*)(F.ws + WS_CTL); bar.bar = F.ctl + CW_BAR;
            F.G = (int)gridDim.x + z_; F.vcu = vcu0 + z_; bx = (int)blockIdx.x + z_; F.lds = (LAS unsigned char*)lds_raw + z_; F.MISC = (volatile LAS unsigned*)(F.lds + MISC_OFF); bar.st = F.MISC; bar.x = xcc0 + (unsigned)z_; F.wave = wave0 + z_; }
        const int pb = 2 + 8 * layer, kind = layer % 3, jj = layer / 3; const bool last = layer == DEPTH - 1;
        const int nrows = last ? T_LAT : T_ALL;
        if (IN(pb + 0)) for (int rep = 0; rep < NREP(kind == 0 ? 2 : (kind == 1 ? 3 : 4)); ++rep) {
            if (EN(2) && kind == 0) {
                const unsigned char* W8 = WSP(const unsigned char, WS_WQKV) + (size_t)jj * 3072 * 1024; const float* sw = WSP(const float, WS_WQKVS) + jj * 3072;
                { DenseSched S; S.init8(WSP(const unsigned char, WS_U), W8, T_ALL, 2048, 1024, 1024, F.G, bx);
                  EpiQK8 E{WSP(unsigned char, WS_Q), WSP(const float, WS_ROPE), sw};
                  g8::gemm_phase(F.lds, S, E, F.wave); }
                { VtSched S; S.init(W8 + (size_t)2048 * 1024, WSP(const unsigned char, WS_U), F.G, bx);
                  EpiVt8 E{WSP(unsigned char, WS_V), sw + 2048};
                  g8::gemm_phase(F.lds, S, E, F.wave); }
            } else if (EN(3) && kind == 1) {
                F1Sched S; S.init(WSP(const bf16_t, WS_ACS), WSP(const bf16_t, WS_U), F.G, bx);
                EpiFp8T<0> E{WSP(unsigned char, WS_YT), 8192, 1.0f};
                g8::gemm_phase(F.lds, S, E, F.wave);
            } else if (EN(4) && kind == 2) {
                GatedSched S; S.init8(WSP(const unsigned char, WS_U), WSP(const unsigned char, WS_PW1), T_ALL, 1024, 1024, 1024, F.G, bx);
                EpiGlu8 E{WSP(bf16_t, WS_G), 1024, F.in[F.zi + I_CBPW1], WSP(const float, WS_PW1S), 1024};
                g8::gemm_phase(F.lds, S, E, F.wave);
            }
        }
        SEAM(pb + 0);
        if (IN(pb + 1)) for (int rep = 0; rep < NREP(kind == 0 ? 5 : (kind == 1 ? 6 : 7)); ++rep) {
            if (EN(5) && kind == 0) {
                const float li = 0.8f - 0.6f * __expf(-0.3f * (float)layer);
                const int ln_ = hidden_tid(F.wave) & 63; const float d1 = wave_sum(F.in[F.zi + I_LQ1][jj * 64 + ln_] * F.in[F.zi + I_LK1][jj * 64 + ln_]), d2 = wave_sum(F.in[F.zi + I_LQ2][jj * 64 + ln_] * F.in[F.zi + I_LK2][jj * 64 + ln_]);
                att::Params P{WSP(const unsigned char, WS_Q), WSP(const unsigned char, WS_K), WSP(const unsigned char, WS_V), WSP(unsigned char, WS_MIX), WSP(float, WS_ASCR), F.in[F.zi + I_SUBLN] + jj * 128, __expf(d1) - __expf(d2) + li, (1.0f - li) * MIX_PRESCALE, F.wave};
                const int nun = last ? 1024 : 1024 + 64;
#if ATT_PROBE
                for (int un = F.vcu; un < nun; un += F.G) {
                    int b, h, q0, tb;
                    if (un < 1024) { b = un >> 7; h = (un >> 4) & 7; q0 = b * SEQ + (un & 15) * 256; tb = 0; } else { const int q = un - 1024; b = q >> 3; h = q & 7; q0 = T_LAT + b * CTXL; tb = 64; }
                    for (int c = 0; c < 2; ++c) att::unit<8, ATT_PROBE>(P, b, h, c, q0, tb, 68, F.lds);
                }
                __syncthreads();
#endif
                for (int un = F.vcu; un < nun; un += F.G) {
                    int b, h, q0, tb;
                    if (un < 1024) { b = un >> 7; h = (un >> 4) & 7; q0 = b * SEQ + (un & 15) * 256; tb = 0; } else { const int q = un - 1024; b = q >> 3; h = q & 7; q0 = T_LAT + b * CTXL; tb = 64; }
                    for (int c = 0; c < 2; ++c) att::unit<8>(P, b, h, c, q0, tb, 68, F.lds);
                }
            } else if (EN(6) && kind == 1) {
                F2Sched S; S.init(WSP(const unsigned char, WS_DFTN), WSP(const unsigned char, WS_YT), F.G, bx); EpiFp8T<2> E{WSP(unsigned char, WS_MIX), 1024, MIX_PRESCALE / DFT_PRESCALE}; g8::gemm_phase(F.lds, S, E, F.wave);
            } else if (EN(7) && kind == 2) {
                __syncthreads(); phase_dwconv(F);
            }
        }
        SEAM(pb + 1);
        if (EN(8) && IN(pb + 2)) for (int rep = 0; rep < NREP(8); ++rep) {
            const unsigned char* Bt = WSP(const unsigned char, 0) + (kind == 0 ? WS_WO + (size_t)jj * 1024 * 1024 : (kind == 1 ? WS_WF : WS_PW2));
            const float* wsc = WSP(const float, WS_WZS) + (kind == 0 ? jj : kind + 1) * 1024;
            const float* bias = kind == 0 ? (const float*)(F.ws + WS_CTL + 524288) : (kind == 1 ? F.in[F.zi + I_FB] : F.in[F.zi + I_CBPW2]);
            DenseSched S; S.init8(WSP(const unsigned char, WS_MIX), Bt, nrows, 1024, 1024, 1024, F.G, bx);
            EpiBf16T<2> E{WSP(bf16_t, WS_Y), 1024, bias, 0, wsc, 1.0f / MIX_PRESCALE};
            g8::gemm_phase(F.lds, S, E, F.wave);
        }
        SEAM(pb + 2);
        if (EN(9) && IN(pb + 3)) { for (int rep = 0; rep < NREP(9); ++rep) { __syncthreads(); phase_ln1_router(F, layer, nrows, rep == 0); } } SEAM(pb + 3);
        if (EN(10) && IN(pb + 4)) { phase_assign(F, layer, nrows); } SEAM(pb + 4);
        if (EN(11) && IN(pb + 5)) for (int rep = 0; rep < NREP(11); ++rep) {
            volatile LAS int* ts = MK_MULTI ? moe_tables(F, layer) : (volatile LAS int*)(F.lds + MISC_OFF + 256);
            MoeSched<true> S; S.init(WSP(const char, WS_V2), WSP(const char, WS_W1) + (size_t)layer * 32 * 2048 * 1024, WSP(const int, WS_ROWTOK), ts, F.G, bx, F.wave);
            EpiGatedI8 E{WSP(unsigned char, WS_H), F.in[F.zi + I_MB1] + (size_t)layer * 32 * 2048, WSP(const float, WS_W1S) + (size_t)layer * 32 * 2048, WSP(const float, WS_SAP)};
#if MOE_PROBE
            { EpiGatedI8T<(MOE_PROBE >> 4)> EP{E.O, E.bias, E.sw, E.sap};
              g8::gemm_phase<EpiGatedI8T<(MOE_PROBE >> 4)>, MoeSched<true>, (MOE_PROBE & 15)>(F.lds, S, EP, F.wave); __syncthreads(); }
#endif
            g8::gemm_phase(F.lds, S, E, F.wave);
        }
        SEAM(pb + 5);
        if (EN(12) && IN(pb + 6)) for (int rep = 0; rep < NREP(12); ++rep) {
            volatile LAS int* ts = MK_MULTI ? moe_tables(F, layer) : (volatile LAS int*)(F.lds + MISC_OFF + 256);
            MoeSched<false> S; S.init(WSP(const char, WS_H), WSP(const char, WS_W2) + (size_t)layer * 32 * 1024 * 1024, nullptr, ts, F.G, bx, F.wave);
            EpiY2 E{WSP(unsigned char, WS_Y2), F.in[F.zi + I_MB2] + (size_t)layer * 32 * 1024, WSP(const float, WS_W2S) + (size_t)layer * 32 * 1024};
            g8::gemm_phase(F.lds, S, E, F.wave);
        }
        SEAM(pb + 6);
        if (EN(13) && IN(pb + 7)) { for (int rep = 0; rep < NREP(13); ++rep) { __syncthreads(); phase_combine_ln2(F, layer, nrows); } } SEAM(pb + 7);
    }
#undef IN
#undef SEAM
}

extern "C" void kernel_launch(void* const* d_in, const int* in_sizes, int n_in, void* d_out, int out_size, void* d_ws, size_t ws_size, hipStream_t stream) {
    static int grid = 0;
    if (grid == 0) {
        if (n_in != 33 || out_size != T_LAT * D || ws_size < WS_END) { fprintf(stderr, "kernel_launch: unexpected shapes (n_in %d, out %d, ws %zu < %zu); nothing launched\n", n_in, out_size, ws_size, (size_t)WS_END); grid = -1; return; }
        int dev = 0, cus = 0, per_cu = 0;
        if (hipGetDevice(&dev) != hipSuccess || hipDeviceGetAttribute(&cus, hipDeviceAttributeMultiprocessorCount, dev) != hipSuccess) { grid = -1; return; }
        if (hipFuncSetAttribute((const void*)fwd, hipFuncAttributeMaxDynamicSharedMemorySize, LDS_BYTES) != hipSuccess) { fprintf(stderr, "kernel_launch: hipFuncSetAttribute failed\n"); grid = -1; return; }
        if (hipOccupancyMaxActiveBlocksPerMultiprocessor(&per_cu, (const void*)fwd, NTHR, LDS_BYTES) != hipSuccess || per_cu < 1) fprintf(stderr, "kernel_launch: occupancy query says %d blocks per CU\n", per_cu);
        (void)hipGetLastError();
        grid = cus < 256 ? cus : 256;
    }
    if (grid < 0) return;
    if (hipMemsetAsync((char*)d_ws + WS_CTL, 0, CTL_ZERO_BYTES, stream) != hipSuccess) return;
    Args a{};
    for (int i = 0; i < 33; ++i) a.in[i] = (const float*)d_in[i];
    a.out = (float*)d_out; a.ws = (unsigned char*)d_ws;
#if MK_MULTI
    for (int p = 0; p < NPHASE; ++p) { a.ph_lo = p; a.ph_hi = p + 1; hipLaunchKernelGGL(fwd, dim3(grid), dim3(NTHR), LDS_BYTES, stream, a); }
#else
    a.ph_lo = 0; a.ph_hi = NPHASE;
    hipLaunchKernelGGL(fwd, dim3(grid), dim3(NTHR), LDS_BYTES, stream, a);
#endif
    const hipError_t le = hipPeekAtLastError();
    if (le != hipSuccess) fprintf(stderr, "kernel_launch: launch failed: %s\n", hipGetErrorName(le));
}
```
